# Optimizing an MI355X kernel written in HIP

```python
import jax, jax.numpy as jnp
from jax import lax
import numpy as np

D_MODEL = 1024
BATCH = 8
SEQ = 4096
DEPTH = 1

HGRN_HEADS = 4
HGRN_HEAD_DIM = 128
HGRN_WIDTH = HGRN_HEADS * HGRN_HEAD_DIM
HGRN_CHUNK = 64
FOX_HEADS = 8
FOX_HEAD_DIM = 64
FOX_WIDTH = FOX_HEADS * FOX_HEAD_DIM
FOX_QBLOCK = 128
PEER_HEADS = 8
PEER_DK = 256
PEER_DK_HALF = PEER_DK // 2
N_KEYS = 128
N_EXPERTS = N_KEYS * N_KEYS
PEER_TOPK = 16
PEER_CHUNK = 128

RMS_EPS = 1e-6

_IN_SIZES = (HGRN_WIDTH, HGRN_WIDTH, HGRN_WIDTH, HGRN_WIDTH,
             FOX_WIDTH, FOX_WIDTH, FOX_WIDTH, FOX_HEADS,
             D_MODEL, D_MODEL)
IN_WIDTH = sum(_IN_SIZES)
IN_SPLITS = tuple(int(v) for v in np.cumsum(_IN_SIZES)[:-1])

kernel_name = "hgrn2_fox_gated_peer_block"


def rms_norm(x, w):
    xf = x.astype(jnp.float32)
    y = xf * lax.rsqrt(jnp.mean(xf * xf, axis=-1, keepdims=True) + RMS_EPS)
    return (y * w.astype(jnp.float32)).astype(x.dtype)


def hgrn2_mixer(q, f_logit, i, g, lb, norm_w):
    B, S, _ = q.shape
    C, H, dh = HGRN_CHUNK, HGRN_HEADS, HGRN_HEAD_DIM
    n_chunks = S // C
    f32 = jnp.float32
    qf = jax.nn.silu(q.astype(f32))
    f = lb + (1.0 - lb) * jax.nn.sigmoid(f_logit.astype(f32))
    log_f = jnp.log(f)
    k = 1.0 - f

    def to_chunks(t):
        return t.reshape(B, n_chunks, C, H, dh).transpose(1, 0, 3, 2, 4)

    qc, kc, vc, lfc = to_chunks(qf), to_chunks(k), to_chunks(i.astype(f32)), to_chunks(log_f)
    causal = jnp.tril(jnp.ones((C, C), dtype=bool))

    def step(state, inp):
        qb, kb, vb, lfb = inp
        cum = jnp.cumsum(lfb, axis=-2)
        diff = cum[..., :, None, :] - cum[..., None, :, :]
        decay = jnp.exp(jnp.where(causal[:, :, None], diff, -jnp.inf))
        scores = jnp.einsum('bhtk,bhsk,bhtsk->bhts', qb, kb, decay)
        o = jnp.einsum('bhts,bhsv->bhtv', scores, vb) \
            + jnp.einsum('bhtk,bhkv->bhtv', qb * jnp.exp(cum), state)
        last = cum[..., -1:, :]
        new_state = jnp.exp(last[..., 0, :])[..., None] * state \
            + jnp.einsum('bhsk,bhsv->bhkv', kb * jnp.exp(last - cum), vb)
        return new_state, o

    s0 = jnp.zeros((B, H, dh, dh), f32)
    _, o = lax.scan(step, s0, (qc, kc, vc, lfc))
    o = o.transpose(1, 0, 3, 2, 4).reshape(B, S, H, dh)
    o = o * lax.rsqrt(jnp.mean(o * o, axis=-1, keepdims=True) + RMS_EPS)
    o = o * norm_w.astype(f32).reshape(H, dh)
    o = o.reshape(B, S, HGRN_WIDTH) * jax.nn.silu(g.astype(f32))
    return o.astype(q.dtype)


def fox_attention(q, k, v, f_logit, f_bias):
    B, S, _ = q.shape
    H, dh, QB = FOX_HEADS, FOX_HEAD_DIM, FOX_QBLOCK
    nb = S // QB
    log_f = jax.nn.log_sigmoid(f_logit.astype(jnp.float32) + f_bias.astype(jnp.float32))
    c = jnp.cumsum(log_f, axis=1).transpose(0, 2, 1)
    scale = dh ** -0.5
    qh = q.reshape(B, S, H, dh).transpose(0, 2, 1, 3) * scale
    kh = k.reshape(B, S, H, dh).transpose(0, 2, 1, 3)
    vh = v.reshape(B, S, H, dh).transpose(0, 2, 1, 3)
    q_blocks = qh.reshape(B, H, nb, QB, dh).transpose(2, 0, 1, 3, 4)
    cq_blocks = c.reshape(B, H, nb, QB).transpose(2, 0, 1, 3)
    key_pos = jnp.arange(S)

    def block(args):
        qb, cqb, bi = args
        s = jnp.einsum('bhqd,bhkd->bhqk', qb, kh).astype(jnp.float32)
        s = s + cqb[..., :, None] - c[..., None, :]
        q_pos = bi * QB + jnp.arange(QB)
        mask = key_pos[None, :] <= q_pos[:, None]
        p = jax.nn.softmax(jnp.where(mask, s, -jnp.inf), axis=-1)
        return jnp.einsum('bhqk,bhkd->bhqd', p.astype(vh.dtype), vh)

    o = lax.map(block, (q_blocks, cq_blocks, jnp.arange(nb)))
    return o.transpose(1, 0, 3, 2, 4).reshape(B, S, FOX_WIDTH)


def peer_ffn(x, w_q, sub_keys, u_table, v_table):
    B, S, D = x.shape
    T = B * S
    xt = x.reshape(T, D)
    q = (xt @ w_q).reshape(T, PEER_HEADS, 2, PEER_DK_HALF)
    s = jnp.einsum('thpd,hpnd->thpn', q, sub_keys).astype(jnp.float32)
    s1, i1 = lax.top_k(s[:, :, 0], PEER_TOPK)
    s2, i2 = lax.top_k(s[:, :, 1], PEER_TOPK)
    cand = (s1[..., :, None] + s2[..., None, :]).reshape(T, PEER_HEADS, PEER_TOPK * PEER_TOPK)
    cand_idx = (i1[..., :, None] * N_KEYS + i2[..., None, :]).reshape(T, PEER_HEADS, PEER_TOPK * PEER_TOPK)
    top_s, pos = lax.top_k(cand, PEER_TOPK)
    idx = jnp.take_along_axis(cand_idx, pos, axis=-1)
    gates = jax.nn.softmax(top_s, axis=-1).astype(x.dtype)
    nc = T // PEER_CHUNK
    HK = PEER_HEADS * PEER_TOPK

    def chunk(args):
        xc, ic, gc = args
        u = u_table[ic]
        a = jax.nn.gelu(jnp.einsum('cd,ced->ce', xc, u), approximate=False) * gc
        return jnp.einsum('ce,ced->cd', a, v_table[ic])

    out = lax.map(chunk, (xt.reshape(nc, PEER_CHUNK, D),
                          idx.reshape(nc, PEER_CHUNK, HK),
                          gates.reshape(nc, PEER_CHUNK, HK)))
    return out.reshape(B, S, D)


def setup_inputs(seed: int = 0) -> dict:
    key = jax.random.key(seed)
    ks = jax.random.split(key, 16)
    f32 = jnp.float32
    nrm = lambda k, shape, s: jax.random.normal(k, shape, f32) * s
    return {
        "x": nrm(ks[0], (BATCH, SEQ, D_MODEL), 1.0),
        "norm_mix_w": 1.0 + nrm(ks[1], (DEPTH, D_MODEL), 0.02),
        "w_in": nrm(ks[2], (DEPTH, D_MODEL, IN_WIDTH), D_MODEL ** -0.5),
        "hgrn_lb_logits": nrm(ks[3], (DEPTH + 1, HGRN_WIDTH), 0.5),
        "hgrn_norm_w": 1.0 + nrm(ks[4], (DEPTH, HGRN_WIDTH), 0.02),
        "fox_f_bias": 2.0 + nrm(ks[5], (DEPTH, FOX_HEADS), 0.5),
        "w_branch_hgrn": nrm(ks[6], (DEPTH, HGRN_WIDTH, D_MODEL), HGRN_WIDTH ** -0.5),
        "w_branch_fox": nrm(ks[7], (DEPTH, FOX_WIDTH, D_MODEL), FOX_WIDTH ** -0.5),
        "w_out": nrm(ks[8], (DEPTH, D_MODEL, D_MODEL), D_MODEL ** -0.5),
        "norm_ffn_w": 1.0 + nrm(ks[9], (DEPTH, D_MODEL), 0.02),
        "peer_w_q": nrm(ks[10], (DEPTH, D_MODEL, PEER_HEADS * PEER_DK), D_MODEL ** -0.5),
        "peer_sub_keys": nrm(ks[11], (DEPTH, PEER_HEADS, 2, N_KEYS, PEER_DK_HALF), PEER_DK_HALF ** -0.5),
        "peer_u": nrm(ks[12], (DEPTH, N_EXPERTS, D_MODEL), D_MODEL ** -0.5),
        "peer_v": nrm(ks[13], (DEPTH, N_EXPERTS, D_MODEL), 0.5),
        "norm_final_w": 1.0 + nrm(ks[14], (D_MODEL,), 0.02),
    }


def reference(x, norm_mix_w, w_in, hgrn_lb_logits, hgrn_norm_w, fox_f_bias, w_branch_hgrn,
              w_branch_fox, w_out, norm_ffn_w, peer_w_q, peer_sub_keys, peer_u, peer_v,
              norm_final_w):
    lb_all = jnp.cumsum(jax.nn.softmax(hgrn_lb_logits.astype(jnp.float32), axis=0), axis=0)
    h = x
    for l in range(DEPTH):
        xn = rms_norm(h, norm_mix_w[l])
        proj = xn @ w_in[l]
        hq, hf, hi, hg, fq, fk, fv, ff, ga, gb = jnp.split(proj, IN_SPLITS, axis=-1)
        a = hgrn2_mixer(hq, hf, hi, hg, lb_all[l], hgrn_norm_w[l])
        b = fox_attention(fq, fk, fv, ff, fox_f_bias[l])
        merged = jax.nn.sigmoid(ga) * (a @ w_branch_hgrn[l]) \
            + jax.nn.sigmoid(gb) * (b @ w_branch_fox[l])
        h = h + merged @ w_out[l]
        h = h + peer_ffn(rms_norm(h, norm_ffn_w[l]), peer_w_q[l], peer_sub_keys[l],
                         peer_u[l], peer_v[l])
    return rms_norm(h, norm_final_w)
```

```cpp
#include <hip/hip_runtime.h>
#include <hip/hip_cooperative_groups.h>
#include <math.h>
#include <stdio.h>
namespace cg = cooperative_groups;

#ifndef MEGA
#define MEGA 0
#endif

#define DI __device__ __forceinline__
constexpr int kB = 8, kS = 4096, kT = kB * kS, kD = 1024, kINW = 5640;
constexpr float kEps = 1e-6f;

struct Params {
    const float *x, *nmw, *w_in, *lbl, *hnw, *ffb, *w_a, *w_b, *w_out, *nfw, *w_q, *sk, *pu, *pv, *nlw;
    float* out; float* ws;
};

constexpr size_t OFF_RS1 = 0, OFF_RS2 = 32768, OFF_CFOX = 65536, OFF_IDX = 327680, OFF_GATE = 4521984;
constexpr size_t OFF_A = 9437184, OFF_B = OFF_A + 16777216, OFF_GA = OFF_B + 16777216, OFF_GB = OFF_GA + 33554432;

DI float sigmoidf_(float v) { return 1.f / (1.f + expf(-v)); }
DI float wave_sum(float v) {
#pragma unroll
    for (int o = 32; o > 0; o >>= 1) v += __shfl_xor(v, o);
    return v;
}

DI void ph_rowscale(const float* X, float* rs, int bid, int nblk) {
    const int wid = threadIdx.x >> 6, lane = threadIdx.x & 63;
    for (int row = bid * 4 + wid; row < kT; row += nblk * 4) {
        const float4* p = (const float4*)(X + (size_t)row * kD);
        float s = 0.f;
#pragma unroll
        for (int i = 0; i < 4; ++i) { float4 v = p[lane + 64 * i]; s += v.x * v.x + v.y * v.y + v.z * v.z + v.w * v.w; }
        s = wave_sum(s);
        if (lane == 0) rs[row] = 1.0f / sqrtf(s * (1.0f / kD) + kEps);
    }
}

template <int EPI>
DI void ph_sgemm(const float* A, int lda, const float* rowscale, const float* colw, const float* W, int ldw, int N, int K,
                 float* C, int ldc, const float* G2, int ldg, int bid, int nblk, float* sm) {
    const int ntn = (N + 63) / 64, ntm = kT / 64, ntiles = ntm * ntn;
    float(*As)[68] = (float(*)[68])sm;
    float(*Bs)[68] = (float(*)[68])(sm + 16 * 68);
    const int tid = threadIdx.x, ty = tid >> 4, tx = tid & 15;
    for (int tile = bid; tile < ntiles; tile += nblk) {
        const int tm = tile / ntn, tn = tile % ntn;
        const int row0 = tm * 64, col0 = tn * 64;
        float acc[4][4];
#pragma unroll
        for (int i = 0; i < 4; ++i)
#pragma unroll
            for (int j = 0; j < 4; ++j) acc[i][j] = 0.f;
        for (int k0 = 0; k0 < K; k0 += 16) {
            {
                const int r = tid >> 2, kk = (tid & 3) * 4;
                float4 v = *(const float4*)(A + (size_t)(row0 + r) * lda + k0 + kk);
                const float s = rowscale ? rowscale[row0 + r] : 1.f;
                if (colw) { const float4 w = *(const float4*)(colw + k0 + kk); v.x = v.x * s * w.x; v.y = v.y * s * w.y; v.z = v.z * s * w.z; v.w = v.w * s * w.w; }
                else { v.x *= s; v.y *= s; v.z *= s; v.w *= s; }
                As[kk + 0][r] = v.x; As[kk + 1][r] = v.y; As[kk + 2][r] = v.z; As[kk + 3][r] = v.w;
            }
            {
                const int kk = tid >> 4, c = (tid & 15) * 4;
                float4 v = make_float4(0.f, 0.f, 0.f, 0.f);
                if (col0 + c < N) v = *(const float4*)(W + (size_t)(k0 + kk) * ldw + col0 + c);
                *(float4*)&Bs[kk][c] = v;
            }
            __syncthreads();
#pragma unroll
            for (int kk = 0; kk < 16; ++kk) {
                const float4 a = *(const float4*)&As[kk][ty * 4];
                const float4 b = *(const float4*)&Bs[kk][tx * 4];
                const float av[4] = {a.x, a.y, a.z, a.w}, bv[4] = {b.x, b.y, b.z, b.w};
#pragma unroll
                for (int i = 0; i < 4; ++i)
#pragma unroll
                    for (int j = 0; j < 4; ++j) acc[i][j] += av[i] * bv[j];
            }
            __syncthreads();
        }
#pragma unroll
        for (int i = 0; i < 4; ++i) {
            const int r = row0 + ty * 4 + i;
#pragma unroll
            for (int j = 0; j < 4; ++j) {
                const int c = col0 + tx * 4 + j;
                if (c < N) {
                    float* cp = C + (size_t)r * ldc + c;
                    if (EPI == 0) *cp = acc[i][j];
                    else if (EPI == 1) *cp = sigmoidf_(*cp) * acc[i][j];
                    else if (EPI == 2) *cp = *cp + sigmoidf_(G2[(size_t)r * ldg + c]) * acc[i][j];
                    else *cp = G2[(size_t)r * ldg + c] + acc[i][j];
                }
            }
        }
    }
}

DI void ph_hgrn(const float* HIN, const float* lbl, const float* normw, float* Aout, int bid, int nblk, float* sm) {
    float* qs = sm; float* fs = sm + 128; float* ks = sm + 256; float* red = sm + 384; float* wsum = sm + 640;
    const int tid = threadIdx.x, v = tid & 127, kh = tid >> 7, lane = tid & 63, wid = tid >> 6;
    for (int item = bid; item < 32; item += nblk) {
        const int b = item >> 2, h = item & 3;
        float S[64];
#pragma unroll
        for (int k = 0; k < 64; ++k) S[k] = 0.f;
        float lbv = 0.f;
        if (tid < 128) { const float l0 = lbl[h * 128 + tid], l1 = lbl[512 + h * 128 + tid]; lbv = 1.f / (1.f + expf(l1 - l0)); }
        const float nw = normw[h * 128 + v];
        for (int t = 0; t < kS; ++t) {
            const float* row = HIN + (size_t)(b * kS + t) * 2048;
            if (tid < 128) {
                const float q = row[h * 128 + tid], fl = row[512 + h * 128 + tid];
                const float f = lbv + (1.f - lbv) * sigmoidf_(fl);
                qs[tid] = q * sigmoidf_(q); fs[tid] = f; ks[tid] = 1.f - f;
            }
            const float vi = row[1024 + h * 128 + v];
            const float g = row[1536 + h * 128 + v];
            __syncthreads();
            float o = 0.f;
#pragma unroll
            for (int k = 0; k < 64; ++k) { const int kk = kh * 64 + k; S[k] = fs[kk] * S[k] + ks[kk] * vi; o += qs[kk] * S[k]; }
            red[tid] = o;
            __syncthreads();
            const float of = red[v] + red[v + 128];
            float sq = (kh == 0) ? of * of : 0.f;
            sq = wave_sum(sq);
            if (lane == 0) wsum[wid] = sq;
            __syncthreads();
            const float tot = wsum[0] + wsum[1];
            if (kh == 0) {
                const float on = of * (1.0f / sqrtf(tot * (1.0f / 128.f) + kEps)) * nw;
                Aout[(size_t)(b * kS + t) * 512 + h * 128 + v] = on * (g * sigmoidf_(g));
            }
        }
        __syncthreads();
    }
}

DI void ph_cfox(const float* FIN  , const float* fbias, float* cf  , int bid, int nblk) {
    for (int seq = bid * 256 + threadIdx.x; seq < 64; seq += nblk * 256) {
        const int b = seq >> 3, h = seq & 7;
        const float bias = fbias[h];
        float c = 0.f;
        for (int t = 0; t < kS; ++t) {
            const float z = FIN[(size_t)(b * kS + t) * 1544 + 1536 + h] + bias;
            c += fminf(z, 0.f) - log1pf(expf(-fabsf(z)));
            cf[seq * kS + t] = c;
        }
    }
}

DI void ph_fox(const float* FIN, const float* cf, float* Bout, int bid, int nblk, float* sm) {
    float(*Ks)[64] = (float(*)[64])sm;
    float(*Vs)[64] = (float(*)[64])(sm + 4096);
    float* cs = sm + 8192;
    const int tid = threadIdx.x;
    for (int item = bid; item < 1024; item += nblk) {
        const int qb = 15 - (item & 15), bh = item >> 4, b = bh >> 3, h = bh & 7;
        const int tq = qb * 256 + tid;
        float q[64], o[64];
        const float* qrow = FIN + (size_t)(b * kS + tq) * 1544 + h * 64;
#pragma unroll
        for (int d = 0; d < 64; ++d) { q[d] = qrow[d] * 0.125f; o[d] = 0.f; }
        const float cq = cf[bh * kS + tq];
        float m = -INFINITY, l = 0.f;
        const int nkt = (qb + 1) * 4;
        for (int kt = 0; kt < nkt; ++kt) {
            __syncthreads();
            {
                const int r = tid >> 2, c0 = (tid & 3) * 16;
                const float* kr = FIN + (size_t)(b * kS + kt * 64 + r) * 1544 + 512 + h * 64 + c0;
                const float* vr = FIN + (size_t)(b * kS + kt * 64 + r) * 1544 + 1024 + h * 64 + c0;
#pragma unroll
                for (int i = 0; i < 16; i += 4) { *(float4*)&Ks[r][c0 + i] = *(const float4*)(kr + i); *(float4*)&Vs[r][c0 + i] = *(const float4*)(vr + i); }
                if (tid < 64) cs[tid] = cf[bh * kS + kt * 64 + tid];
            }
            __syncthreads();
            for (int j = 0; j < 64; ++j) {
                const int s = kt * 64 + j;
                if (s <= tq) {
                    float dot = 0.f;
#pragma unroll
                    for (int d = 0; d < 64; ++d) dot += q[d] * Ks[j][d];
                    const float lg = dot + cq - cs[j];
                    if (lg > m) {
                        const float sc = expf(m - lg);
                        l *= sc;
#pragma unroll
                        for (int d = 0; d < 64; ++d) o[d] *= sc;
                        m = lg;
                    }
                    const float p = expf(lg - m);
                    l += p;
#pragma unroll
                    for (int d = 0; d < 64; ++d) o[d] += p * Vs[j][d];
                }
            }
        }
        const float inv = 1.f / l;
        float* orow = Bout + (size_t)(b * kS + tq) * 512 + h * 64;
#pragma unroll
        for (int d = 0; d < 64; ++d) orow[d] = o[d] * inv;
    }
}

DI void ph_topk(const float* Q  , const float* sk  , int* idx, float* gate, int bid, int nblk, float* sm) {
    float* qs = sm;
    float* sc = sm + 2048;
    float* tv = sm + 4096;
    int* ti = (int*)(sm + 4352);
    float* cand = sm + 4608;
    const int tid = threadIdx.x;
    for (int t = bid; t < kT; t += nblk) {
        __syncthreads();
        for (int i = tid; i < 2048; i += 256) qs[i] = Q[(size_t)t * 2048 + i];
        __syncthreads();
        for (int i = 0; i < 8; ++i) {
            const int sidx = i * 256 + tid;
            const int hp = sidx >> 7;
            const float* kr = sk + (size_t)sidx * 128;
            const float* qq = qs + hp * 128;
            float s = 0.f;
            for (int d = 0; d < 128; d += 4) { const float4 kv = *(const float4*)(kr + d); s += qq[d] * kv.x + qq[d + 1] * kv.y + qq[d + 2] * kv.z + qq[d + 3] * kv.w; }
            sc[sidx] = s;
        }
        __syncthreads();
        if (tid < 16) {
            float* l = sc + tid * 128;
            for (int r = 0; r < 16; ++r) {
                float best = -INFINITY; int bi = 0;
                for (int n = 0; n < 128; ++n) { const float v = l[n]; if (v > best) { best = v; bi = n; } }
                tv[tid * 16 + r] = best; ti[tid * 16 + r] = bi; l[bi] = -INFINITY;
            }
        }
        __syncthreads();
        {
            const int h = tid >> 5;
            for (int c = (tid & 31); c < 256; c += 32) cand[h * 256 + c] = tv[(h * 2) * 16 + (c >> 4)] + tv[(h * 2 + 1) * 16 + (c & 15)];
        }
        __syncthreads();
        if (tid < 8) {
            const int h = tid;
            float* l = cand + h * 256;
            float tsv[16]; int tpi[16];
            float mx = -INFINITY;
#pragma unroll
            for (int r = 0; r < 16; ++r) {
                float best = -INFINITY; int bi = 0;
                for (int n = 0; n < 256; ++n) { const float v = l[n]; if (v > best) { best = v; bi = n; } }
                tsv[r] = best; tpi[r] = bi; l[bi] = -INFINITY; mx = fmaxf(mx, best);
            }
            float sum = 0.f;
#pragma unroll
            for (int r = 0; r < 16; ++r) { tsv[r] = expf(tsv[r] - mx); sum += tsv[r]; }
            const float inv = 1.f / sum;
#pragma unroll
            for (int r = 0; r < 16; ++r) {
                const int i1 = ti[(h * 2) * 16 + (tpi[r] >> 4)], i2 = ti[(h * 2 + 1) * 16 + (tpi[r] & 15)];
                idx[(size_t)t * 128 + h * 16 + r] = i1 * 128 + i2;
                gate[(size_t)t * 128 + h * 16 + r] = tsv[r] * inv;
            }
        }
    }
}

DI void ph_experts(const float* H, const float* rs2, const float* nfw, const float* pu, const float* pv, const int* idx, const float* gate,
                   const float* nlw, float* out, int bid, int nblk, float* sm) {
    float* xs = sm;
    float* asv = sm + 1024;
    int* es = (int*)(sm + 1152);
    float* red = sm + 1280;
    const int tid = threadIdx.x, lane = tid & 63, wid = tid >> 6;
    for (int t = bid; t < kT; t += nblk) {
        __syncthreads();
        const float r2 = rs2[t];
        const float4 hv = *(const float4*)(H + (size_t)t * kD + tid * 4);
        {
            const float4 w = *(const float4*)(nfw + tid * 4);
            xs[tid * 4 + 0] = hv.x * r2 * w.x; xs[tid * 4 + 1] = hv.y * r2 * w.y; xs[tid * 4 + 2] = hv.z * r2 * w.z; xs[tid * 4 + 3] = hv.w * r2 * w.w;
        }
        if (tid < 128) es[tid] = idx[(size_t)t * 128 + tid];
        __syncthreads();
        for (int e = wid; e < 128; e += 4) {
            const float* ur = pu + (size_t)es[e] * kD;
            float s = 0.f;
#pragma unroll
            for (int i = 0; i < 4; ++i) { const float4 u = *(const float4*)(ur + (lane + 64 * i) * 4); const float* xx = xs + (lane + 64 * i) * 4; s += u.x * xx[0] + u.y * xx[1] + u.z * xx[2] + u.w * xx[3]; }
            s = wave_sum(s);
            if (lane == 0) asv[e] = 0.5f * s * (1.f + erff(s * 0.70710678118654752f)) * gate[(size_t)t * 128 + e];
        }
        __syncthreads();
        float4 y = make_float4(0.f, 0.f, 0.f, 0.f);
        for (int e = 0; e < 128; ++e) {
            const float a = asv[e];
            const float4 v = *(const float4*)(pv + (size_t)es[e] * kD + tid * 4);
            y.x += a * v.x; y.y += a * v.y; y.z += a * v.z; y.w += a * v.w;
        }
        y.x += hv.x; y.y += hv.y; y.z += hv.z; y.w += hv.w;
        float sq = y.x * y.x + y.y * y.y + y.z * y.z + y.w * y.w;
        sq = wave_sum(sq);
        if (lane == 0) red[wid] = sq;
        __syncthreads();
        const float tot = red[0] + red[1] + red[2] + red[3];
        const float rr = 1.0f / sqrtf(tot * (1.0f / kD) + kEps);
        const float4 w = *(const float4*)(nlw + tid * 4);
        *(float4*)(out + (size_t)t * kD + tid * 4) = make_float4(y.x * rr * w.x, y.y * rr * w.y, y.z * rr * w.z, y.w * rr * w.w);
    }
}

constexpr int NPHASE = 15;
template <int PH>
DI void run_phase(const Params& p, int bid, int nblk, float* sm) {
    float* ws = p.ws;
    float* rs1 = ws + OFF_RS1; float* rs2 = ws + OFF_RS2; float* cf = ws + OFF_CFOX; int* idx = (int*)(ws + OFF_IDX); float* gate = ws + OFF_GATE;
    float* Ab = ws + OFF_A; float* Bb = ws + OFF_B; float* GA = ws + OFF_GA; float* GB = ws + OFF_GB;
    if (PH == 0) ph_rowscale(p.x, rs1, bid, nblk);
    else if (PH == 1) ph_sgemm<0>(p.x, kD, rs1, p.nmw, p.w_in, kINW, 2048, kD, GA, 2048, nullptr, 0, bid, nblk, sm);
    else if (PH == 2) ph_hgrn(GA, p.lbl, p.hnw, Ab, bid, nblk, sm);
    else if (PH == 3) ph_sgemm<0>(p.x, kD, rs1, p.nmw, p.w_in + 2048, kINW, 1544, kD, GA, 1544, nullptr, 0, bid, nblk, sm);
    else if (PH == 4) ph_cfox(GA, p.ffb, cf, bid, nblk);
    else if (PH == 5) ph_fox(GA, cf, Bb, bid, nblk, sm);
    else if (PH == 6) ph_sgemm<0>(p.x, kD, rs1, p.nmw, p.w_in + 3592, kINW, 1024, kD, GA, 1024, nullptr, 0, bid, nblk, sm);
    else if (PH == 7) ph_sgemm<0>(p.x, kD, rs1, p.nmw, p.w_in + 4616, kINW, 1024, kD, GB, 1024, nullptr, 0, bid, nblk, sm);
    else if (PH == 8) ph_sgemm<1>(Ab, 512, nullptr, nullptr, p.w_a, kD, 1024, 512, GA, 1024, nullptr, 0, bid, nblk, sm);
    else if (PH == 9) ph_sgemm<2>(Bb, 512, nullptr, nullptr, p.w_b, kD, 1024, 512, GA, 1024, GB, 1024, bid, nblk, sm);
    else if (PH == 10) ph_sgemm<3>(GA, 1024, nullptr, nullptr, p.w_out, kD, 1024, kD, GB, 1024, p.x, 1024, bid, nblk, sm);
    else if (PH == 11) ph_rowscale(GB, rs2, bid, nblk);
    else if (PH == 12) ph_sgemm<0>(GB, 1024, rs2, p.nfw, p.w_q, 2048, 2048, kD, Ab, 2048, nullptr, 0, bid, nblk, sm);
    else if (PH == 13) ph_topk(Ab, p.sk, idx, gate, bid, nblk, sm);
    else if (PH == 14) ph_experts(GB, rs2, p.nfw, p.pu, p.pv, idx, gate, p.nlw, p.out, bid, nblk, sm);
}

constexpr int SM_FLOATS = 8192 + 64 + 1024;

template <int PH>
__global__ void __launch_bounds__(256) k_phase(Params p) {
    __shared__ __attribute__((aligned(16))) float sm[SM_FLOATS];
    run_phase<PH>(p, blockIdx.x, gridDim.x, sm);
}

__global__ void __launch_bounds__(256) k_mega(Params p) {
    __shared__ __attribute__((aligned(16))) float sm[SM_FLOATS];
    cg::grid_group grid = cg::this_grid();
    const int bid = blockIdx.x, nblk = gridDim.x;
    run_phase<0>(p, bid, nblk, sm); grid.sync();
    run_phase<1>(p, bid, nblk, sm); grid.sync();
    run_phase<2>(p, bid, nblk, sm); grid.sync();
    run_phase<3>(p, bid, nblk, sm); grid.sync();
    run_phase<4>(p, bid, nblk, sm); grid.sync();
    run_phase<5>(p, bid, nblk, sm); grid.sync();
    run_phase<6>(p, bid, nblk, sm);
    run_phase<7>(p, bid, nblk, sm); grid.sync();
    run_phase<8>(p, bid, nblk, sm); grid.sync();
    run_phase<9>(p, bid, nblk, sm); grid.sync();
    run_phase<10>(p, bid, nblk, sm); grid.sync();
    run_phase<11>(p, bid, nblk, sm); grid.sync();
    run_phase<12>(p, bid, nblk, sm); grid.sync();
    run_phase<13>(p, bid, nblk, sm); grid.sync();
    run_phase<14>(p, bid, nblk, sm);
}

template <int PH>
static void launch_phase(const Params& p, int grid, hipStream_t stream) { k_phase<PH><<<grid, 256, 0, stream>>>(p); }

extern "C" void kernel_launch(void* const* d_in, const int* in_sizes, int n_in, void* d_out, int out_size, void* d_ws, size_t ws_size, hipStream_t stream) {
    Params p{};
    p.x = (const float*)d_in[0]; p.nmw = (const float*)d_in[1]; p.w_in = (const float*)d_in[2]; p.lbl = (const float*)d_in[3];
    p.hnw = (const float*)d_in[4]; p.ffb = (const float*)d_in[5]; p.w_a = (const float*)d_in[6]; p.w_b = (const float*)d_in[7];
    p.w_out = (const float*)d_in[8]; p.nfw = (const float*)d_in[9]; p.w_q = (const float*)d_in[10]; p.sk = (const float*)d_in[11];
    p.pu = (const float*)d_in[12]; p.pv = (const float*)d_in[13]; p.nlw = (const float*)d_in[14];
    p.out = (float*)d_out; p.ws = (float*)d_ws;
#if MEGA
    static int grid_blocks = 0;
    if (!grid_blocks) {
        int dev = 0, cus = 0, per_cu = 0;
        hipGetDevice(&dev);
        hipDeviceGetAttribute(&cus, hipDeviceAttributeMultiprocessorCount, dev);
        hipOccupancyMaxActiveBlocksPerMultiprocessor(&per_cu, k_mega, 256, 0);
        if (per_cu > 2) per_cu = 2;
        grid_blocks = cus * per_cu;
    }
    void* args[] = {&p};
    hipError_t e = hipLaunchCooperativeKernel((void*)k_mega, dim3(grid_blocks), dim3(256), args, 0, stream);
    if (e != hipSuccess) fprintf(stderr, "cooperative launch failed: %s (grid %d)\n", hipGetErrorString(e), grid_blocks);
#else
    const int G = 2048;
    launch_phase<0>(p, G, stream); launch_phase<1>(p, G, stream); launch_phase<2>(p, 32, stream); launch_phase<3>(p, G, stream);
    launch_phase<4>(p, 1, stream); launch_phase<5>(p, 1024, stream); launch_phase<6>(p, G, stream); launch_phase<7>(p, G, stream);
    launch_phase<8>(p, G, stream); launch_phase<9>(p, G, stream); launch_phase<10>(p, G, stream); launch_phase<11>(p, G, stream);
    launch_phase<12>(p, G, stream); launch_phase<13>(p, G, stream); launch_phase<14>(p, G, stream);
#endif
}
```

```cpp
#include <hip/hip_runtime.h>
#include <math.h>
#include <stdio.h>

#ifndef MEGA
#define MEGA 1
#endif

#define DI __device__ __forceinline__
__device__ __forceinline__ int vtid_opaque() { int t = (int)threadIdx.x; asm volatile("" : "+v"(t)); return t & 255; }
#define VTID (vtid_opaque())
constexpr int kB = 8, kS = 4096, kT = kB * kS, kD = 1024, kINW = 5640;
constexpr float kEps = 1e-6f;

struct Params {
    const float *x, *nmw, *w_in, *lbl, *hnw, *ffb, *w_a, *w_b, *w_out, *nfw, *w_q, *sk, *pu, *pv, *nlw;
    float* out; unsigned char* ws;
};
constexpr size_t MBy = 1u << 20;
constexpr size_t OFF_SW = 256 * 1024;
constexpr size_t OFF_RS1 = 0, OFF_SSQ = 1 * MBy, OFF_CFOX = 3 * MBy, OFF_LFF = 4 * MBy, OFF_DC = 5 * MBy, OFF_IDX = 6 * MBy, OFF_GATE = 22 * MBy;
constexpr size_t OFF_WTIN = 38 * MBy, OFF_WTA = 50 * MBy, OFF_WTB = 51 * MBy, OFF_WTOUT = 52 * MBy, OFF_WTQ = 54 * MBy, OFF_SKB = 58 * MBy, OFF_UB = 59 * MBy  , OFF_VB = 75 * MBy  , OFF_ABUF = 91 * MBy  , OFF_SU = 107 * MBy, OFF_SV = 107 * MBy + 65536;
constexpr size_t OFF_AUG = 44 * MBy;
constexpr size_t OFF_R1 = 123 * MBy;
constexpr size_t OFF_R2 = 187 * MBy;
constexpr size_t OFF_R3 = 251 * MBy;
constexpr size_t OFF_R4 = 315 * MBy;
constexpr size_t OFF_R6 = 379 * MBy;
constexpr int kINP = 5760;
constexpr float kLog2e = 1.4426950408889634f;

DI float sigmoidf_(float v) { return 1.f / (1.f + expf(-v)); }
DI float wave_max(float v) {
#pragma unroll
    for (int o = 32; o > 0; o >>= 1) v = fmaxf(v, __shfl_xor(v, o));
    return v;
}
DI float wave_sum(float v) {
#pragma unroll
    for (int o = 32; o > 0; o >>= 1) v += __shfl_xor(v, o);
    return v;
}

#define LAS __attribute__((address_space(3)))
typedef unsigned short bf16_t;
typedef short bf16x8 __attribute__((ext_vector_type(8)));
typedef float f32x4 __attribute__((ext_vector_type(4)));
typedef unsigned u32x4 __attribute__((ext_vector_type(4)));
typedef unsigned u32x2 __attribute__((ext_vector_type(2)));
typedef float f32x2_t __attribute__((ext_vector_type(2)));
typedef __bf16 bf16x2_t __attribute__((ext_vector_type(2)));
DI unsigned cvtpk(float lo, float hi) { f32x2_t v = {lo, hi}; bf16x2_t b = __builtin_convertvector(v, bf16x2_t); return __builtin_bit_cast(unsigned, b); }
DI float bf2f(bf16_t v) { return __uint_as_float(((unsigned)v) << 16); }


#define XB_TMO      128
#define XB_XCNT(j)  (256  + 64 * (j))
#define XB_XSUB(j)  (1280 + 64 * (j))
#define XB_XGEN(j)  (2304 + 64 * (j))
#define XB_TOP      3328
#define XB_TOPGEN   3392
#define XCD_BAR_WORDS 3456
#define XB_SPIN_CAP (1u << 18)
DI unsigned xb_ld(unsigned* p)              { return __hip_atomic_load(p, __ATOMIC_RELAXED, __HIP_MEMORY_SCOPE_AGENT); }
DI unsigned xb_add(unsigned* p, unsigned v) { return __hip_atomic_fetch_add(p, v, __ATOMIC_RELAXED, __HIP_MEMORY_SCOPE_AGENT); }
DI unsigned xb_xcc_id() { return (unsigned)__builtin_amdgcn_s_getreg((3 << 11) | 20) & 0xFu; }
#define XB_SPIN(cond, bar) do { unsigned _sp = 0; while (cond) { __builtin_amdgcn_s_sleep(1); \
    if ((++_sp & 255u) == 0u) { if (xb_ld(&(bar)[XB_TMO])) break; if (_sp > XB_SPIN_CAP) { atomicAdd(&(bar)[XB_TMO], 1u); break; } } } } while (0)
struct XcdBarrier { unsigned* bar; unsigned x; volatile LAS unsigned* st; };
DI XcdBarrier xcd_barrier_post(unsigned* bar, volatile LAS unsigned* st) {
    XcdBarrier b; b.bar = bar; b.x = xb_xcc_id(); b.st = st;
    if (threadIdx.x == 0) (void)xb_add(&bar[XB_XCNT(b.x)], 1u);
    return b;
}
DI void xcd_barrier_complete(unsigned* bar, unsigned x, unsigned& nloc, unsigned& nx) {
    const unsigned G = gridDim.x * gridDim.y * gridDim.z;
    unsigned sum, cnt, mine, sp = 0u;
    for (;;) {
        sum = 0u; cnt = 0u; mine = 0u;
#pragma unroll
        for (unsigned j = 0; j < 16; ++j) { const unsigned c = xb_ld(&bar[XB_XCNT(j)]); sum += c; cnt += (c > 0u) ? 1u : 0u; mine = (j == x) ? c : mine; }
        if (sum == G) break;
        __builtin_amdgcn_s_sleep(1);
        if ((++sp & 255u) == 0u) { if (xb_ld(&bar[XB_TMO])) break; if (sp > XB_SPIN_CAP) { atomicAdd(&bar[XB_TMO], 1u); break; } }
    }
    nloc = mine > 0u ? mine : 1u; nx = cnt > 0u ? cnt : 1u;
}
DI void xcd_barrier(const XcdBarrier& b) {
    asm volatile("s_waitcnt vmcnt(0)" ::: "memory");
    __syncthreads();
    if (threadIdx.x == 0) {
        unsigned* bar = b.bar;
        __builtin_amdgcn_s_waitcnt(0);
        unsigned nloc = b.st[0], nx = b.st[1];
        if (nloc == 0u) { xcd_barrier_complete(bar, b.x, nloc, nx); b.st[0] = nloc; b.st[1] = nx; }
        const unsigned old = xb_add(&bar[XB_XSUB(b.x)], 1u);
        const unsigned gen = old / nloc;
        if (old + 1u == (gen + 1u) * nloc) {
            __builtin_amdgcn_fence(__ATOMIC_RELEASE, "agent");
            asm volatile("s_waitcnt vmcnt(0)" ::: "memory");
            const unsigned og = xb_add(&bar[XB_TOP], 1u);
            const unsigned tg = og / nx;
            if (og + 1u == (tg + 1u) * nx) xb_add(&bar[XB_TOPGEN], 1u);
            else XB_SPIN(xb_ld(&bar[XB_TOPGEN]) == tg, bar);
            __builtin_amdgcn_fence(__ATOMIC_ACQUIRE, "agent");
            xb_add(&bar[XB_XGEN(b.x)], 1u);
            asm volatile("s_waitcnt vmcnt(0)" ::: "memory");
        } else {
            XB_SPIN(xb_ld(&bar[XB_XGEN(b.x)]) == gen, bar);
            __builtin_amdgcn_fence(__ATOMIC_ACQUIRE, "agent");
            asm volatile("s_waitcnt vmcnt(0)" ::: "memory");
        }
    }
    __syncthreads();
}

DI void ph_conv_x8(const float* X, unsigned char* X8, float* rsx, int bid, int nblk) {
    const int wid = VTID >> 6, lane = VTID & 63;
    for (int row0 = (bid * 4 + wid) * 2; row0 < kT; row0 += nblk * 8) {
        float4 v[2][4];
#pragma unroll
        for (int r = 0; r < 2; ++r)
#pragma unroll
            for (int i = 0; i < 4; ++i) v[r][i] = ((const float4*)(X + (size_t)(row0 + r) * kD))[lane + 64 * i];
#pragma unroll
        for (int r = 0; r < 2; ++r) {
            float s = 0.f, m = 0.f;
#pragma unroll
            for (int i = 0; i < 4; ++i) { const float4 w = v[r][i]; s += w.x * w.x + w.y * w.y + w.z * w.z + w.w * w.w; m = fmaxf(m, fmaxf(fmaxf(fabsf(w.x), fabsf(w.y)), fmaxf(fabsf(w.z), fabsf(w.w)))); }
            s = wave_sum(s); m = wave_max(m);
            const float inv = (m > 0.f) ? 127.f / m : 0.f;
#pragma unroll
            for (int i = 0; i < 4; ++i) { const float4 w = v[r][i];
                const int a = (int)rintf(w.x * inv), b = (int)rintf(w.y * inv), c = (int)rintf(w.z * inv), d = (int)rintf(w.w * inv);
                ((unsigned*)(X8 + (size_t)(row0 + r) * kD))[lane + 64 * i] = (unsigned)(a & 0xff) | ((unsigned)(b & 0xff) << 8) | ((unsigned)(c & 0xff) << 16) | ((unsigned)(d & 0xff) << 24); }
            if (lane == 0) rsx[row0 + r] = m * (1.0f / 127.f) / sqrtf(s * (1.0f / kD) + kEps);
        }
    }
}
DI void ph_colmax(const float* W, int ldw, int nsrc0, int Ncnt, int K, const float* kscale, float* cm, int bid, int nblk, float* smf) {
    float* cmx = smf;
    const int ntn = (Ncnt + 63) / 64, ntk = K / 64, tid = VTID;
    for (int tbase = 0; tbase < ntn * ntk; tbase += nblk) {
        const bool active = tbase + bid < ntn * ntk; const int tile = active ? tbase + bid : 0;
        const int n0 = (tile / ntk) * 64, k0 = (tile % ntk) * 64, r = tid >> 4, c4 = (tid & 15) * 4;
        float4 mx = make_float4(0.f, 0.f, 0.f, 0.f);
        if (n0 + c4 < Ncnt) {
#pragma unroll
            for (int i = 0; i < 4; ++i) { const int k = k0 + r + 16 * i; const float4 v = *(const float4*)(W + (size_t)k * ldw + nsrc0 + n0 + c4); const float ks = kscale ? kscale[k] : 1.f;
                mx.x = fmaxf(mx.x, fabsf(v.x * ks)); mx.y = fmaxf(mx.y, fabsf(v.y * ks)); mx.z = fmaxf(mx.z, fabsf(v.z * ks)); mx.w = fmaxf(mx.w, fabsf(v.w * ks)); }
        }
        __syncthreads();
        cmx[r * 64 + c4] = mx.x; cmx[r * 64 + c4 + 1] = mx.y; cmx[r * 64 + c4 + 2] = mx.z; cmx[r * 64 + c4 + 3] = mx.w;
        __syncthreads();
        if (tid < 64 && active && n0 + tid < Ncnt) { float m = 0.f;
#pragma unroll
            for (int i = 0; i < 16; ++i) m = fmaxf(m, cmx[i * 64 + tid]);
            atomicMax((unsigned*)cm + n0 + tid, __float_as_uint(m)); }
    }
}
DI void ph_conv_wt8(const float* W, int ldw, int nsrc0, int Ncnt, int K, const float* kscale, const float* cm, unsigned char* Wt8, int bid, int nblk, float* smf) {
    float(*tl)[65] = (float(*)[65])smf;
    const int ntn = (Ncnt + 63) / 64, ntk = K / 64, tid = VTID;
    for (int tbase = 0; tbase < ntn * ntk; tbase += nblk) {
        const bool active = tbase + bid < ntn * ntk; const int tile = active ? tbase + bid : 0;
        const int n0 = (tile / ntk) * 64, k0 = (tile % ntk) * 64;
        __syncthreads();
        {
            const int r = tid >> 4, c4 = (tid & 15) * 4;
#pragma unroll
            for (int i = 0; i < 4; ++i) {
                const int k = r + 16 * i;
                float4 v = make_float4(0.f, 0.f, 0.f, 0.f);
                if (n0 + c4 < Ncnt) v = *(const float4*)(W + (size_t)(k0 + k) * ldw + nsrc0 + n0 + c4);
                tl[k][c4] = v.x; tl[k][c4 + 1] = v.y; tl[k][c4 + 2] = v.z; tl[k][c4 + 3] = v.w;
            }
        }
        __syncthreads();
        {
            const int n = tid >> 2, kq = (tid & 3) * 16;
            if (active && n0 + n < Ncnt) {
                const float m = cm[n0 + n], inv = (m > 0.f) ? 127.f / m : 0.f;
                unsigned w[4];
#pragma unroll
                for (int j = 0; j < 4; ++j) { unsigned q = 0;
#pragma unroll
                    for (int b = 0; b < 4; ++b) { const int kk = kq + 4 * j + b; q |= ((unsigned)((int)rintf(tl[kk][n] * (kscale ? kscale[k0 + kk] : 1.f) * inv) & 0xff)) << (8 * b); }
                    w[j] = q; }
                *(uint4*)(Wt8 + (size_t)(n0 + n) * K + k0 + kq) = make_uint4(w[0], w[1], w[2], w[3]);
            }
        }
    }
}
DI void ph_conv_wt(const float* W, int ldw, int nsrc0, int Ncnt, int K, const float* kscale, bf16_t* Wt, int bid, int nblk, float* smf) {
    float(*tl)[65] = (float(*)[65])smf;
    const int ntn = (Ncnt + 63) / 64, ntk = K / 64, tid = VTID;
    for (int tbase = 0; tbase < ntn * ntk; tbase += nblk) {
        const bool active = tbase + bid < ntn * ntk; const int tile = active ? tbase + bid : 0;
        const int n0 = (tile / ntk) * 64, k0 = (tile % ntk) * 64;
        __syncthreads();
        {
            const int r = tid >> 4, c4 = (tid & 15) * 4;
#pragma unroll
            for (int i = 0; i < 4; ++i) {
                const int k = r + 16 * i;
                float4 v = make_float4(0.f, 0.f, 0.f, 0.f);
                if (n0 + c4 < Ncnt) v = *(const float4*)(W + (size_t)(k0 + k) * ldw + nsrc0 + n0 + c4);
                tl[k][c4] = v.x; tl[k][c4 + 1] = v.y; tl[k][c4 + 2] = v.z; tl[k][c4 + 3] = v.w;
            }
        }
        __syncthreads();
        {
            const int n = tid >> 2, kq = (tid & 3) * 16;
            if (active && n0 + n < Ncnt) {
                unsigned w[8];
#pragma unroll
                for (int j = 0; j < 8; ++j) {
                    const float s0 = kscale ? kscale[k0 + kq + 2 * j] : 1.f, s1 = kscale ? kscale[k0 + kq + 2 * j + 1] : 1.f;
                    w[j] = cvtpk(tl[kq + 2 * j][n] * s0, tl[kq + 2 * j + 1][n] * s1);
                }
                uint4* dst = (uint4*)(Wt + (size_t)(n0 + n) * K + k0 + kq);
                dst[0] = make_uint4(w[0], w[1], w[2], w[3]); dst[1] = make_uint4(w[4], w[5], w[6], w[7]);
            }
        }
    }
}
DI void ph_zero_bf16(bf16_t* p, size_t n  , int bid, int nblk) {
    for (size_t i = (size_t)bid * 256 + VTID; i < n / 8; i += (size_t)nblk * 256) ((uint4*)p)[i] = make_uint4(0, 0, 0, 0);
}

DI void ph_conv_plain(const float* src, bf16_t* dst, size_t n  , const float* colscale  , int bid, int nblk) {
    for (size_t i = (size_t)bid * 256 + VTID; i < n / 8; i += (size_t)nblk * 256) {
        float4 a = ((const float4*)src)[2 * i], b = ((const float4*)src)[2 * i + 1];
        if (colscale) { const int c = (int)((i * 8) & (kD - 1)); const float4 s0 = *(const float4*)(colscale + c), s1 = *(const float4*)(colscale + c + 4);
            a.x *= s0.x; a.y *= s0.y; a.z *= s0.z; a.w *= s0.w; b.x *= s1.x; b.y *= s1.y; b.z *= s1.z; b.w *= s1.w; }
        ((uint4*)dst)[i] = make_uint4(cvtpk(a.x, a.y), cvtpk(a.z, a.w), cvtpk(b.x, b.y), cvtpk(b.z, b.w));
    }
}

DI void acc_zero(f32x4 (&acc)[4][4]) {
#pragma unroll
    for (int m = 0; m < 4; ++m)
#pragma unroll
        for (int n = 0; n < 4; ++n) acc[m][n] = (f32x4){0.f, 0.f, 0.f, 0.f};
}
struct LaneId { int wr, wc, fr, fq; };
DI LaneId lane_id() { const int tid = VTID, wid = tid >> 6, lane = tid & 63; return LaneId{wid >> 1, wid & 1, lane & 15, lane >> 4}; }

DI float fsigmoid(float z) { return __builtin_amdgcn_rcpf(1.f + __builtin_amdgcn_exp2f(-z * kLog2e)); }
DI void store_bf4(bf16_t* p, f32x4 v) { *(uint2*)p = make_uint2(cvtpk(v[0], v[1]), cvtpk(v[2], v[3])); }
DI f32x4 load_bf4(const bf16_t* p) { const uint2 u = *(const uint2*)p; return (f32x4){__uint_as_float(u.x << 16), __uint_as_float(u.x & 0xffff0000u), __uint_as_float(u.y << 16), __uint_as_float(u.y & 0xffff0000u)}; }
DI void store_bf8(bf16_t* p, const f32x4& v0, const f32x4& v1) { *(uint4*)p = make_uint4(cvtpk(v0[0], v0[1]), cvtpk(v0[2], v0[3]), cvtpk(v1[0], v1[1]), cvtpk(v1[2], v1[3])); }
DI void load_bf8(const bf16_t* p, f32x4& v0, f32x4& v1) { const uint4 u = *(const uint4*)p;
    v0 = (f32x4){__uint_as_float(u.x << 16), __uint_as_float(u.x & 0xffff0000u), __uint_as_float(u.y << 16), __uint_as_float(u.y & 0xffff0000u)};
    v1 = (f32x4){__uint_as_float(u.z << 16), __uint_as_float(u.z & 0xffff0000u), __uint_as_float(u.w << 16), __uint_as_float(u.w & 0xffff0000u)}; }

namespace pg8 {
#define PG8_LAS __attribute__((address_space(3)))
constexpr int BM = 256, BK = 64, HALF = 128, HTB = HALF * BK * 2  , STAGE_BYTES = 8 * HTB, NXCD = 8, WGM = 8;

__host__ __device__ __forceinline__ int lds_byte(int r, int c) { const int st = (r >> 4) * 2 + (c >> 5), rr = r & 15, cc = c & 31, ob = rr * 64 + cc * 2; return st * 1024 + (ob ^ (((ob >> 9) & 1) << 5)); }
__host__ __device__ __forceinline__ void stage_rc(int b, int& R, int& C) { const int st = b / 1024, sb = b % 1024, swz = sb ^ (((sb >> 9) & 1) << 5); R = (st >> 1) * 16 + swz / 64; C = (st & 1) * 32 + (swz % 64) / 2; }
__host__ __device__ __forceinline__ int perm32(int rho) { const int n = rho >> 4, i = rho & 15; return 8 * (i >> 2) + 4 * n + (i & 3); }

struct Unit { int pm, pn; };
struct Gemm { const bf16_t* A; const bf16_t* Bt; int M, N, K; };

struct StaticOrder {
    int nM, nN, nwg, G, c;
    __host__ __device__ void init(int M, int N, int G_, int c_) { nM = M / BM; nN = N / BM; nwg = nM * nN; G = G_; c = c_; }
    __host__ __device__ bool next(int i, Unit& u) const {
        const long L = (long)i * G + c; if (L >= nwg) return false;
        int wgid = (int)L; { const int q = nwg / NXCD, r = nwg % NXCD, xcd = wgid % NXCD, off = wgid / NXCD; wgid = (xcd < r ? xcd * (q + 1) : r * (q + 1) + (xcd - r) * q) + off; }
        const int nig = WGM * nN, gid = wgid / nig, fm = gid * WGM, gsz = (nM - fm) < WGM ? (nM - fm) : WGM;
        u.pm = fm + ((wgid % nig) % gsz); u.pn = (wgid % nig) / gsz; return true;
    }
    __device__ __forceinline__ void a_ready(const Unit&) const {}
    __device__ __forceinline__ void done(const Unit&) const {}
};
__device__ __forceinline__ unsigned cvt_pk_bf16(float lo, float hi) { unsigned r; asm volatile("v_cvt_pk_bf16_f32 %0, %1, %2" : "=v"(r) : "v"(lo), "v"(hi)); return r; }
typedef float f32x2 __attribute__((ext_vector_type(2)));
template <class Epi, class Sched, bool ALIGN_EPI = false, bool SP2 = false>
__device__ __forceinline__ void gemm_phase(PG8_LAS unsigned char* lds, const Gemm g, const Sched& S, const Epi& E) {
    int tid_ = (int)threadIdx.x; asm volatile("" : "+v"(tid_));
    const int tid = tid_, wid = __builtin_amdgcn_readfirstlane(tid >> 6), lane = tid & 63, wr = wid >> 2, wc = wid & 3, fr = lane & 15, fq = lane >> 4;
    const int K = g.K, nt = K / BK;
    unsigned voffA[2], voffB[2];
#pragma unroll
    for (int i = 0; i < 2; ++i) { int R, C; stage_rc(tid * 16 + i * 8192, R, C); const int Rb = Epi::PERM ? ((R & ~31) + perm32(R & 31)) : R;
        voffA[i] = (unsigned)(R * K + C) * 2u; voffB[i] = (unsigned)(Rb * K + C) * 2u; }
    const size_t kstep = (size_t)(BK * 2);
    const size_t hstep = (size_t)HALF * K * 2;
    const size_t tstep = 2 * hstep;
    const unsigned ldsw = (unsigned)wid * 1024u;
    const int aoff = lds_byte(wr * 64 + fr, fq * 8), boff = lds_byte(wc * 32 + fr, fq * 8);
#define PG8_SA(b, h) (((b) * 2 + (h)) * HTB)
#define PG8_SB(b, h) ((4 + (b) * 2 + (h)) * HTB)
#define PG8_STAGE(bufoff, gbase, voff) do { _Pragma("unroll") for (int _i = 0; _i < 2; ++_i) \
        __builtin_amdgcn_global_load_lds((const unsigned*)((const char*)(gbase) + (voff)[_i]), (PG8_LAS unsigned*)(lds + (bufoff) + ldsw + _i * 8192), 16, 0, 0); } while (0)
#define PG8_LDA(dst, b, h) do { _Pragma("unroll") for (int m = 0; m < 4; ++m) _Pragma("unroll") for (int k = 0; k < 2; ++k) dst[m][k] = *(const PG8_LAS bf16x8*)(lds + PG8_SA(b, h) + aoff + m * 2048 + k * 1024); } while (0)
#define PG8_LDB(dst, b, h) do { _Pragma("unroll") for (int n = 0; n < 2; ++n) _Pragma("unroll") for (int k = 0; k < 2; ++k) dst[n][k] = *(const PG8_LAS bf16x8*)(lds + PG8_SB(b, h) + boff + n * 2048 + k * 1024); } while (0)
#define PG8_MMA(ai, bj, At, Bt) do { __builtin_amdgcn_s_setprio(1); _Pragma("unroll") for (int m = 0; m < 4; ++m) _Pragma("unroll") for (int n = 0; n < 2; ++n) _Pragma("unroll") for (int k = 0; k < 2; ++k) \
        acc[ai][bj][m][n] = __builtin_amdgcn_mfma_f32_16x16x32_bf16(Bt[n][k], At[m][k], acc[ai][bj][m][n], 0, 0, 0); __builtin_amdgcn_s_setprio(0); } while (0)
#define PG8_WAIT_V(n) asm volatile("s_waitcnt vmcnt(" #n ")" ::: "memory")
#define PG8_WAIT_L(n) asm volatile("s_waitcnt lgkmcnt(" #n ")" ::: "memory")
#define PG8_BAR __builtin_amdgcn_s_barrier()
#define PG8_SCHED __builtin_amdgcn_sched_barrier(0)
    Unit cur, nxt; int ui = 0;
    if (!S.next(0, cur)) return;
    f32x4 acc[2][2][4][2];
#pragma unroll
    for (int a = 0; a < 2; ++a)
#pragma unroll
        for (int b = 0; b < 2; ++b)
#pragma unroll
            for (int m = 0; m < 4; ++m)
#pragma unroll
                for (int n = 0; n < 2; ++n) acc[a][b][m][n] = (f32x4){0.f, 0.f, 0.f, 0.f};
    bf16x8 At[4][2], B0[2][2], B1[2][2];
    const char* cA = (const char*)g.A + (size_t)cur.pm * tstep; const char* cB = (const char*)g.Bt + (size_t)cur.pn * tstep;
    S.a_ready(cur);
    if constexpr (SP2) {
        PG8_STAGE(PG8_SB(0, 0), cB, voffB); PG8_STAGE(PG8_SB(0, 1), cB + hstep, voffB); PG8_STAGE(PG8_SA(0, 0), cA, voffA); PG8_STAGE(PG8_SA(0, 1), cA + hstep, voffA);
        if (wr == 1) PG8_BAR;
        PG8_WAIT_V(2); PG8_BAR;
        PG8_STAGE(PG8_SB(1, 0), cB + kstep, voffB); PG8_STAGE(PG8_SA(1, 0), cA + kstep, voffA); PG8_STAGE(PG8_SB(1, 1), cB + hstep + kstep, voffB);
        PG8_WAIT_V(6); PG8_BAR;
    } else {
        PG8_STAGE(PG8_SB(0, 0), cB, voffB); PG8_STAGE(PG8_SA(0, 0), cA, voffA); PG8_STAGE(PG8_SB(0, 1), cB + hstep, voffB); PG8_STAGE(PG8_SA(0, 1), cA + hstep, voffA);
        if (wr == 1) PG8_BAR;
        PG8_WAIT_V(4); PG8_BAR;
        PG8_STAGE(PG8_SB(1, 0), cB + kstep, voffB); PG8_STAGE(PG8_SA(1, 0), cA + kstep, voffA); PG8_STAGE(PG8_SB(1, 1), cB + hstep + kstep, voffB);
        PG8_WAIT_V(6); PG8_BAR;
    }
    for (;;) {
        const bool has_next = S.next(ui + 1, nxt);
        const char* nA = has_next ? (const char*)g.A + (size_t)nxt.pm * tstep : cA; const char* nB = has_next ? (const char*)g.Bt + (size_t)nxt.pn * tstep : cB;
        for (int t = 0; t < nt; t += 2) {
            const bool last = (t == nt - 2);
            const char* a1 = cA + (size_t)(t + 1) * kstep;
            const char* a2 = last ? nA : cA + (size_t)(t + 2) * kstep; const char* b2 = last ? nB : cB + (size_t)(t + 2) * kstep;
            const char* a3 = a2 + kstep; const char* b3 = b2 + kstep;
            if (last && has_next) S.a_ready(nxt);
            if constexpr (SP2) {
            PG8_LDB(B0, 0, 0); PG8_LDB(B1, 0, 1); PG8_SCHED; PG8_LDA(At, 0, 0); PG8_STAGE(PG8_SA(1, 1), a1 + hstep, voffA);
            PG8_WAIT_V(8); PG8_WAIT_L(0); PG8_BAR; PG8_MMA(0, 0, At, B0); PG8_MMA(0, 1, At, B1); PG8_BAR; PG8_SCHED;
            PG8_LDA(At, 0, 1); PG8_STAGE(PG8_SB(0, 0), b2, voffB); PG8_STAGE(PG8_SB(0, 1), b2 + hstep, voffB); PG8_STAGE(PG8_SA(0, 0), a2, voffA);
            PG8_WAIT_V(8); PG8_WAIT_L(0); PG8_BAR; PG8_MMA(1, 0, At, B0); PG8_MMA(1, 1, At, B1); PG8_BAR; PG8_SCHED;
            PG8_LDB(B0, 1, 0); PG8_LDB(B1, 1, 1); PG8_SCHED; PG8_LDA(At, 1, 0); PG8_STAGE(PG8_SA(0, 1), a2 + hstep, voffA);
            PG8_WAIT_V(8); PG8_WAIT_L(0); PG8_BAR; PG8_MMA(0, 0, At, B0); PG8_MMA(0, 1, At, B1); PG8_BAR; PG8_SCHED;
            PG8_LDA(At, 1, 1); PG8_STAGE(PG8_SB(1, 0), b3, voffB); PG8_STAGE(PG8_SB(1, 1), b3 + hstep, voffB); PG8_STAGE(PG8_SA(1, 0), a3, voffA);
            PG8_WAIT_V(8); PG8_WAIT_L(0); PG8_BAR; PG8_MMA(1, 0, At, B0); PG8_MMA(1, 1, At, B1); PG8_BAR; PG8_SCHED;
            } else {
            PG8_LDB(B0, 0, 0); PG8_SCHED; PG8_LDA(At, 0, 0); PG8_STAGE(PG8_SA(1, 1), a1 + hstep, voffA);
            PG8_WAIT_L(8); PG8_BAR; PG8_WAIT_L(0); PG8_MMA(0, 0, At, B0); PG8_BAR; PG8_SCHED;
            PG8_LDB(B1, 0, 1); PG8_STAGE(PG8_SB(0, 0), b2, voffB);
            PG8_BAR; PG8_WAIT_L(0); PG8_MMA(0, 1, At, B1); PG8_BAR;
            PG8_LDA(At, 0, 1); PG8_STAGE(PG8_SA(0, 0), a2, voffA);
            PG8_BAR; PG8_WAIT_L(0); PG8_MMA(1, 0, At, B0); PG8_BAR; PG8_SCHED;
            PG8_STAGE(PG8_SB(0, 1), b2 + hstep, voffB);
            PG8_WAIT_V(6); PG8_BAR; PG8_MMA(1, 1, At, B1); PG8_BAR;
            PG8_LDB(B0, 1, 0); PG8_SCHED; PG8_LDA(At, 1, 0); PG8_STAGE(PG8_SA(0, 1), a2 + hstep, voffA);
            PG8_WAIT_L(8); PG8_BAR; PG8_WAIT_L(0); PG8_MMA(0, 0, At, B0); PG8_BAR; PG8_SCHED;
            PG8_LDB(B1, 1, 1); PG8_STAGE(PG8_SB(1, 0), b3, voffB);
            PG8_BAR; PG8_WAIT_L(0); PG8_MMA(0, 1, At, B1); PG8_BAR;
            PG8_LDA(At, 1, 1); PG8_STAGE(PG8_SA(1, 0), a3, voffA);
            PG8_BAR; PG8_WAIT_L(0); PG8_MMA(1, 0, At, B0); PG8_BAR; PG8_SCHED;
            PG8_STAGE(PG8_SB(1, 1), b3 + hstep, voffB);
            PG8_WAIT_V(6); PG8_BAR; PG8_MMA(1, 1, At, B1); PG8_BAR;
            }
        }
        if constexpr (ALIGN_EPI) { if (wr == 0) PG8_BAR; }
        if constexpr (!Epi::AFTER_DRAIN) { E(acc, cur, wr, wc, fr, fq); S.done(cur); }
        if (!has_next) break;
#pragma unroll
        for (int a = 0; a < 2; ++a)
#pragma unroll
            for (int b = 0; b < 2; ++b)
#pragma unroll
                for (int m = 0; m < 4; ++m)
#pragma unroll
                    for (int n = 0; n < 2; ++n) acc[a][b][m][n] = (f32x4){0.f, 0.f, 0.f, 0.f};
        cur = nxt; cA = nA; cB = nB; ++ui;
        if constexpr (ALIGN_EPI) { if (wr == 1) PG8_BAR; }
    }
    PG8_WAIT_V(0);
    if constexpr (!ALIGN_EPI) { if (wr == 0) PG8_BAR; }
    PG8_BAR;
    if constexpr (Epi::AFTER_DRAIN) { E.fused(acc, cur, wr, wc, fr, fq, lds, wid, lane); S.done(cur); }
#undef PG8_SA
#undef PG8_SB
#undef PG8_STAGE
#undef PG8_LDA
#undef PG8_LDB
#undef PG8_MMA
#undef PG8_WAIT_V
#undef PG8_WAIT_L
#undef PG8_BAR
#undef PG8_SCHED
}
typedef int i32x4 __attribute__((ext_vector_type(4)));
template <class Epi, class Sched, bool ALIGN_EPI = false, bool SP2 = false>
__device__ __forceinline__ void gemm_phase_i8(PG8_LAS unsigned char* lds, const Gemm g, const Sched& S, const Epi& E) {
    int tid_ = (int)threadIdx.x; asm volatile("" : "+v"(tid_));
    const int tid = tid_, wid = __builtin_amdgcn_readfirstlane(tid >> 6), lane = tid & 63, wr = wid >> 2, wc = wid & 3, fr = lane & 15, fq = lane >> 4;
    const int K = g.K, nt = K / BK;
    unsigned voffA[2], voffB[2];
#pragma unroll
    for (int i = 0; i < 2; ++i) { int R, C; stage_rc(tid * 16 + i * 8192, R, C); const int Rb = Epi::PERM ? ((R & ~31) + perm32(R & 31)) : R;
        voffA[i] = (unsigned)(R * K + C) * 2u; voffB[i] = (unsigned)(Rb * K + C) * 2u; }
    const size_t kstep = (size_t)(BK * 2);
    const size_t hstep = (size_t)HALF * K * 2;
    const size_t tstep = 2 * hstep;
    const unsigned ldsw = (unsigned)wid * 1024u;
    const int aoff = lds_byte(wr * 64 + fr, fq * 8), boff = lds_byte(wc * 32 + fr, fq * 8);
#define PG8_SA(b, h) (((b) * 2 + (h)) * HTB)
#define PG8_SB(b, h) ((4 + (b) * 2 + (h)) * HTB)
#define PG8_STAGE(bufoff, gbase, voff) do { _Pragma("unroll") for (int _i = 0; _i < 2; ++_i) \
        __builtin_amdgcn_global_load_lds((const unsigned*)((const char*)(gbase) + (voff)[_i]), (PG8_LAS unsigned*)(lds + (bufoff) + ldsw + _i * 8192), 16, 0, 0); } while (0)
#define PG8_LDA(dst, b, h) do { _Pragma("unroll") for (int m = 0; m < 4; ++m) _Pragma("unroll") for (int k = 0; k < 2; ++k) dst[m][k] = *(const PG8_LAS bf16x8*)(lds + PG8_SA(b, h) + aoff + m * 2048 + k * 1024); } while (0)
#define PG8_LDB(dst, b, h) do { _Pragma("unroll") for (int n = 0; n < 2; ++n) _Pragma("unroll") for (int k = 0; k < 2; ++k) dst[n][k] = *(const PG8_LAS bf16x8*)(lds + PG8_SB(b, h) + boff + n * 2048 + k * 1024); } while (0)
#define PG8_MMA(ai, bj, At, Bt) do { __builtin_amdgcn_s_setprio(1); _Pragma("unroll") for (int m = 0; m < 4; ++m) _Pragma("unroll") for (int n = 0; n < 2; ++n) _Pragma("unroll") for (int k = 0; k < 2; ++k) \
        acc[ai][bj][m][n] = __builtin_amdgcn_mfma_i32_16x16x64_i8(__builtin_bit_cast(i32x4, Bt[n][k]), __builtin_bit_cast(i32x4, At[m][k]), acc[ai][bj][m][n], 0, 0, 0); __builtin_amdgcn_s_setprio(0); } while (0)
#define PG8_WAIT_V(n) asm volatile("s_waitcnt vmcnt(" #n ")" ::: "memory")
#define PG8_WAIT_L(n) asm volatile("s_waitcnt lgkmcnt(" #n ")" ::: "memory")
#define PG8_BAR __builtin_amdgcn_s_barrier()
#define PG8_SCHED __builtin_amdgcn_sched_barrier(0)
    Unit cur, nxt; int ui = 0;
    if (!S.next(0, cur)) return;
    i32x4 acc[2][2][4][2];
#pragma unroll
    for (int a = 0; a < 2; ++a)
#pragma unroll
        for (int b = 0; b < 2; ++b)
#pragma unroll
            for (int m = 0; m < 4; ++m)
#pragma unroll
                for (int n = 0; n < 2; ++n) acc[a][b][m][n] = (i32x4){0, 0, 0, 0};
    bf16x8 At[4][2], B0[2][2], B1[2][2];
    const char* cA = (const char*)g.A + (size_t)cur.pm * tstep; const char* cB = (const char*)g.Bt + (size_t)cur.pn * tstep;
    S.a_ready(cur);
    if constexpr (SP2) {
        PG8_STAGE(PG8_SB(0, 0), cB, voffB); PG8_STAGE(PG8_SB(0, 1), cB + hstep, voffB); PG8_STAGE(PG8_SA(0, 0), cA, voffA); PG8_STAGE(PG8_SA(0, 1), cA + hstep, voffA);
        if (wr == 1) PG8_BAR;
        PG8_WAIT_V(2); PG8_BAR;
        PG8_STAGE(PG8_SB(1, 0), cB + kstep, voffB); PG8_STAGE(PG8_SA(1, 0), cA + kstep, voffA); PG8_STAGE(PG8_SB(1, 1), cB + hstep + kstep, voffB);
        PG8_WAIT_V(6); PG8_BAR;
    } else {
        PG8_STAGE(PG8_SB(0, 0), cB, voffB); PG8_STAGE(PG8_SA(0, 0), cA, voffA); PG8_STAGE(PG8_SB(0, 1), cB + hstep, voffB); PG8_STAGE(PG8_SA(0, 1), cA + hstep, voffA);
        if (wr == 1) PG8_BAR;
        PG8_WAIT_V(4); PG8_BAR;
        PG8_STAGE(PG8_SB(1, 0), cB + kstep, voffB); PG8_STAGE(PG8_SA(1, 0), cA + kstep, voffA); PG8_STAGE(PG8_SB(1, 1), cB + hstep + kstep, voffB);
        PG8_WAIT_V(6); PG8_BAR;
    }
    for (;;) {
        const bool has_next = S.next(ui + 1, nxt);
        const char* nA = has_next ? (const char*)g.A + (size_t)nxt.pm * tstep : cA; const char* nB = has_next ? (const char*)g.Bt + (size_t)nxt.pn * tstep : cB;
        for (int t = 0; t < nt; t += 2) {
            const bool last = (t == nt - 2);
            const char* a1 = cA + (size_t)(t + 1) * kstep;
            const char* a2 = last ? nA : cA + (size_t)(t + 2) * kstep; const char* b2 = last ? nB : cB + (size_t)(t + 2) * kstep;
            const char* a3 = a2 + kstep; const char* b3 = b2 + kstep;
            if (last && has_next) S.a_ready(nxt);
            if constexpr (SP2) {
            PG8_LDB(B0, 0, 0); PG8_LDB(B1, 0, 1); PG8_SCHED; PG8_LDA(At, 0, 0); PG8_STAGE(PG8_SA(1, 1), a1 + hstep, voffA);
            PG8_WAIT_V(8); PG8_WAIT_L(0); PG8_BAR; PG8_MMA(0, 0, At, B0); PG8_MMA(0, 1, At, B1); PG8_BAR; PG8_SCHED;
            PG8_LDA(At, 0, 1); PG8_STAGE(PG8_SB(0, 0), b2, voffB); PG8_STAGE(PG8_SB(0, 1), b2 + hstep, voffB); PG8_STAGE(PG8_SA(0, 0), a2, voffA);
            PG8_WAIT_V(8); PG8_WAIT_L(0); PG8_BAR; PG8_MMA(1, 0, At, B0); PG8_MMA(1, 1, At, B1); PG8_BAR; PG8_SCHED;
            PG8_LDB(B0, 1, 0); PG8_LDB(B1, 1, 1); PG8_SCHED; PG8_LDA(At, 1, 0); PG8_STAGE(PG8_SA(0, 1), a2 + hstep, voffA);
            PG8_WAIT_V(8); PG8_WAIT_L(0); PG8_BAR; PG8_MMA(0, 0, At, B0); PG8_MMA(0, 1, At, B1); PG8_BAR; PG8_SCHED;
            PG8_LDA(At, 1, 1); PG8_STAGE(PG8_SB(1, 0), b3, voffB); PG8_STAGE(PG8_SB(1, 1), b3 + hstep, voffB); PG8_STAGE(PG8_SA(1, 0), a3, voffA);
            PG8_WAIT_V(8); PG8_WAIT_L(0); PG8_BAR; PG8_MMA(1, 0, At, B0); PG8_MMA(1, 1, At, B1); PG8_BAR; PG8_SCHED;
            } else {
            PG8_LDB(B0, 0, 0); PG8_SCHED; PG8_LDA(At, 0, 0); PG8_STAGE(PG8_SA(1, 1), a1 + hstep, voffA);
            PG8_WAIT_L(8); PG8_BAR; PG8_WAIT_L(0); PG8_MMA(0, 0, At, B0); PG8_BAR; PG8_SCHED;
            PG8_LDB(B1, 0, 1); PG8_STAGE(PG8_SB(0, 0), b2, voffB);
            PG8_BAR; PG8_WAIT_L(0); PG8_MMA(0, 1, At, B1); PG8_BAR;
            PG8_LDA(At, 0, 1); PG8_STAGE(PG8_SA(0, 0), a2, voffA);
            PG8_BAR; PG8_WAIT_L(0); PG8_MMA(1, 0, At, B0); PG8_BAR; PG8_SCHED;
            PG8_STAGE(PG8_SB(0, 1), b2 + hstep, voffB);
            PG8_WAIT_V(6); PG8_BAR; PG8_MMA(1, 1, At, B1); PG8_BAR;
            PG8_LDB(B0, 1, 0); PG8_SCHED; PG8_LDA(At, 1, 0); PG8_STAGE(PG8_SA(0, 1), a2 + hstep, voffA);
            PG8_WAIT_L(8); PG8_BAR; PG8_WAIT_L(0); PG8_MMA(0, 0, At, B0); PG8_BAR; PG8_SCHED;
            PG8_LDB(B1, 1, 1); PG8_STAGE(PG8_SB(1, 0), b3, voffB);
            PG8_BAR; PG8_WAIT_L(0); PG8_MMA(0, 1, At, B1); PG8_BAR;
            PG8_LDA(At, 1, 1); PG8_STAGE(PG8_SA(1, 0), a3, voffA);
            PG8_BAR; PG8_WAIT_L(0); PG8_MMA(1, 0, At, B0); PG8_BAR; PG8_SCHED;
            PG8_STAGE(PG8_SB(1, 1), b3 + hstep, voffB);
            PG8_WAIT_V(6); PG8_BAR; PG8_MMA(1, 1, At, B1); PG8_BAR;
            }
        }
        if constexpr (ALIGN_EPI) { if (wr == 0) PG8_BAR; }
        if constexpr (!Epi::AFTER_DRAIN) { E(acc, cur, wr, wc, fr, fq); S.done(cur); }
        if (!has_next) break;
#pragma unroll
        for (int a = 0; a < 2; ++a)
#pragma unroll
            for (int b = 0; b < 2; ++b)
#pragma unroll
                for (int m = 0; m < 4; ++m)
#pragma unroll
                    for (int n = 0; n < 2; ++n) acc[a][b][m][n] = (i32x4){0, 0, 0, 0};
        cur = nxt; cA = nA; cB = nB; ++ui;
        if constexpr (ALIGN_EPI) { if (wr == 1) PG8_BAR; }
    }
    PG8_WAIT_V(0);
    if constexpr (!ALIGN_EPI) { if (wr == 0) PG8_BAR; }
    PG8_BAR;
    if constexpr (Epi::AFTER_DRAIN) { E.fused(acc, cur, wr, wc, fr, fq, lds, wid, lane); S.done(cur); }
#undef PG8_SA
#undef PG8_SB
#undef PG8_STAGE
#undef PG8_LDA
#undef PG8_LDB
#undef PG8_MMA
#undef PG8_WAIT_V
#undef PG8_WAIT_L
#undef PG8_BAR
#undef PG8_SCHED
}
}

struct ProjOut { const float* rs1; const float* lbl; const float* ffb; bf16_t *QH, *LF, *VH, *GH, *FQ, *FK, *FV, *SGA, *SGB; float* LFF; };
DI float rs2_of(const float* SSQ, int row) {
    const f32x4* p = (const f32x4*)(SSQ + (size_t)row * 16); const f32x4 a = p[0], b = p[1], c = p[2], d = p[3];
    const float s = ((a[0] + a[1]) + (a[2] + a[3])) + ((b[0] + b[1]) + (b[2] + b[3])) + ((c[0] + c[1]) + (c[2] + c[3])) + ((d[0] + d[1]) + (d[2] + d[3]));
    return 1.0f / sqrtf(s * (1.0f / kD) + kEps);
}
constexpr int HG_TSTR = 144;
constexpr int HG_KSTR = 272;
DI void hg_load_vt(const bf16_t* VHc  , LAS unsigned char* vt) {
    const int tid = VTID, s = tid & 63, vq = tid >> 6;
#pragma unroll
    for (int i = 0; i < 4; ++i) {
        const int vc = 8 * (vq + 4 * i);
        const uint4 u = *(const uint4*)(VHc + (size_t)s * 512 + vc);
        const unsigned w[4] = {u.x, u.y, u.z, u.w};
#pragma unroll
        for (int j = 0; j < 4; ++j) {
            *(LAS unsigned short*)(vt + (vc + 2 * j) * HG_TSTR + s * 2) = (unsigned short)(w[j] & 0xffffu);
            *(LAS unsigned short*)(vt + (vc + 2 * j + 1) * HG_TSTR + s * 2) = (unsigned short)(w[j] >> 16);
        }
    }
}
DI void ph_hgrn1(const bf16_t* LF, const bf16_t* VH, bf16_t* ST, float* DC, int bid, int nblk, LAS unsigned char* lds) {
    LAS unsigned char* klt = lds;
    LAS unsigned char* vt = lds + 128 * HG_TSTR;
    LAS float* tot = (LAS float*)(lds + 256 * HG_TSTR);
    const int tid = VTID, k = tid & 127, half = tid >> 7; const LaneId li = lane_id();
    for (int ib = 0; ib < 2048; ib += nblk) {
        const int item = ib + bid;
        const int c = item & 63, bh = item >> 6, b = bh >> 2, h = bh & 3;
        const size_t rowbase = (size_t)(b * kS + c * 64) * 512 + h * 128;
        __syncthreads();
        float lf[32], cum[32];
        { float run = 0.f;
#pragma unroll
          for (int i = 0; i < 32; ++i) { lf[i] = bf2f(LF[rowbase + (size_t)(32 * half + i) * 512 + k]); run += lf[i]; cum[i] = run; }
          tot[half * 128 + k] = run; }
        hg_load_vt(VH + rowbase, vt);
        __syncthreads();
        {
            const float t0 = tot[k], t1 = tot[128 + k], r4 = t0 + t1, base = half ? t0 : 0.f;
            unsigned w[16];
#pragma unroll
            for (int i = 0; i < 32; i += 2) {
                const float a0 = (1.f - __builtin_amdgcn_exp2f(lf[i])) * __builtin_amdgcn_exp2f(r4 - (base + cum[i]));
                const float a1 = (1.f - __builtin_amdgcn_exp2f(lf[i + 1])) * __builtin_amdgcn_exp2f(r4 - (base + cum[i + 1]));
                w[i >> 1] = cvtpk(a0, a1);
            }
#pragma unroll
            for (int i = 0; i < 4; ++i) *(LAS u32x4*)(klt + k * HG_TSTR + half * 64 + i * 16) = (u32x4){w[4 * i], w[4 * i + 1], w[4 * i + 2], w[4 * i + 3]};
            if (half == 0) DC[(size_t)item * 128 + k] = __builtin_amdgcn_exp2f(r4);
        }
        __syncthreads();
        f32x4 acc[4][4]; acc_zero(acc);
#pragma unroll
        for (int ks = 0; ks < 2; ++ks) {
            bf16x8 af[4], bfr[4];
#pragma unroll
            for (int m = 0; m < 4; ++m) af[m] = *(const LAS bf16x8*)(vt + (li.wr * 64 + m * 16 + li.fr) * HG_TSTR + ks * 64 + li.fq * 16);
#pragma unroll
            for (int n = 0; n < 4; ++n) bfr[n] = *(const LAS bf16x8*)(klt + (li.wc * 64 + n * 16 + li.fr) * HG_TSTR + ks * 64 + li.fq * 16);
#pragma unroll
            for (int m = 0; m < 4; ++m)
#pragma unroll
                for (int n = 0; n < 4; ++n) acc[m][n] = __builtin_amdgcn_mfma_f32_16x16x32_bf16(bfr[n], af[m], acc[m][n], 0, 0, 0);
        }
        bf16_t* dst = ST + (size_t)item * 16384;
#pragma unroll
        for (int m = 0; m < 4; ++m)
#pragma unroll
            for (int n = 0; n < 4; ++n) store_bf4(dst + (li.wr * 64 + m * 16 + li.fr) * 128 + li.wc * 64 + n * 16 + li.fq * 4, acc[m][n]);
    }
}
DI void ph_hgrn2(bf16_t* ST, const float* DC, int bid, int nblk) {
    for (int u = bid * 256 + VTID; u < 32 * 2048; u += nblk * 256) {
        const int bh = u >> 11, vk = u & 2047, k8 = (vk & 15) * 8;
        float S[8];
#pragma unroll
        for (int j = 0; j < 8; ++j) S[j] = 0.f;
        bf16_t* p = ST + (size_t)bh * 64 * 16384 + (size_t)vk * 8;
        const float* d = DC + (size_t)bh * 64 * 128 + k8;
#pragma unroll 8
        for (int c = 0; c < 64; ++c) {
            const uint4 lt = *(const uint4*)(p + (size_t)c * 16384);
            const float4 d0 = *(const float4*)(d + c * 128), d1 = *(const float4*)(d + c * 128 + 4);
            *(uint4*)(p + (size_t)c * 16384) = make_uint4(cvtpk(S[0], S[1]), cvtpk(S[2], S[3]), cvtpk(S[4], S[5]), cvtpk(S[6], S[7]));
            const float dd[8] = {d0.x, d0.y, d0.z, d0.w, d1.x, d1.y, d1.z, d1.w};
            const unsigned lw[4] = {lt.x, lt.y, lt.z, lt.w};
#pragma unroll
            for (int j = 0; j < 4; ++j) { S[2 * j] = dd[2 * j] * S[2 * j] + __uint_as_float(lw[j] << 16); S[2 * j + 1] = dd[2 * j + 1] * S[2 * j + 1] + __uint_as_float(lw[j] & 0xffff0000u); }
        }
    }
}
DI bf16x8 hg_scale_frag(bf16x8 q, const LAS float* ra, const LAS float* rb  ) {
    const f32x4 a0 = *(const LAS f32x4*)ra, a1 = *(const LAS f32x4*)(ra + 4);
    f32x4 b0 = (f32x4){0.f, 0.f, 0.f, 0.f}, b1 = b0;
    if (rb) { b0 = *(const LAS f32x4*)rb; b1 = *(const LAS f32x4*)(rb + 4); }
    const u32x4 u = __builtin_bit_cast(u32x4, q);
    unsigned w[4];
#pragma unroll
    for (int j = 0; j < 4; ++j) {
        const float ea = (j < 2) ? a0[2 * j] - b0[2 * j] : a1[2 * j - 4] - b1[2 * j - 4];
        const float eb = (j < 2) ? a0[2 * j + 1] - b0[2 * j + 1] : a1[2 * j - 3] - b1[2 * j - 3];
        w[j] = cvtpk(__uint_as_float(u[j] << 16) * __builtin_amdgcn_exp2f(ea), __uint_as_float(u[j] & 0xffff0000u) * __builtin_amdgcn_exp2f(eb));
    }
    return __builtin_bit_cast(bf16x8, (u32x4){w[0], w[1], w[2], w[3]});
}
constexpr int HG3_QH = 0, HG3_KE = 64 * HG_KSTR, HG3_VT = 128 * HG_KSTR, HG3_AM = HG3_VT + 128 * HG_TSTR, HG3_R = HG3_AM + 64 * HG_TSTR, HG3_TOT = HG3_R + 5 * 512, HG3_BYTES = HG3_TOT + 1024;
DI void ph_hgrn3(const bf16_t* QH, const bf16_t* LF, const bf16_t* VH, const bf16_t* GH, const bf16_t* ST, const float* normw, bf16_t* Aout, int bid, int nblk, LAS unsigned char* lds) {
    LAS unsigned char* qh = lds + HG3_QH; LAS unsigned char* ke = lds + HG3_KE; LAS unsigned char* vt = lds + HG3_VT; LAS unsigned char* am = lds + HG3_AM;
    LAS float* R = (LAS float*)(lds + HG3_R); LAS float* tot = (LAS float*)(lds + HG3_TOT);
    const int tid = VTID, k = tid & 127, half = tid >> 7, lane = tid & 63, I = tid >> 6, fr = lane & 15, fq = lane >> 4;
    for (int ib = 0; ib < 2048; ib += nblk) {
        const int item = ib + bid;
        const int c = item & 63, bh = item >> 6, b = bh >> 2, h = bh & 3;
        const size_t rowbase = (size_t)(b * kS + c * 64) * 512 + h * 128;
        uint4 stg[8];
#pragma unroll
        for (int i = 0; i < 8; ++i) stg[i] = *(const uint4*)(ST + (size_t)item * 16384 + (size_t)(tid + 256 * i) * 8);
        __syncthreads();
        float lf[32], cum[32];
        { float run = 0.f;
#pragma unroll
          for (int i = 0; i < 32; ++i) { lf[i] = bf2f(LF[rowbase + (size_t)(32 * half + i) * 512 + k]); run += lf[i]; cum[i] = run; }
          tot[half * 128 + k] = run; }
        hg_load_vt(VH + rowbase, vt);
        __syncthreads();
        {
            const float t0 = tot[k], base = half ? t0 : 0.f;
            const float rmid = base + cum[15], rend = base + cum[31];
            if (half == 0) { R[k] = 0.f; R[128 + k] = rmid; R[256 + k] = rend; } else { R[384 + k] = rmid; R[512 + k] = rend; }
#pragma unroll
            for (int i = 0; i < 32; ++i) {
                const float cf_ = base + cum[i], rI = (i < 16) ? base : rmid, rI1 = (i < 16) ? rmid : rend;
                const float qv = bf2f(QH[rowbase + (size_t)(32 * half + i) * 512 + k]);
                const float qhv = qv * __builtin_amdgcn_exp2f(cf_ - rI);
                const float kev = (1.f - __builtin_amdgcn_exp2f(lf[i])) * __builtin_amdgcn_exp2f(rI1 - cf_);
                *(LAS unsigned short*)(qh + (32 * half + i) * HG_KSTR + k * 2) = (unsigned short)(cvtpk(qhv, 0.f) & 0xffffu);
                *(LAS unsigned short*)(ke + (32 * half + i) * HG_KSTR + k * 2) = (unsigned short)(cvtpk(kev, 0.f) & 0xffffu);
            }
        }
        __syncthreads();
        bf16x8 qf[4];
#pragma unroll
        for (int ks = 0; ks < 4; ++ks) qf[ks] = *(const LAS bf16x8*)(qh + (16 * I + fr) * HG_KSTR + ks * 64 + fq * 16);
        for (int J = 0; J <= I; ++J) {
            f32x4 d = (f32x4){0.f, 0.f, 0.f, 0.f};
#pragma unroll
            for (int ks = 0; ks < 4; ++ks) {
                const bf16x8 kf = *(const LAS bf16x8*)(ke + (16 * J + fr) * HG_KSTR + ks * 64 + fq * 16);
                const bf16x8 qs = (J == I - 1) ? qf[ks] : hg_scale_frag(qf[ks], R + I * 128 + ks * 32 + fq * 8, R + (J + 1) * 128 + ks * 32 + fq * 8);
                d = __builtin_amdgcn_mfma_f32_16x16x32_bf16(kf, qs, d, 0, 0, 0);
            }
            if (J == I) {
#pragma unroll
                for (int j = 0; j < 4; ++j) if (4 * fq + j > fr) d[j] = 0.f;
            }
            *(LAS u32x2*)(am + (16 * I + fr) * HG_TSTR + (16 * J + 4 * fq) * 2) = (u32x2){cvtpk(d[0], d[1]), cvtpk(d[2], d[3])};
        }
        if ((I & 1) == 0) *(LAS u32x2*)(am + (16 * I + fr) * HG_TSTR + (16 * (I + 1) + 4 * fq) * 2) = (u32x2){0u, 0u};
        f32x4 o[8];
#pragma unroll
        for (int n = 0; n < 8; ++n) o[n] = (f32x4){0.f, 0.f, 0.f, 0.f};
        for (int ks = 0; ks <= (I >> 1); ++ks) {
            const bf16x8 af = *(const LAS bf16x8*)(am + (16 * I + fr) * HG_TSTR + ks * 64 + fq * 16);
#pragma unroll
            for (int n = 0; n < 8; ++n) { const bf16x8 vf = *(const LAS bf16x8*)(vt + (n * 16 + fr) * HG_TSTR + ks * 64 + fq * 16); o[n] = __builtin_amdgcn_mfma_f32_16x16x32_bf16(vf, af, o[n], 0, 0, 0); }
        }
        __syncthreads();
#pragma unroll
        for (int i = 0; i < 8; ++i) { const int pc = tid + 256 * i, row = pc >> 4, ch = pc & 15;
            *(LAS u32x4*)(lds + HG3_QH + row * 256 + ((ch ^ (row & 15)) << 4)) = (u32x4){stg[i].x, stg[i].y, stg[i].z, stg[i].w}; }
        __syncthreads();
#pragma unroll
        for (int ks = 0; ks < 4; ++ks) {
            const bf16x8 qc = hg_scale_frag(qf[ks], R + I * 128 + ks * 32 + fq * 8, nullptr);
#pragma unroll
            for (int n = 0; n < 8; ++n) { const bf16x8 sf = *(const LAS bf16x8*)(lds + HG3_QH + (n * 16 + fr) * 256 + (((ks * 4 + fq) ^ fr) << 4)); o[n] = __builtin_amdgcn_mfma_f32_16x16x32_bf16(sf, qc, o[n], 0, 0, 0); }
        }
        float ss = 0.f;
#pragma unroll
        for (int n = 0; n < 8; ++n) ss += o[n][0] * o[n][0] + o[n][1] * o[n][1] + o[n][2] * o[n][2] + o[n][3] * o[n][3];
        ss += __shfl_xor(ss, 16); ss += __shfl_xor(ss, 32);
        const float rstd = 1.0f / sqrtf(ss * (1.0f / 128.f) + kEps);
        const size_t orow = rowbase + (size_t)(16 * I + fr) * 512;
#pragma unroll
        for (int n = 0; n < 8; ++n) {
            const int v0 = n * 16 + 4 * fq;
            const f32x4 g = load_bf4(GH + orow + v0); const f32x4 w = *(const f32x4*)(normw + h * 128 + v0);
            store_bf4(Aout + orow + v0, o[n] * rstd * w * g);
        }
    }
}

DI void ph_cfox(const float* LFF, float* cf, bf16_t* aug, int bid, int nblk, float* sm) {
    const int tid = VTID, lane = tid & 63, wid = tid >> 6;
    for (int seq = bid; seq < 64; seq += nblk) {
        const int b = seq >> 3, h = seq & 7;
        float v[16]; float run = 0.f;
#pragma unroll
        for (int i = 0; i < 16; ++i) { run += LFF[(size_t)(b * kS + tid * 16 + i) * 8 + h]; v[i] = run; }
        float inc = run;
#pragma unroll
        for (int o = 1; o < 64; o <<= 1) { const float n = __shfl_up(inc, o); if (lane >= o) inc += n; }
        __syncthreads();
        if (lane == 63) sm[wid] = inc;
        __syncthreads();
        float base = inc - run;
        for (int w = 0; w < wid; ++w) base += sm[w];
#pragma unroll
        for (int i = 0; i < 16; i += 4) *(float4*)(cf + (size_t)seq * kS + tid * 16 + i) = make_float4(base + v[i], base + v[i + 1], base + v[i + 2], base + v[i + 3]);
#pragma unroll
        for (int i = 0; i < 16; ++i) {
            const float xx = -(base + v[i]); const unsigned b1 = cvtpk(xx, 0.f) & 0xffffu; const float r1 = xx - __uint_as_float(b1 << 16);
            const unsigned b2 = cvtpk(r1, 0.f) & 0xffffu; const float r2 = r1 - __uint_as_float(b2 << 16); const unsigned b3 = cvtpk(r2, 0.f) & 0xffffu;
            *(uint4*)(aug + ((size_t)seq * kS + tid * 16 + i) * 8) = make_uint4(b1 | (b2 << 16), b3 | 0xBF800000u, 0xBF80BF80u, 0u);
        }
    }
}
DI float max3f(float a, float b, float c) { float r; asm("v_max3_f32 %0, %1, %2, %3" : "=v"(r) : "v"(a), "v"(b), "v"(c)); return r; }
DI float max2f(float a, float b) { float r; asm("v_max_f32_e32 %0, %1, %2" : "=v"(r) : "v"(a), "v"(b)); return r; }
typedef float f32x16 __attribute__((ext_vector_type(16)));
typedef short s16x4 __attribute__((ext_vector_type(4)));
namespace at64 {
using bf16 = bf16_t;
constexpr int SEQ = kS, NHEAD = 8, D = 64, DM = NHEAD * D;
constexpr int NW = 8, QBLK = 32, QB = QBLK * NW, KVBLK = 64, NQB = SEQ / QB;
constexpr float C2 = 1.0f;
constexpr int SLOTB = 8192, LDS_K = 0, LDS_V = 3 * SLOTB, LDS_WS = 6 * SLOTB, LDS_OST = LDS_WS + NW * 256, LDS_AUG = LDS_OST + NW * 4096, LDS_BYTES = LDS_AUG + SEQ * 16;
#define ATTN64_THR 8
#define ATTN64_BROKEN 0
#define SBAR() __builtin_amdgcn_sched_barrier(0)
#define PIN(x) asm volatile("" : "+v"(x))
#define MFMA(a, b, c) __builtin_amdgcn_mfma_f32_32x32x16_bf16(a, b, c, 0, 0, 0)
#define WAIT_BAR(N) asm volatile("s_waitcnt vmcnt(" #N ") lgkmcnt(0)\n\ts_barrier" ::: "memory")

__device__ __forceinline__ int crow(int r, int hi) { return (r & 3) + 8 * (r >> 2) + 4 * hi; }
__device__ __forceinline__ unsigned cvtpk(float lo, float hi) { unsigned r; asm("v_cvt_pk_bf16_f32 %0, %1, %2" : "=v"(r) : "v"(lo), "v"(hi)); return r; }
__device__ __forceinline__ void glds16(const void* sbase, unsigned voff, unsigned lds_base) {
    unsigned sv; asm volatile("s_mov_b32 %0, m0\n\ts_mov_b32 m0, %3\n\ts_nop 0\n\tglobal_load_lds_dwordx4 %1, %2\n\ts_mov_b32 m0, %0" : "=&s"(sv) : "v"(voff), "s"(sbase), "s"(lds_base) : "memory"); }
typedef __attribute__((address_space(3))) const char* lds_cptr;
typedef short v4i16_t __attribute__((ext_vector_type(4)));
__device__ __forceinline__ void kload2(bf16x8* kf, lds_cptr kp, int d0) { kf[2 * d0] = *(const __attribute__((address_space(3))) bf16x8*)(kp + d0 * 2048); kf[2 * d0 + 1] = *(const __attribute__((address_space(3))) bf16x8*)(kp + d0 * 2048 + 512); }
__device__ __forceinline__ s16x4 vtr(lds_cptr p) { return __builtin_bit_cast(s16x4, __builtin_amdgcn_ds_read_tr16_b64_v4i16((__attribute__((address_space(3))) v4i16_t*)p)); }
#define MX3(a, b, c) __builtin_fmaxf(__builtin_fmaxf((a), (b)), (c))
__device__ __forceinline__ float rowmax(const f32x16& p0, const f32x16& p1) {
    float a = MX3(p0[0], p0[1], p1[0]), b = MX3(p0[2], p0[3], p1[1]); a = MX3(a, p1[2], p1[3]);
#pragma unroll
    for (int r = 4; r < 16; r += 4) { a = MX3(a, p0[r], p0[r + 1]); b = MX3(b, p0[r + 2], p0[r + 3]); a = MX3(a, p1[r], p1[r + 1]); b = MX3(b, p1[r + 2], p1[r + 3]); }
    float m = __builtin_fmaxf(a, b); auto rr = __builtin_amdgcn_permlane32_swap(__float_as_uint(m), __float_as_uint(m), false, false);
    return __builtin_fmaxf(__uint_as_float(rr[0]), __uint_as_float(rr[1])); }
__device__ __forceinline__ void cmask(f32x16& p0, f32x16& p1, int jb, int qrel, int hi) {
    const int kb = 64 * jb + 4 * hi;
#pragma unroll
    for (int r = 0; r < 16; ++r) { const int kv = kb + (r & 3) + 8 * (r >> 2); if (kv > qrel) p0[r] = -INFINITY; if (kv + 32 > qrel) p1[r] = -INFINITY; } }

__device__ __forceinline__ void attn64_unit(int b, int h, int qb, bool fill, const bf16* Q, const bf16* __restrict__ K, const bf16* __restrict__ V, const bf16* __restrict__ AUG, bf16* O, char* lds) {
    const int tid = threadIdx.x, lane = tid & 63, r32 = lane & 31, hi = lane >> 5; const int wid = __builtin_amdgcn_readfirstlane(tid >> 6);
    const long rowbase = (long)b * SEQ; const int q0 = qb * QB, NT = (q0 + QB) / KVBLK;
    const bf16* Qw = Q + (rowbase + q0 + wid * QBLK) * DM + h * D;
    const unsigned lds0 = (unsigned)(uintptr_t)lds; float* wsf = (float*)(lds + LDS_WS) + wid * 64;
    if (fill) { const char* ag = (const char*)(AUG + ((long)(b * NHEAD + h) * SEQ) * 8); const int nby = (q0 + QB) * 16;
      for (int of = tid * 16; of < nby; of += 64 * NW * 16) *(__attribute__((address_space(3))) u32x4*)((lds_cptr)lds + LDS_AUG + of) = *(const u32x4*)(ag + of); }
    const lds_cptr augp = (lds_cptr)lds + LDS_AUG + r32 * 16;
    bf16x8 qaug = __builtin_bit_cast(bf16x8, (u32x4){hi == 0 ? 0x3F803F80u : 0u, hi == 0 ? 0x00003F80u : 0u, 0u, 0u});
    float mf = 0.f;
#define SETQ() do { const unsigned m1_ = cvtpk(mf, 0.f) & 0xffffu; const float r1_ = mf - __uint_as_float(m1_ << 16); const unsigned m2_ = cvtpk(r1_, 0.f) & 0xffffu; \
        const float r2_ = r1_ - __uint_as_float(m2_ << 16); const unsigned m3_ = cvtpk(r2_, 0.f) & 0xffffu; \
        qaug = __builtin_bit_cast(bf16x8, (u32x4){hi == 0 ? 0x3F803F80u : 0u, hi == 0 ? (0x3F80u | (m1_ << 16)) : 0u, hi == 0 ? (m2_ | (m3_ << 16)) : 0u, 0u}); } while (0)
    bf16x8 ka0, ka1;
#define KAR(st) do { ka0 = *(const __attribute__((address_space(3))) bf16x8*)(augp + (NT - 1 - (st)) * 1024); ka1 = *(const __attribute__((address_space(3))) bf16x8*)(augp + (NT - 1 - (st)) * 1024 + 512); } while (0)
#define KAF(v) (v)
    const bf16* kbase = K + rowbase * DM + h * D + wid * 8; const unsigned koff = (unsigned)lane * (DM * 2);
    const bf16* vbase = V + rowbase * DM + h * D + (long)(16 * (wid & 3)) * DM + (wid >> 2) * 32; const unsigned voff = (unsigned)((lane >> 2) * (DM * 2) + (lane & 3) * 16);
    const unsigned kdst = lds0 + LDS_K + wid * 1024, vdst = lds0 + LDS_V + wid * 1024;
#define DMA_K(t, slot) glds16(kbase + (long)(NT - 1 - (t)) * KVBLK * DM, koff, (unsigned)__builtin_amdgcn_readfirstlane(kdst + (slot)))
#define DMA_V(t, slot) glds16(vbase + (long)(NT - 1 - (t)) * KVBLK * DM, voff, (unsigned)__builtin_amdgcn_readfirstlane(vdst + (slot)))
    const lds_cptr vp0 = (lds_cptr)lds + LDS_V + ((lane >> 4) & 1) * 32 + (lane & 3) * 8 + (4 * hi + ((lane & 15) >> 2)) * 64;
    const lds_cptr kp0 = (lds_cptr)lds + LDS_K + hi * 1024 + r32 * 16;
    DMA_K(0, 0); DMA_V(0, 0); DMA_K(1, SLOTB);
    bf16x8 qr[4];
#pragma unroll
    for (int d0 = 0; d0 < 4; ++d0) qr[d0] = *reinterpret_cast<const bf16x8*>(&Qw[(long)r32 * DM + d0 * 16 + hi * 8]);
    float mhat = 0.f, l_reg = 0.f; f32x16 o[2]; o[0] = f32x16{}; o[1] = f32x16{};
    const f32x16 zero16 = f32x16{};
    const int qrel = wid * QBLK + r32; bool resc = false;
    f32x16 pA0, pA1, pB0, pB1; bf16x8 kf[8]; s16x4 vlo[8], vhi[8]; u32x4 pw0, pw1, pw2, pw3;
    int sl_prev = 0, sl_cur = 0, sl_next = SLOTB;
#define ROT() do { sl_prev = sl_cur; sl_cur = sl_next; sl_next = (sl_next == 2 * SLOTB) ? 0 : sl_next + SLOTB; } while (0)
#define EX0(v) __builtin_amdgcn_exp2f(__builtin_fmaf((v), C2, nmh))
#define EX(v) __builtin_amdgcn_exp2f(v)
#define RESC() do { if (resc && !ATTN64_BROKEN) { _Pragma("unroll") for (int d_ = 0; d_ < 2; ++d_) _Pragma("unroll") for (int r = 0; r < 16; ++r) o[d_][r] *= wsf[crow(r, hi)]; } } while (0)
    DMA_K(2, 2 * SLOTB);
    WAIT_BAR(3);
    _Pragma("unroll") for (int d0 = 0; d0 < 4; ++d0) kload2(kf, kp0, d0);
    pA0 = MFMA(kf[0], qr[0], zero16); pA1 = MFMA(kf[1], qr[0], zero16); pA0 = MFMA(kf[2], qr[1], pA0); pA1 = MFMA(kf[3], qr[1], pA1);
    pA0 = MFMA(kf[4], qr[2], pA0); pA1 = MFMA(kf[5], qr[2], pA1); pA0 = MFMA(kf[6], qr[3], pA0); pA1 = MFMA(kf[7], qr[3], pA1);
    KAR(0); pA0 = MFMA(KAF(ka0), qaug, pA0); pA1 = MFMA(KAF(ka1), qaug, pA1);
    cmask(pA0, pA1, 3, qrel, hi);
    { const float rm = rowmax(pA0, pA1); mhat = __builtin_fmaxf(rm, -1e30f) * C2; const float nmh = -mhat;
#pragma unroll
      for (int r = 0; r < 16; ++r) { pA0[r] = EX0(pA0[r]); pA1[r] = EX0(pA1[r]); }
      mf = (mhat < -0.5e30f) ? 0.f : mhat; SETQ(); }
    WAIT_BAR(0);
    DMA_K(3, 0); DMA_V(1, SLOTB); ROT();
    _Pragma("unroll") for (int d0 = 0; d0 < 4; ++d0) kload2(kf, kp0 + sl_cur, d0);
    WAIT_BAR(2);
#define PKW(P, i) cvtpk(P[i], P[i + 1])
#define PAF(k) __builtin_bit_cast(bf16x8, pw##k)
#define VFR(i) (bf16x8){vlo[i][0], vlo[i][1], vlo[i][2], vlo[i][3], vhi[i][0], vhi[i][1], vhi[i][2], vhi[i][3]}
#define VRD(i) do { vlo[i] = vtr(vp_ + (((i) >> 2) * 4096 + ((i) & 3) * 1024)); vhi[i] = vtr(vp_ + (((i) >> 2) * 4096 + ((i) & 3) * 1024 + 512)); } while (0)
#define KRD(G, d0) do { if (G) { kload2(kf, kp0 + sl_next, d0); SBAR(); } } while (0)
#define GAPA(MF, a0, a1, a2, a3, W0, W1, PW) do { MF; sacc += a0; sacc += a1; sacc += a2; sacc += a3; W0; W1; PIN(PW); PIN(sacc); SBAR(); } while (0)
#define GAPB(MF, X, i) do { MF; X[i] = EX(X[i]); X[i + 1] = EX(X[i + 1]); X[i + 2] = EX(X[i + 2]); X[i + 3] = EX(X[i + 3]); PIN(X); SBAR(); } while (0)
#define STEP(C0, C1, P0, P1, t, MASK, GK, GV, GL) do { SBAR(); \
    const lds_cptr vp_ = vp0 + sl_prev; \
    VRD(0); SBAR(); float sacc = P0[0] + P0[1];                                                                                                       \
                    GAPA(C0 = MFMA(kf[0], qr[0], zero16), P0[2], P0[3], P0[4], P0[5],     pw0[0] = PKW(P0, 0),  pw0[1] = PKW(P0, 2),  pw0); \
    VRD(4); SBAR(); GAPA(C1 = MFMA(kf[1], qr[0], zero16), P0[6], P0[7], P0[8], P0[9],     pw0[2] = PKW(P0, 4),  pw0[3] = PKW(P0, 6),  pw0); \
    VRD(1); SBAR(); GAPA(C0 = MFMA(kf[2], qr[1], C0),    P0[10], P0[11], P0[12], P0[13], pw1[0] = PKW(P0, 8),  pw1[1] = PKW(P0, 10), pw1); \
    VRD(5); SBAR(); GAPA(C1 = MFMA(kf[3], qr[1], C1),    P0[14], P0[15], P1[0], P1[1],   pw1[2] = PKW(P0, 12), pw1[3] = PKW(P0, 14), pw1); \
    VRD(2); SBAR(); GAPA(C0 = MFMA(kf[4], qr[2], C0),    P1[2], P1[3], P1[4], P1[5],     pw2[0] = PKW(P1, 0),  pw2[1] = PKW(P1, 2),  pw2); \
    KAR(t); SBAR();                                                                                                                                    \
    VRD(6); SBAR(); GAPA(C1 = MFMA(kf[5], qr[2], C1),    P1[6], P1[7], P1[8], P1[9],     pw2[2] = PKW(P1, 4),  pw2[3] = PKW(P1, 6),  pw2); \
    VRD(3); SBAR(); GAPA(C0 = MFMA(kf[6], qr[3], C0),    P1[10], P1[11], P1[12], P1[13], pw3[0] = PKW(P1, 8),  pw3[1] = PKW(P1, 10), pw3); \
    VRD(7); SBAR(); GAPA(C1 = MFMA(kf[7], qr[3], C1),    P1[14], P1[15], 0.f, 0.f,       pw3[2] = PKW(P1, 12), pw3[3] = PKW(P1, 14), pw3); \
    C0 = MFMA(KAF(ka0), qaug, C0); C1 = MFMA(KAF(ka1), qaug, C1); SBAR();                                                  \
    l_reg += sacc; \
    if (GK) DMA_K((t) + 3, sl_cur); if (GV) DMA_V((t) + 1, sl_next);                                                       \
    if ((t) <= 3) cmask(C0, C1, 3 - (t), qrel, hi);                                                                         \
    { const float rmx = rowmax(C0, C1), rm = rmx + (mf - mhat); resc = false;                                               \
      if (__builtin_expect(__any(rm > (float)ATTN64_THR), 0)) { const float dl = __builtin_fmaxf(rm, 0.f);                    \
          const float mnew = (mhat < -0.5e30f) ? ((dl > 0.f) ? rmx + mf : mhat) : mhat + dl; \
          const float f = __builtin_amdgcn_exp2f(-dl); l_reg *= f; if (hi == 0) wsf[r32] = f; resc = true; \
          const float mfn = (mnew < -0.5e30f) ? 0.f : mnew, adj = mfn - mf;                                                   \
          _Pragma("unroll") for (int r = 0; r < 16; ++r) { C0[r] -= adj; C1[r] -= adj; } \
          mhat = mnew; mf = mfn; SETQ(); } } \
    SBAR(); \
    GAPB(o[0] = MFMA(PAF(0), VFR(0), o[0]), C0, 0);              GAPB(o[1] = MFMA(PAF(0), VFR(4), o[1]), C0, 4); \
    KRD(GL, 0); GAPB(o[0] = MFMA(PAF(1), VFR(1), o[0]), C0, 8);  KRD(GL, 1); GAPB(o[1] = MFMA(PAF(1), VFR(5), o[1]), C0, 12);                                     \
    KRD(GL, 2); GAPB(o[0] = MFMA(PAF(2), VFR(2), o[0]), C1, 0);  KRD(GL, 3); GAPB(o[1] = MFMA(PAF(2), VFR(6), o[1]), C1, 4); \
    GAPB(o[0] = MFMA(PAF(3), VFR(3), o[0]), C1, 8);              GAPB(o[1] = MFMA(PAF(3), VFR(7), o[1]), C1, 12); \
    } while (0)
    int t = 1;
    for (; t + 5 < NT; t += 2) {
        STEP(pB0, pB1, pA0, pA1, t, false, true, true, true);     WAIT_BAR(2); RESC(); ROT();
        STEP(pA0, pA1, pB0, pB1, t + 1, false, true, true, true); WAIT_BAR(2); RESC(); ROT();
    }
#define ENDW(tt) do { if ((tt) + 3 < NT) { WAIT_BAR(2); } else if ((tt) + 2 < NT) { WAIT_BAR(1); } else { WAIT_BAR(0); } } while (0)
    for (; t + 1 < NT; t += 2) {
        STEP(pB0, pB1, pA0, pA1, t, true, (t + 3 < NT), (t + 1 < NT), (t + 1 < NT));         ENDW(t);     RESC(); ROT();
        STEP(pA0, pA1, pB0, pB1, t + 1, true, (t + 4 < NT), (t + 2 < NT), (t + 2 < NT));     ENDW(t + 1); RESC(); ROT();
    }
    STEP(pB0, pB1, pA0, pA1, NT - 1, true, false, false, false); RESC();
    { float sacc = pB0[0] + pB0[1];
#pragma unroll
      for (int r = 2; r < 16; ++r) sacc += pB0[r];
#pragma unroll
      for (int r = 0; r < 16; ++r) sacc += pB1[r];
      l_reg += sacc;
      pw0 = (u32x4){PKW(pB0, 0), PKW(pB0, 2), PKW(pB0, 4), PKW(pB0, 6)}; pw1 = (u32x4){PKW(pB0, 8), PKW(pB0, 10), PKW(pB0, 12), PKW(pB0, 14)};
      pw2 = (u32x4){PKW(pB1, 0), PKW(pB1, 2), PKW(pB1, 4), PKW(pB1, 6)}; pw3 = (u32x4){PKW(pB1, 8), PKW(pB1, 10), PKW(pB1, 12), PKW(pB1, 14)};
      const lds_cptr vp_ = vp0 + sl_cur; _Pragma("unroll") for (int i = 0; i < 8; ++i) VRD(i);
      o[0] = MFMA(PAF(0), VFR(0), o[0]); o[1] = MFMA(PAF(0), VFR(4), o[1]); o[0] = MFMA(PAF(1), VFR(1), o[0]); o[1] = MFMA(PAF(1), VFR(5), o[1]);
      o[0] = MFMA(PAF(2), VFR(2), o[0]); o[1] = MFMA(PAF(2), VFR(6), o[1]); o[0] = MFMA(PAF(3), VFR(3), o[0]); o[1] = MFMA(PAF(3), VFR(7), o[1]); }
    { auto rr = __builtin_amdgcn_permlane32_swap(__float_as_uint(l_reg), __float_as_uint(l_reg), false, false); l_reg = __uint_as_float(rr[0]) + __uint_as_float(rr[1]); }
    if (hi == 0) wsf[32 + r32] = l_reg; asm volatile("s_waitcnt lgkmcnt(0)" ::: "memory");
    float rli[16];
#pragma unroll
    for (int r = 0; r < 16; ++r) rli[r] = __builtin_amdgcn_rcpf(wsf[32 + crow(r, hi)]);
    bf16* Ow = O + (rowbase + q0 + wid * QBLK) * DM + h * D; bf16* stg = (bf16*)(lds + LDS_OST) + wid * 2048;
#pragma unroll
    for (int r = 0; r < 16; ++r) { const int orow = crow(r, hi);
#pragma unroll
        for (int d0 = 0; d0 < 2; ++d0) stg[orow * 64 + d0 * 32 + r32] = (bf16)(cvtpk(o[d0][r] * rli[r], 0.f) & 0xffffu); }
    asm volatile("s_waitcnt lgkmcnt(0)" ::: "memory");
#pragma unroll
    for (int i = 0; i < 4; ++i) { const int row = i * 8 + (lane >> 3), ch = lane & 7; *(u32x4*)(Ow + (long)row * DM + ch * 8) = *(const u32x4*)(stg + row * 64 + ch * 8); }
    asm volatile("s_waitcnt lgkmcnt(0)\n\ts_barrier" ::: "memory");
#undef DMA_K
#undef DMA_V
#undef ROT
#undef EX
#undef RESC
#undef PKW
#undef PAF
#undef VFR
#undef VRD
#undef KRD
#undef ENDW
#undef GAPA
#undef GAPB
#undef STEP
#undef KAR
#undef KAF
#undef SETQ
#undef EX0
}
#undef SBAR
#undef PIN
#undef MFMA
#undef WAIT_BAR
#undef MX3
__device__ __forceinline__ void run_all(const bf16* Q, const bf16* K, const bf16* V, const bf16* AUG, bf16* O, char* lds) {
    constexpr int NPAIR = NQB / 2;
    for (int i = (int)blockIdx.x; i < kB * NHEAD * NPAIR; i += (int)gridDim.x) {
        const int x = i & 7, kk = i >> 3, bh = x + 8 * (kk / NPAIR), j = kk % NPAIR;
        attn64_unit(bh / NHEAD, bh % NHEAD, NQB - 1 - j, true, Q, K, V, AUG, O, lds);
        attn64_unit(bh / NHEAD, bh % NHEAD, j, false, Q, K, V, AUG, O, lds);
    }
}
}

DI float min2f(float a, float b) { float r; asm("v_min_f32_e32 %0, %1, %2" : "=v"(r) : "v"(a), "v"(b)); return r; }
#define CE_DESC(a, b) do { const float hi_ = max2f(a, b), lo_ = min2f(a, b); a = hi_; b = lo_; } while (0)
template <int N> DI void bitonic_sort_desc(float* v) {
#pragma unroll
    for (int k = 2; k <= N; k <<= 1)
#pragma unroll
        for (int j = k >> 1; j > 0; j >>= 1)
#pragma unroll
            for (int i = 0; i < N; ++i) { const int l = i ^ j; if (l > i) { if ((i & k) == 0) CE_DESC(v[i], v[l]); else CE_DESC(v[l], v[i]); } }
}
DI void bitonic_merge16_desc(float* c) {
#pragma unroll
    for (int j = 8; j > 0; j >>= 1)
#pragma unroll
        for (int i = 0; i < 16; ++i) { const int l = i ^ j; if (l > i) CE_DESC(c[i], c[l]); }
}
DI void top16_merge(float* a, const float* b) {
#pragma unroll
    for (int i = 0; i < 16; ++i) a[i] = max2f(a[i], b[15 - i]);
    bitonic_merge16_desc(a);
}
DI void top16_xlane(float* a, int mask) {
    float o[16];
#pragma unroll
    for (int i = 0; i < 16; ++i) o[i] = __shfl_xor(a[i], mask);
    top16_merge(a, o);
}
DI void ph_topk2(const bf16_t* Q, const bf16_t* SKb, int* idx, float* gate, int bid, int nblk, LAS unsigned char* lds) {
    const int tid = VTID, lane = tid & 63, wid = tid >> 6, fr = lane & 15, fq = lane >> 4;
    LAS unsigned* tab = (LAS unsigned*)(lds + 65536 + wid * 2304) + fr * 33;
    const int h = bid & 7;
    {
        const bf16_t* src = SKb + (size_t)h * 2 * 128 * 128;
#pragma unroll 4
        for (int i = 0; i < 16; ++i) {
            const int pc = tid + 256 * i, row = pc >> 4, ch = pc & 15;
            const uint4 v = *(const uint4*)(src + (size_t)row * 128 + ch * 8);
            *(LAS u32x4*)(lds + row * 256 + ((ch ^ (row & 15)) << 4)) = (u32x4){v.x, v.y, v.z, v.w};
        }
    }
    __syncthreads();
    const int ntile = kT / 16, hw = (bid >> 3) * 4 + wid, nhw = (nblk >> 3) * 4;
    for (int tile = hw; tile < ntile; tile += nhw) {
        const int t0 = tile * 16;
        float L[2][16];
#pragma unroll
        for (int p = 0; p < 2; ++p) {
            f32x4 acc[8];
#pragma unroll
            for (int n = 0; n < 8; ++n) acc[n] = (f32x4){0.f, 0.f, 0.f, 0.f};
            const bf16_t* qp = Q + (size_t)(t0 + fr) * 2048 + h * 256 + p * 128 + fq * 8;
#pragma unroll
            for (int ks = 0; ks < 4; ++ks) {
                const bf16x8 af = *(const bf16x8*)(qp + ks * 32);
#pragma unroll
                for (int n = 0; n < 8; ++n) { const bf16x8 kf = *(const LAS bf16x8*)(lds + (p * 128 + n * 16 + fr) * 256 + (((ks * 4 + fq) ^ fr) << 4)); acc[n] = __builtin_amdgcn_mfma_f32_16x16x32_bf16(kf, af, acc[n], 0, 0, 0); }
            }
            float v[32];
#pragma unroll
            for (int n = 0; n < 8; ++n)
#pragma unroll
                for (int j = 0; j < 4; ++j) v[n * 4 + j] = __uint_as_float((__float_as_uint(acc[n][j]) & ~0x7fu) | (unsigned)(n * 16 + 4 * fq + j));
            bitonic_sort_desc<16>(v); bitonic_sort_desc<16>(v + 16);
            top16_merge(v, v + 16);
            top16_xlane(v, 16); top16_xlane(v, 32);
#pragma unroll
            for (int i = 0; i < 16; ++i) L[p][i] = v[i];
        }
        if (fq == 0) {
#pragma unroll
            for (int i = 0; i < 16; ++i) { tab[i] = __float_as_uint(L[0][i]) & 0x7fu; tab[16 + i] = __float_as_uint(L[1][i]) & 0x7fu; }
        }
        float c[64]; int cnt = 0;
#pragma unroll
        for (int a = 0; a < 16; ++a)
#pragma unroll
            for (int b = 0; b < 16; ++b)
                if ((a + 1) * (b + 1) <= 16) {
                    const float s = __uint_as_float(__float_as_uint(L[0][a]) & ~0x7fu) + __uint_as_float(__float_as_uint(L[1][b]) & ~0x7fu);
                    c[cnt++] = __uint_as_float((__float_as_uint(s) & ~0xffu) | (unsigned)(a * 16 + b));
                }
#pragma unroll
        for (int i = 50; i < 64; ++i) c[i] = -1e30f;
        bitonic_sort_desc<16>(c); bitonic_sort_desc<16>(c + 16); bitonic_sort_desc<16>(c + 32); bitonic_sort_desc<16>(c + 48);
        top16_merge(c, c + 16); top16_merge(c + 32, c + 48); top16_merge(c, c + 32);
        float e[16]; int id[16]; float sum = 0.f;
        const float mx = __uint_as_float(__float_as_uint(c[0]) & ~0xffu);
#pragma unroll
        for (int r = 0; r < 16; ++r) {
            const unsigned bits = __float_as_uint(c[r]); const int a = (bits >> 4) & 15, b = bits & 15;
            id[r] = (int)(tab[a] * 128u + tab[16 + b]);
            e[r] = __builtin_amdgcn_exp2f((__uint_as_float(bits & ~0xffu) - mx) * kLog2e); sum += e[r];
        }
        const float inv = 1.f / sum;
        if (fq == 0) {
            int* ip = idx + (size_t)(t0 + fr) * 128 + h * 16; float* gp = gate + (size_t)(t0 + fr) * 128 + h * 16;
#pragma unroll
            for (int r = 0; r < 16; r += 4) { *(int4*)(ip + r) = make_int4(id[r], id[r + 1], id[r + 2], id[r + 3]); *(float4*)(gp + r) = make_float4(e[r] * inv, e[r + 1] * inv, e[r + 2] * inv, e[r + 3] * inv); }
        }
    }
}

typedef int i32x4 __attribute__((ext_vector_type(4)));
template <int SLICED> DI void ph_quant_rows(const float* src, const float* colscale, unsigned char* dst, float* scale, int bias, int bid, int nblk) {
    const int wid = VTID >> 6, lane = VTID & 63;
    for (int row0 = (bid * 4 + wid) * 2; row0 < 16384; row0 += nblk * 8) {
        float4 v[2][4];
#pragma unroll
        for (int r = 0; r < 2; ++r)
#pragma unroll
            for (int i = 0; i < 4; ++i) v[r][i] = ((const float4*)(src + (size_t)(row0 + r) * kD))[lane + 64 * i];
#pragma unroll
        for (int r = 0; r < 2; ++r) {
            const int row = row0 + r; float m = 0.f;
#pragma unroll
            for (int i = 0; i < 4; ++i) {
                if (colscale) { const float4 sc = ((const float4*)colscale)[lane + 64 * i]; v[r][i].x *= sc.x; v[r][i].y *= sc.y; v[r][i].z *= sc.z; v[r][i].w *= sc.w; }
                m = fmaxf(m, fmaxf(fmaxf(fabsf(v[r][i].x), fabsf(v[r][i].y)), fmaxf(fabsf(v[r][i].z), fabsf(v[r][i].w))));
            }
            m = wave_max(m);
            const float inv = (m > 0.f) ? 127.f / m : 0.f;
#pragma unroll
            for (int i = 0; i < 4; ++i) {
                const int a = (int)rintf(v[r][i].x * inv) + bias, b = (int)rintf(v[r][i].y * inv) + bias, c = (int)rintf(v[r][i].z * inv) + bias, d = (int)rintf(v[r][i].w * inv) + bias;
                const unsigned pk_ = (unsigned)(a & 0xff) | ((unsigned)(b & 0xff) << 8) | ((unsigned)(c & 0xff) << 16) | ((unsigned)(d & 0xff) << 24);
                const int col_ = (lane + 64 * i) * 4;
                if (SLICED) *(unsigned*)(dst + ((size_t)(col_ >> 7) * 16384 + row) * 128 + (col_ & 127)) = pk_;
                else ((unsigned*)(dst + (size_t)row * kD))[lane + 64 * i] = pk_;
            }
            if (lane == 0) scale[row] = (m > 0.f) ? m * (1.0f / 127.f) : 1.f;
        }
    }
}
DI float gelu_fast(float v) {
    const float av = fabsf(v), t = __builtin_amdgcn_rcpf(av * 0.2316418882f + 1.0f);
    float q = t * 0.5307027145f + (-0.7265760135f); q = q * t + 0.7107068705f; q = q * t + (-0.142248368f); q = q * t + 0.127414796f; q = q * t;
    const float m = v * (q * __builtin_amdgcn_exp2f((v * v) * (-0.72134752044f)));
    return v < 0.f ? m : v - m;
}
constexpr int EXW_BYTES = 19584;
constexpr int EX6_LIST = 8192, EX6_TOT = EX6_LIST + 4096, EX6_SXR = EX6_TOT + 4096;
DI void ph_exp_u7(const bf16_t* Hb, const float* SSQ, const unsigned char* U8, const float* su, const float* sv, const int* idx, const float* gate, float* abuf,
                  int bid, int nblk, LAS unsigned char* lds) {
    const int tid = VTID, lane = tid & 63, wid = tid >> 6, fr = lane & 15;
    LAS unsigned char* wl = lds + wid * EXW_BYTES;
    LAS unsigned* list = (LAS unsigned*)(wl + EX6_LIST); LAS int* tot = (LAS int*)(wl + EX6_TOT); LAS float* sxr = (LAS float*)(wl + EX6_SXR);
    const unsigned long long lt = (1ull << lane) - 1ull;
    const unsigned lane16 = (unsigned)lane * 16u;
    for (int tg = bid * 4 + wid; tg < kT / 8; tg += nblk * 4) {
        const int t0 = tg * 8;
#pragma unroll 4
        for (int tl = 0; tl < 8; ++tl) {
            const size_t t = (size_t)(t0 + tl);
            const uint4 x0 = *(const uint4*)(Hb + t * kD + lane * 16), x1 = *(const uint4*)(Hb + t * kD + lane * 16 + 8);
            float sq = SSQ[t * 16 + fr];
            float xf[16];
            { const unsigned ww[8] = {x0.x, x0.y, x0.z, x0.w, x1.x, x1.y, x1.z, x1.w};
#pragma unroll
              for (int j = 0; j < 8; ++j) { xf[2 * j] = __uint_as_float(ww[j] << 16); xf[2 * j + 1] = __uint_as_float(ww[j] & 0xffff0000u); } }
            float m = 0.f;
#pragma unroll
            for (int j = 0; j < 16; ++j) m = fmaxf(m, fabsf(xf[j]));
            m = wave_max(m);
            const float inv = (m > 0.f) ? 127.f / m : 0.f;
            unsigned pk[4];
#pragma unroll
            for (int j = 0; j < 4; ++j) {
                const int a = (int)rintf(xf[4 * j] * inv), b = (int)rintf(xf[4 * j + 1] * inv), c = (int)rintf(xf[4 * j + 2] * inv), d = (int)rintf(xf[4 * j + 3] * inv);
                pk[j] = (unsigned)(a & 0xff) | ((unsigned)(b & 0xff) << 8) | ((unsigned)(c & 0xff) << 16) | ((unsigned)(d & 0xff) << 24);
            }
            *(LAS u32x4*)(wl + tl * 1024 + lane * 16) = (u32x4){pk[0], pk[1], pk[2], pk[3]};
            sq += __shfl_xor(sq, 1); sq += __shfl_xor(sq, 2); sq += __shfl_xor(sq, 4); sq += __shfl_xor(sq, 8);
            if (lane == 0) sxr[tl] = m * (1.0f / 127.f) / sqrtf(sq * (1.0f / kD) + kEps);
        }
        {
            int ev[16];
#pragma unroll
            for (int k = 0; k < 8; ++k) { const size_t t = (size_t)(t0 + k); ev[2 * k] = idx[t * 128 + lane]; ev[2 * k + 1] = idx[t * 128 + 64 + lane]; }
            int n = 0;
#pragma unroll 1
            for (int r = 0; r < 8; ++r) {
#pragma unroll
                for (int k = 0; k < 16; ++k) {
                    const bool in = (ev[k] >> 11) == r;
                    const unsigned long long b = __ballot(in);
                    if (in) list[n + __popcll(b & lt)] = (unsigned)ev[k] | ((unsigned)(k >> 1) << 14) | ((unsigned)((k & 1) * 64 + lane) << 18);
                    n += __popcll(b);
                }
            }
        }
#define EU7_LOAD(ub, en, sb_) do { const unsigned lv_ = list[min((sb_) * 8 + (lane & 7), 1023)]; \
            _Pragma("unroll") for (int j_ = 0; j_ < 8; ++j_) { en[j_] = (unsigned)__builtin_amdgcn_readlane((int)lv_, j_); \
                ub[j_] = *(const uint4*)(U8 + (size_t)(en[j_] & 16383u) * kD + lane16); } } while (0)
#define EU7_COMP(ub, en, sb_) do { i32x4 xq_[8]; int p_[8]; \
            _Pragma("unroll") for (int j_ = 0; j_ < 8; ++j_) xq_[j_] = *(const LAS i32x4*)(wl + ((en[j_] >> 14) & 7u) * 1024u + lane16); \
            _Pragma("unroll") for (int j_ = 0; j_ < 8; ++j_) p_[j_] = __builtin_amdgcn_sdot4((int)ub[j_].x, xq_[j_][0], 0, false); \
            _Pragma("unroll") for (int j_ = 0; j_ < 8; ++j_) p_[j_] = __builtin_amdgcn_sdot4((int)ub[j_].y, xq_[j_][1], p_[j_], false); \
            _Pragma("unroll") for (int j_ = 0; j_ < 8; ++j_) p_[j_] = __builtin_amdgcn_sdot4((int)ub[j_].z, xq_[j_][2], p_[j_], false); \
            _Pragma("unroll") for (int j_ = 0; j_ < 8; ++j_) p_[j_] = __builtin_amdgcn_sdot4((int)ub[j_].w, xq_[j_][3], p_[j_], false); \
            _Pragma("unroll") for (int j_ = 0; j_ < 4; ++j_) { \
                const int hi_ = p_[j_ + 4] + __builtin_amdgcn_update_dpp(0, p_[j_ + 4], 0x114, 0xF, 0xF, true), lo_ = p_[j_] + __builtin_amdgcn_update_dpp(0, p_[j_], 0x104, 0xF, 0xF, true); \
                p_[j_] = (lane & 4) ? hi_ : lo_; } \
            _Pragma("unroll") for (int j_ = 0; j_ < 2; ++j_) { \
                const int hi_ = p_[j_ + 2] + __builtin_amdgcn_update_dpp(0, p_[j_ + 2], 0x4E, 0xF, 0xF, true), lo_ = p_[j_] + __builtin_amdgcn_update_dpp(0, p_[j_], 0x4E, 0xF, 0xF, true); \
                p_[j_] = (lane & 2) ? hi_ : lo_; } \
            { const int hi_ = p_[1] + __builtin_amdgcn_update_dpp(0, p_[1], 0xB1, 0xF, 0xF, true), lo_ = p_[0] + __builtin_amdgcn_update_dpp(0, p_[0], 0xB1, 0xF, 0xF, true); \
              p_[0] = (lane & 1) ? hi_ : lo_; } \
            int s_ = p_[0] + __builtin_amdgcn_update_dpp(0, p_[0], 0x128, 0xF, 0xF, true); \
            { const auto r_ = __builtin_amdgcn_permlane16_swap((unsigned)s_, (unsigned)s_, false, false); s_ = (int)(r_[0] + r_[1]); } \
            { const auto r_ = __builtin_amdgcn_permlane32_swap((unsigned)s_, (unsigned)s_, false, false); s_ = (int)(r_[0] + r_[1]); } \
            if (lane < 8) tot[(sb_) * 8 + lane] = s_; } while (0)
        uint4 uA[8], uB[8], uC[8]; unsigned eA[8], eB[8], eC[8];
        EU7_LOAD(uA, eA, 0); __builtin_amdgcn_sched_barrier(0); EU7_LOAD(uB, eB, 1); __builtin_amdgcn_sched_barrier(0);
#pragma unroll 1
        for (int sb = 0; sb < 128; sb += 3) {
            EU7_LOAD(uC, eC, sb + 2); EU7_COMP(uA, eA, sb);
            EU7_LOAD(uA, eA, sb + 3); if (sb + 1 < 128) EU7_COMP(uB, eB, sb + 1);
            EU7_LOAD(uB, eB, sb + 4); if (sb + 2 < 128) EU7_COMP(uC, eC, sb + 2);
        }
#undef EU7_LOAD
#undef EU7_COMP
#pragma unroll 1
        for (int i0 = lane; i0 < 1024; i0 += 512) {
            float su8[8], sv8[8], g8[8]; unsigned en8[8];
#pragma unroll
            for (int q = 0; q < 8; ++q) {
                en8[q] = list[i0 + 64 * q]; const int e = en8[q] & 16383;
                su8[q] = su[e]; sv8[q] = sv[e]; g8[q] = gate[(size_t)(t0 + ((en8[q] >> 14) & 7)) * 128 + (en8[q] >> 18)];
            }
#pragma unroll
            for (int q = 0; q < 8; ++q) {
                const int tl = (en8[q] >> 14) & 7, slot = en8[q] >> 18;
                const float sdot = (float)tot[i0 + 64 * q] * (su8[q] * sxr[tl]);
                abuf[(size_t)(t0 + tl) * 128 + slot] = gelu_fast(sdot) * g8[q] * sv8[q];
            }
        }
    }
}
DI void tr4x4(unsigned r0, unsigned r1, unsigned r2, unsigned r3, unsigned (&c)[4]) {
    const unsigned t0 = __builtin_amdgcn_perm(r1, r0, 0x05010400u), t1 = __builtin_amdgcn_perm(r1, r0, 0x07030602u);
    const unsigned t2 = __builtin_amdgcn_perm(r3, r2, 0x05010400u), t3 = __builtin_amdgcn_perm(r3, r2, 0x07030602u);
    c[0] = __builtin_amdgcn_perm(t2, t0, 0x05040100u); c[1] = __builtin_amdgcn_perm(t2, t0, 0x07060302u);
    c[2] = __builtin_amdgcn_perm(t3, t1, 0x05040100u); c[3] = __builtin_amdgcn_perm(t3, t1, 0x07060302u);
}
constexpr int EV8_ACC = 0, EV8_LIST = 16384, EV8_SA = EV8_LIST + 2560;
DI void ph_exp_v8(const bf16_t* Hres, const unsigned char* V8, const int* idx, const float* abuf, const float* nlw, float* out, int bid, int nblk, LAS unsigned char* lds) {
    const int tid = VTID, lane = tid & 63, wid = tid >> 6;
    LAS unsigned char* wl = lds + wid * EXW_BYTES;
    LAS unsigned* list = (LAS unsigned*)(wl + EV8_LIST); LAS float* sal = (LAS float*)(wl + EV8_SA); LAS int* acc = (LAS int*)(wl + EV8_ACC);
    const unsigned long long lt = (1ull << lane) - 1ull;
    const unsigned lane16 = (unsigned)lane * 16u;
    for (int tg = bid * 4 + wid; tg < kT / 4; tg += nblk * 4) {
        const int t0 = tg * 4;
        int n = 0;
        {
            int ev[8], a8[8];
#pragma unroll
            for (int tl = 0; tl < 4; ++tl) {
                const size_t t = (size_t)(t0 + tl);
                const float a0 = abuf[t * 128 + lane], a1 = abuf[t * 128 + 64 + lane];
                ev[2 * tl] = idx[t * 128 + lane]; ev[2 * tl + 1] = idx[t * 128 + 64 + lane];
                const float m = wave_max(fmaxf(fabsf(a0), fabsf(a1)));
                const float inv = (m > 0.f) ? 127.f / m : 0.f;
                a8[2 * tl] = (int)rintf(a0 * inv); a8[2 * tl + 1] = (int)rintf(a1 * inv);
                if (lane == 0) sal[tl] = m * (1.0f / 127.f);
#pragma unroll
                for (int q = 0; q < 4; ++q) *(LAS u32x4*)(wl + EV8_ACC + tl * 4096 + q * 1024 + lane16) = (u32x4){0u, 0u, 0u, 0u};
            }
#pragma unroll 1
            for (int r = 0; r < 8; ++r) {
#pragma unroll
                for (int k = 0; k < 8; ++k) {
                    const bool in = (ev[k] >> 11) == r;
                    const unsigned long long b = __ballot(in);
                    if (in) list[n + __popcll(b & lt)] = (unsigned)ev[k] | ((unsigned)(k >> 1) << 14) | ((unsigned)(a8[k] & 0xff) << 16);
                    n += __popcll(b);
                    if (k & 1) { const int pad = (-n) & 3; if (lane < pad) list[n + lane] = ((unsigned)r << 11) | ((unsigned)(k >> 1) << 14); n += pad; }
                }
            }
        }
        int yi[16];
#pragma unroll
        for (int j = 0; j < 16; ++j) yi[j] = 0;
        int cur = 0;
        const int nsb = (n + 7) >> 3, last = n - 1;
#define EV8_FLUSH() do { _Pragma("unroll") for (int j_ = 0; j_ < 16; ++j_) { atomicAdd((int*)(acc + cur * 1024 + j_ * 64 + lane), yi[j_]); yi[j_] = 0; } } while (0)
#define EV8_LOAD(ub, en, sb_) do { const int i_ = (sb_) * 8 + (lane & 7); unsigned lv_ = list[min(i_, last)]; lv_ = (i_ > last) ? (lv_ & 0xff00ffffu) : lv_; \
            _Pragma("unroll") for (int j_ = 0; j_ < 8; ++j_) { en[j_] = (unsigned)__builtin_amdgcn_readlane((int)lv_, j_); \
                ub[j_] = *(const uint4*)(V8 + (size_t)(en[j_] & 16383u) * kD + lane16); } } while (0)
#define EV8_COMP(ub, en) do { _Pragma("unroll") for (int h_ = 0; h_ < 2; ++h_) { \
            const int tlh_ = (int)((en[4 * h_] >> 14) & 3u); \
            if (tlh_ != cur) { EV8_FLUSH(); cur = tlh_; } \
            const int aw_ = (int)(((en[4 * h_] >> 16) & 0xffu) | (((en[4 * h_ + 1] >> 16) & 0xffu) << 8) | (((en[4 * h_ + 2] >> 16) & 0xffu) << 16) | ((en[4 * h_ + 3] >> 16) << 24)); \
            unsigned c_[4]; \
            tr4x4(ub[4 * h_].x, ub[4 * h_ + 1].x, ub[4 * h_ + 2].x, ub[4 * h_ + 3].x, c_); \
            _Pragma("unroll") for (int k_ = 0; k_ < 4; ++k_) yi[k_] = __builtin_amdgcn_sdot4((int)c_[k_], aw_, yi[k_], false); \
            tr4x4(ub[4 * h_].y, ub[4 * h_ + 1].y, ub[4 * h_ + 2].y, ub[4 * h_ + 3].y, c_); \
            _Pragma("unroll") for (int k_ = 0; k_ < 4; ++k_) yi[4 + k_] = __builtin_amdgcn_sdot4((int)c_[k_], aw_, yi[4 + k_], false); \
            tr4x4(ub[4 * h_].z, ub[4 * h_ + 1].z, ub[4 * h_ + 2].z, ub[4 * h_ + 3].z, c_); \
            _Pragma("unroll") for (int k_ = 0; k_ < 4; ++k_) yi[8 + k_] = __builtin_amdgcn_sdot4((int)c_[k_], aw_, yi[8 + k_], false); \
            tr4x4(ub[4 * h_].w, ub[4 * h_ + 1].w, ub[4 * h_ + 2].w, ub[4 * h_ + 3].w, c_); \
            _Pragma("unroll") for (int k_ = 0; k_ < 4; ++k_) yi[12 + k_] = __builtin_amdgcn_sdot4((int)c_[k_], aw_, yi[12 + k_], false); } } while (0)
        uint4 uA[8], uB[8], uC[8]; unsigned eA[8], eB[8], eC[8];
        EV8_LOAD(uA, eA, 0); __builtin_amdgcn_sched_barrier(0); EV8_LOAD(uB, eB, 1); __builtin_amdgcn_sched_barrier(0);
#pragma unroll 1
        for (int sb = 0; sb < nsb; sb += 3) {
            EV8_LOAD(uC, eC, sb + 2); EV8_COMP(uA, eA);
            EV8_LOAD(uA, eA, sb + 3); if (sb + 1 < nsb) EV8_COMP(uB, eB);
            EV8_LOAD(uB, eB, sb + 4); if (sb + 2 < nsb) EV8_COMP(uC, eC);
        }
        EV8_FLUSH();
#undef EV8_LOAD
#undef EV8_COMP
#undef EV8_FLUSH
        uint4 hres[4][2];
#pragma unroll
        for (int tl = 0; tl < 4; ++tl) { hres[tl][0] = *(const uint4*)(Hres + (size_t)(t0 + tl) * kD + lane * 16); hres[tl][1] = *(const uint4*)(Hres + (size_t)(t0 + tl) * kD + lane * 16 + 8); }
#pragma unroll
        for (int tl = 0; tl < 4; ++tl) {
            const size_t t = (size_t)(t0 + tl);
            const float sa = sal[tl];
            const uint4 h0 = hres[tl][0], h1 = hres[tl][1];
            const unsigned hw[8] = {h0.x, h0.y, h0.z, h0.w, h1.x, h1.y, h1.z, h1.w};
            float y[16]; float ss = 0.f;
#pragma unroll
            for (int j = 0; j < 16; ++j) {
                const float hv = (j & 1) ? __uint_as_float(hw[j >> 1] & 0xffff0000u) : __uint_as_float(hw[j >> 1] << 16);
                y[j] = (float)acc[tl * 1024 + j * 64 + lane] * sa + hv; ss += y[j] * y[j];
            }
            ss += __shfl_xor(ss, 1); ss += __shfl_xor(ss, 2); ss += __shfl_xor(ss, 4); ss += __shfl_xor(ss, 8); ss += __shfl_xor(ss, 16); ss += __shfl_xor(ss, 32);
            const float rr = 1.0f / sqrtf(ss * (1.0f / kD) + kEps);
            float* op = out + t * kD + lane * 16;
#pragma unroll
            for (int q = 0; q < 4; ++q) {
                const float4 w4 = *(const float4*)(nlw + lane * 16 + 4 * q);
                *(float4*)(op + 4 * q) = make_float4(y[4 * q] * rr * w4.x, y[4 * q + 1] * rr * w4.y, y[4 * q + 2] * rr * w4.z, y[4 * q + 3] * rr * w4.w);
            }
        }
    }
}

constexpr int EPI_LDS_OFF = 131072, EPI_LDS_WAVE = 2048;
DI void epi_strip(const f32x4& a0, const f32x4& a1, LAS unsigned char* wl, int fr, int fq, f32x4& v0, f32x4& v1) {
    *(LAS f32x4*)(wl + fr * 128 + (((0 + fq) ^ (fr & 7)) << 4)) = a0;
    *(LAS f32x4*)(wl + fr * 128 + (((4 + fq) ^ (fr & 7)) << 4)) = a1;
    const int lane = fr + 16 * fq, r = lane >> 2, c = lane & 3;
    v0 = *(const LAS f32x4*)(wl + r * 128 + (((2 * c) ^ (r & 7)) << 4));
    v1 = *(const LAS f32x4*)(wl + r * 128 + (((2 * c + 1) ^ (r & 7)) << 4));
}
struct Epi8Proj {
    static constexpr bool PERM = false, AFTER_DRAIN = false;
    ProjOut o; const float* sw; LAS unsigned char* lds_epi;
    template <int KIND> DI void half(const pg8::i32x4 (&acc)[2][2][4][2], int bj, int rowb  , int colp  , int cl0  , bf16_t* dst, float sc, int fr, int fq, LAS unsigned char* wl) const {
        const int lane = fr + 16 * fq, r = lane >> 2, cl = cl0 + 8 * (lane & 3);
        float lb[8] = {0.f, 0.f, 0.f, 0.f, 0.f, 0.f, 0.f, 0.f};
        if (KIND == 1) {
#pragma unroll
            for (int j = 0; j < 8; ++j) lb[j] = fsigmoid(o.lbl[cl + j] - o.lbl[512 + cl + j]);
        }
        const f32x4 sw0 = *(const f32x4*)(sw + colp + 8 * (lane & 3)), sw1 = *(const f32x4*)(sw + colp + 8 * (lane & 3) + 4);
        float rsn = o.rs1[rowb + r];
#pragma unroll
        for (int ai = 0; ai < 2; ++ai)
#pragma unroll
            for (int m = 0; m < 4; ++m) {
                f32x4 v0, v1;
                epi_strip(__builtin_convertvector(ai == 0 ? acc[0][bj][m][0] : acc[1][bj][m][0], f32x4), __builtin_convertvector(ai == 0 ? acc[0][bj][m][1] : acc[1][bj][m][1], f32x4), wl, fr, fq, v0, v1);
                const int row = rowb + ai * 128 + m * 16 + r;
                const float rs = rsn * (sc * (1.0f / 127.f));
                { const int nb_ = ai * 4 + m + 1; if (nb_ < 8) rsn = o.rs1[rowb + (nb_ >> 2) * 128 + (nb_ & 3) * 16 + r]; }
                v0 = v0 * sw0 * rs; v1 = v1 * sw1 * rs;
                if (KIND == 0) { for (int j = 0; j < 4; ++j) { v0[j] = v0[j] * fsigmoid(v0[j]); v1[j] = v1[j] * fsigmoid(v1[j]); } store_bf8((bf16_t*)((unsigned char*)dst + (size_t)(unsigned)((row * 512 + cl) * 2)), v0, v1); }
                else if (KIND == 1) { for (int j = 0; j < 4; ++j) { v0[j] = __builtin_amdgcn_logf(lb[j] + (1.f - lb[j]) * fsigmoid(v0[j])); v1[j] = __builtin_amdgcn_logf(lb[4 + j] + (1.f - lb[4 + j]) * fsigmoid(v1[j])); }
                    store_bf8((bf16_t*)((unsigned char*)dst + (size_t)(unsigned)((row * 512 + cl) * 2)), v0, v1); }
                else if (KIND == 2) store_bf8((bf16_t*)((unsigned char*)dst + (size_t)(unsigned)((row * 512 + cl) * 2)), v0, v1);
                else { for (int j = 0; j < 4; ++j) { v0[j] = fsigmoid(v0[j]); v1[j] = fsigmoid(v1[j]); } store_bf8((bf16_t*)((unsigned char*)dst + (size_t)(unsigned)((row * 1024 + cl) * 2)), v0, v1); }
                asm volatile("" ::: "memory");
            }
    }
    DI void half_fv(const pg8::i32x4 (&acc)[2][2][4][2], int bj, int row00, int colp0, int cl0, int fr, int fq, int wc) const {
#pragma unroll
        for (int n = 0; n < 2; ++n) {
            const int cl = cl0 + wc * 32 + n * 16 + fq * 4;
            const f32x4 swv = *(const f32x4*)(sw + colp0 + wc * 32 + n * 16 + fq * 4);
#pragma unroll
            for (int ai = 0; ai < 2; ++ai)
#pragma unroll
                for (int m = 0; m < 4; ++m) {
                    const int row = row00 + ai * 128 + m * 16;
                    const f32x4 z = __builtin_convertvector(ai == 0 ? acc[0][bj][m][n] : acc[1][bj][m][n], f32x4) * swv * (o.rs1[row] * (1.0f / 127.f));
                    bf16_t* d = o.FV + ((size_t)((row >> 12) * 512 + cl)) * kS + (row & (kS - 1));
                    for (int j = 0; j < 4; ++j) d[(size_t)j * kS] = (bf16_t)(cvtpk(z[j], 0.f) & 0xffffu);
                }
        }
    }
    DI void operator()(const pg8::i32x4 (&acc)[2][2][4][2], const pg8::Unit& u, int wr, int wc, int fr_in, int fq_in) const {
        int fr = fr_in, fq = fq_in; asm volatile("" : "+v"(fr), "+v"(fq));
        const int rowb = u.pm * 256 + wr * 64;
        LAS unsigned char* wl = lds_epi + (wr * 4 + wc) * EPI_LDS_WAVE;
#pragma unroll
        for (int bj = 0; bj < 2; ++bj) {
            const int colh = u.pn * 256 + bj * 128, cw = wc * 32, cp = colh + cw;
            if (colh < 512) half<0>(acc, bj, rowb, cp, colh + cw, o.QH, 1.f, fr, fq, wl);
            else if (colh < 1024) half<1>(acc, bj, rowb, cp, colh - 512 + cw, o.LF, 1.f, fr, fq, wl);
            else if (colh < 1536) half<2>(acc, bj, rowb, cp, colh - 1024 + cw, o.VH, 1.f, fr, fq, wl);
            else if (colh < 2048) half<0>(acc, bj, rowb, cp, colh - 1536 + cw, o.GH, 1.f, fr, fq, wl);
            else if (colh < 2560) half<2>(acc, bj, rowb, cp, colh - 2048 + cw, o.FQ, 0.125f * kLog2e, fr, fq, wl);
            else if (colh < 3072) half<2>(acc, bj, rowb, cp, colh - 2560 + cw, o.FK, 1.f, fr, fq, wl);
            else if (colh < 3584) half<2>(acc, bj, rowb, cp, colh - 3072 + cw, o.FV, 1.f, fr, fq, wl);
            else if (colh < 3712) { if (wc == 0 && fq < 2) {
                    const f32x4 swv = *(const f32x4*)(sw + colh + fq * 4);
#pragma unroll
                    for (int ai = 0; ai < 2; ++ai)
#pragma unroll
                        for (int m = 0; m < 4; ++m) { const int row = rowb + fr + ai * 128 + m * 16; const f32x4 z = __builtin_convertvector(ai == 0 ? acc[0][bj][m][0] : acc[1][bj][m][0], f32x4) * swv * (o.rs1[row] * (1.0f / 127.f)); f32x4 q;
                            for (int j = 0; j < 4; ++j) q[j] = -__builtin_amdgcn_logf(1.f + __builtin_amdgcn_exp2f(-(z[j] + o.ffb[fq * 4 + j]) * kLog2e));
                            *(f32x4*)(o.LFF + (size_t)row * 8 + fq * 4) = q; } } }
            else if (colh < 4736) half<5>(acc, bj, rowb, cp, colh - 3712 + cw, o.SGA, 1.f, fr, fq, wl);
            else if (colh < kINP) half<5>(acc, bj, rowb, cp, colh - 4736 + cw, o.SGB, 1.f, fr, fq, wl);
        }
    }
};
DI void unpack_bf8(const uint4& u, f32x4& v0, f32x4& v1) {
    v0 = (f32x4){__uint_as_float(u.x << 16), __uint_as_float(u.x & 0xffff0000u), __uint_as_float(u.y << 16), __uint_as_float(u.y & 0xffff0000u)};
    v1 = (f32x4){__uint_as_float(u.z << 16), __uint_as_float(u.z & 0xffff0000u), __uint_as_float(u.w << 16), __uint_as_float(u.w & 0xffff0000u)}; }
struct Epi8Gate {
    static constexpr bool PERM = false, AFTER_DRAIN = false;
    const bf16_t* G; bf16_t* Mg; int mode; LAS unsigned char* lds_epi;
    DI void operator()(const f32x4 (&acc)[2][2][4][2], const pg8::Unit& u, int wr, int wc, int fr, int fq) const {
        LAS unsigned char* wl = lds_epi + (wr * 4 + wc) * EPI_LDS_WAVE; const int lane = fr + 16 * fq, r = lane >> 2, c8 = 8 * (lane & 3);
        const size_t base = (size_t)(u.pm * 256 + wr * 64 + r) * 1024 + u.pn * 256 + wc * 32 + c8;
#define EPG_OFF(blk) (base + (size_t)((((blk) >> 3) * 128 + (((blk) >> 1) & 3) * 16) * 1024 + ((blk) & 1) * 128))
        uint4 gn = *(const uint4*)(G + EPG_OFF(0)), pn = make_uint4(0u, 0u, 0u, 0u);
        if (mode) pn = *(const uint4*)(Mg + EPG_OFF(0));
#pragma unroll
        for (int blk = 0; blk < 16; ++blk) {
            const int ai = blk >> 3, m = (blk >> 1) & 3, bj = blk & 1;
            const uint4 gc = gn, pc = pn;
            if (blk + 1 < 16) { gn = *(const uint4*)(G + EPG_OFF(blk + 1)); if (mode) pn = *(const uint4*)(Mg + EPG_OFF(blk + 1)); }
            f32x4 v0, v1; epi_strip(acc[ai][bj][m][0], acc[ai][bj][m][1], wl, fr, fq, v0, v1);
            f32x4 g0, g1; unpack_bf8(gc, g0, g1); v0 = v0 * g0; v1 = v1 * g1;
            if (mode) { f32x4 p0, p1; unpack_bf8(pc, p0, p1); v0 += p0; v1 += p1; }
            store_bf8(Mg + EPG_OFF(blk), v0, v1);
        }
#undef EPG_OFF
    }
};
struct Epi8Wout {
    static constexpr bool PERM = false, AFTER_DRAIN = false;
    const float* X; bf16_t* Hb; float* SSQ; LAS unsigned char* lds_epi;
    DI void operator()(const f32x4 (&acc)[2][2][4][2], const pg8::Unit& u, int wr, int wc, int fr, int fq) const {
        LAS unsigned char* wl = lds_epi + (wr * 4 + wc) * EPI_LDS_WAVE; const int lane = fr + 16 * fq, r = lane >> 2, c8 = 8 * (lane & 3);
        const int row0 = u.pm * 256 + wr * 64 + r;
        const size_t base = (size_t)row0 * 1024 + u.pn * 256 + wc * 32 + c8;
#define EPO_OFF(blk) (base + (size_t)((((blk) >> 3) * 128 + (((blk) >> 1) & 3) * 16) * 1024 + ((blk) & 1) * 128))
        f32x4 xn0 = *(const f32x4*)(X + EPO_OFF(0)), xn1 = *(const f32x4*)(X + EPO_OFF(0) + 4);
        float ss = 0.f;
#pragma unroll
        for (int blk = 0; blk < 16; ++blk) {
            const int ai = blk >> 3, m = (blk >> 1) & 3, bj = blk & 1;
            const f32x4 x0 = xn0, x1 = xn1;
            if (blk + 1 < 16) { xn0 = *(const f32x4*)(X + EPO_OFF(blk + 1)); xn1 = *(const f32x4*)(X + EPO_OFF(blk + 1) + 4); }
            f32x4 v0, v1; epi_strip(acc[ai][bj][m][0], acc[ai][bj][m][1], wl, fr, fq, v0, v1);
            v0 += x0; v1 += x1;
            store_bf8(Hb + EPO_OFF(blk), v0, v1);
            ss += (v0[0] * v0[0] + v0[1] * v0[1]) + (v0[2] * v0[2] + v0[3] * v0[3]) + (v1[0] * v1[0] + v1[1] * v1[1]) + (v1[2] * v1[2] + v1[3] * v1[3]);
            if (bj == 1) {
                ss += __shfl_xor(ss, 1); ss += __shfl_xor(ss, 2);
                if ((lane & 3) == 0) SSQ[(size_t)(row0 + ai * 128 + m * 16) * 16 + u.pn * 4 + wc] = ss;
                ss = 0.f;
            }
        }
#undef EPO_OFF
    }
};
struct Epi8Wq {
    static constexpr bool PERM = false, AFTER_DRAIN = false;
    const float* SSQ; bf16_t* Q; LAS unsigned char* lds_epi;
    DI void operator()(const f32x4 (&acc)[2][2][4][2], const pg8::Unit& u, int wr, int wc, int fr, int fq) const {
        LAS unsigned char* wl = lds_epi + (wr * 4 + wc) * EPI_LDS_WAVE; const int lane = fr + 16 * fq, r = lane >> 2, c8 = 8 * (lane & 3);
        const int row0 = u.pm * 256 + wr * 64 + r;
        f32x4 sp[8];
#pragma unroll
        for (int q = 0; q < 8; ++q) sp[q] = *(const f32x4*)(SSQ + (size_t)(row0 + (q >> 2) * 128 + (q & 3) * 16) * 16 + 4 * (lane & 3));
#pragma unroll
        for (int ai = 0; ai < 2; ++ai)
#pragma unroll
            for (int m = 0; m < 4; ++m) {
                const int row = row0 + ai * 128 + m * 16;
                const f32x4 a = sp[ai * 4 + m];
                float s4 = (a[0] + a[1]) + (a[2] + a[3]); s4 += __shfl_xor(s4, 1); s4 += __shfl_xor(s4, 2);
                const float r2 = 1.0f / sqrtf(s4 * (1.0f / kD) + kEps);
#pragma unroll
                for (int bj = 0; bj < 2; ++bj) {
                    f32x4 v0, v1; epi_strip(acc[ai][bj][m][0], acc[ai][bj][m][1], wl, fr, fq, v0, v1);
                    store_bf8(Q + (size_t)row * 2048 + u.pn * 256 + bj * 128 + wc * 32 + c8, v0 * r2, v1 * r2);
                }
            }
    }
};

constexpr int NPHASE = 9;
template <int PH>
DI void run_phase(const Params& p, int bid, int nblk, float* sm) {
    unsigned char* ws = p.ws;
    float* rs1 = (float*)(ws + OFF_RS1); float* SSQ = (float*)(ws + OFF_SSQ); float* cf = (float*)(ws + OFF_CFOX); float* LFF = (float*)(ws + OFF_LFF);
    int* idx = (int*)(ws + OFF_IDX); float* gate = (float*)(ws + OFF_GATE);
    bf16_t* Wtin = (bf16_t*)(ws + OFF_WTIN); bf16_t* Wta = (bf16_t*)(ws + OFF_WTA); bf16_t* Wtb = (bf16_t*)(ws + OFF_WTB); bf16_t* Wto = (bf16_t*)(ws + OFF_WTOUT); bf16_t* Wtq = (bf16_t*)(ws + OFF_WTQ); bf16_t* SKb = (bf16_t*)(ws + OFF_SKB); unsigned char* U8 = ws + OFF_UB; unsigned char* V8 = ws + OFF_VB; float* abuf = (float*)(ws + OFF_ABUF); float* su = (float*)(ws + OFF_SU); float* sv = (float*)(ws + OFF_SV);
    bf16_t* Xb = (bf16_t*)(ws + OFF_R1); bf16_t* ST = Xb; float* DC = (float*)(ws + OFF_DC);
    bf16_t* QH = (bf16_t*)(ws + OFF_R2); bf16_t* LF = QH + (size_t)kT * 512; bf16_t* Mg = QH;
    bf16_t* VH = (bf16_t*)(ws + OFF_R3); bf16_t* GH = VH + (size_t)kT * 512; bf16_t* Hb = VH;
    bf16_t* FK = (bf16_t*)(ws + OFF_R4); bf16_t* FV = FK + (size_t)kT * 512;
    bf16_t* SGA = (bf16_t*)(ws + OFF_R6); bf16_t* SGB = SGA + (size_t)kT * 1024; bf16_t* Qp = SGA;
    bf16_t* FQ = (bf16_t*)p.out; bf16_t* Bb = FQ + (size_t)kT * 512; bf16_t* Ab = Bb + (size_t)kT * 512;
    LAS unsigned char* lds = (LAS unsigned char*)sm;
    if (PH == 0) {
        unsigned char* X8 = (unsigned char*)Xb; float* cmp = (float*)(ws + OFF_SW);
        ph_conv_x8(p.x, X8, rs1, bid, nblk);
        ph_colmax(p.w_in, kINW, 0, 3592, kD, p.nmw, cmp, bid, nblk, sm);
        ph_colmax(p.w_in, kINW, 3592, 2048, kD, p.nmw, cmp + 3712, bid, nblk, sm);
        ph_conv_wt(p.w_a, kD, 0, 1024, 512, nullptr, Wta, bid, nblk, sm);
        ph_conv_wt(p.w_b, kD, 0, 1024, 512, nullptr, Wtb, bid, nblk, sm);
        ph_conv_wt(p.w_out, kD, 0, 1024, kD, nullptr, Wto, bid, nblk, sm);
        ph_conv_wt(p.w_q, 2048, 0, 2048, kD, p.nfw, Wtq, bid, nblk, sm);
        ph_conv_plain(p.sk, SKb, (size_t)8 * 2 * 128 * 128, nullptr, bid, nblk);
    }
    else if (PH == 11) {
        unsigned char* W8 = (unsigned char*)Wtin; const float* cmp = (const float*)(ws + OFF_SW);
        ph_conv_wt8(p.w_in, kINW, 0, 3592, kD, p.nmw, cmp, W8, bid, nblk, sm);
        ph_conv_wt8(p.w_in, kINW, 3592, 2048, kD, p.nmw, cmp + 3712, W8 + (size_t)3712 * kD, bid, nblk, sm);
        ph_zero_bf16((bf16_t*)(W8 + (size_t)3592 * kD), (size_t)120 * kD / 2, bid, nblk);
        ph_zero_bf16((bf16_t*)(W8 + (size_t)5760 * kD), (size_t)128 * kD / 2, bid, nblk);
        ph_quant_rows<0>(p.pu, p.nfw, U8, su, 0, bid, nblk);
        ph_quant_rows<0>(p.pv, nullptr, V8, sv, 0, bid, nblk);
    }
    else if (PH == 2) { ph_cfox(LFF, cf, (bf16_t*)(ws + OFF_AUG), nblk - 1 - bid, nblk, sm); ph_hgrn1(LF, VH, ST, DC, bid, nblk, lds); }
    else if (PH == 3) { ph_hgrn2(ST, DC, bid, nblk); }
    else if (PH == 9) ph_hgrn3(QH, LF, VH, GH, ST, p.hnw, Ab, bid, nblk, lds);
    else if (PH == 7) ph_topk2(Qp, SKb, idx, gate, bid, nblk, lds);
    else if (PH == 8) ph_exp_u7(Hb, SSQ, U8, su, sv, idx, gate, abuf, bid, nblk, lds);
    else if (PH == 10) ph_exp_v8(Hb, V8, idx, abuf, p.nlw, p.out, bid, nblk, lds);
}

template <int PH>
DI void run_gemm(const Params& p, LAS unsigned char* lds) {
    unsigned char* ws = p.ws;
    float* rs1 = (float*)(ws + OFF_RS1); float* SSQ = (float*)(ws + OFF_SSQ); float* LFF = (float*)(ws + OFF_LFF);
    bf16_t* Wtin = (bf16_t*)(ws + OFF_WTIN); bf16_t* Wta = (bf16_t*)(ws + OFF_WTA); bf16_t* Wtb = (bf16_t*)(ws + OFF_WTB); bf16_t* Wto = (bf16_t*)(ws + OFF_WTOUT); bf16_t* Wtq = (bf16_t*)(ws + OFF_WTQ);
    bf16_t* Xb = (bf16_t*)(ws + OFF_R1);
    bf16_t* QH = (bf16_t*)(ws + OFF_R2); bf16_t* LF = QH + (size_t)kT * 512; bf16_t* Mg = QH;
    bf16_t* VH = (bf16_t*)(ws + OFF_R3); bf16_t* GH = VH + (size_t)kT * 512; bf16_t* Hb = VH;
    bf16_t* FK = (bf16_t*)(ws + OFF_R4); bf16_t* FV = FK + (size_t)kT * 512;
    bf16_t* SGA = (bf16_t*)(ws + OFF_R6); bf16_t* SGB = SGA + (size_t)kT * 1024; bf16_t* Qp = SGA;
    bf16_t* FQ = (bf16_t*)p.out; bf16_t* Bb = FQ + (size_t)kT * 512; bf16_t* Ab = Bb + (size_t)kT * 512;
    const int G = (int)gridDim.x, c = (int)blockIdx.x;
    if (PH == 1) {
        pg8::Gemm g{Xb, Wtin, kT, 5888, kD / 2}; pg8::StaticOrder S; S.init(kT, 5888, G, c);
        Epi8Proj E{ProjOut{rs1, p.lbl, p.ffb, QH, LF, VH, GH, FQ, FK, FV, SGA, SGB, LFF}, (const float*)(ws + OFF_SW), lds + EPI_LDS_OFF};
        pg8::gemm_phase_i8<Epi8Proj, pg8::StaticOrder, true, true>(lds, g, S, E);
    } else if (PH == 4) {
        { pg8::Gemm g{Ab, Wta, kT, 1024, 512}; pg8::StaticOrder S; S.init(kT, 1024, G, c); Epi8Gate E{SGA, Mg, 0, lds + EPI_LDS_OFF}; pg8::gemm_phase<Epi8Gate, pg8::StaticOrder, true, true>(lds, g, S, E); }
        { pg8::Gemm g{Bb, Wtb, kT, 1024, 512}; pg8::StaticOrder S; S.init(kT, 1024, G, c); Epi8Gate E{SGB, Mg, 1, lds + EPI_LDS_OFF}; pg8::gemm_phase<Epi8Gate, pg8::StaticOrder, true, true>(lds, g, S, E); }
    } else if (PH == 5) {
        pg8::Gemm g{Mg, Wto, kT, 1024, kD}; pg8::StaticOrder S; S.init(kT, 1024, G, c); Epi8Wout E{p.x, Hb, SSQ, lds + EPI_LDS_OFF};
        pg8::gemm_phase<Epi8Wout, pg8::StaticOrder, true, true>(lds, g, S, E);
    } else if (PH == 6) {
        pg8::Gemm g{Hb, Wtq, kT, 2048, kD}; pg8::StaticOrder S; S.init(kT, 2048, G, c); Epi8Wq E{SSQ, Qp, lds + EPI_LDS_OFF};
        pg8::gemm_phase<Epi8Wq, pg8::StaticOrder, true, true>(lds, g, S, E);
    }
}

constexpr int SM_FLOATS = 19584;
constexpr size_t OFF_BAR = 512 * 1024;

__global__ void __launch_bounds__(512, 2) k_mega(Params p) {
    __shared__ __attribute__((aligned(16))) float sm_all[2 * SM_FLOATS + 4];
    volatile LAS unsigned* st = (volatile LAS unsigned*)(LAS float*)(sm_all + 2 * SM_FLOATS);
    if (threadIdx.x == 0) { st[0] = 0u; st[1] = 0u; }
    __syncthreads();
    const XcdBarrier xb = xcd_barrier_post((unsigned*)(p.ws + OFF_BAR), st);
    const int half = __builtin_amdgcn_readfirstlane((int)(threadIdx.x >> 8));
    float* sm = sm_all + half * SM_FLOATS;
    const int bid = blockIdx.x * 2 + half, nblk = gridDim.x * 2;
    run_phase<0>(p, bid, nblk, sm); xcd_barrier(xb);
    run_phase<11>(p, bid, nblk, sm); xcd_barrier(xb);
    run_gemm<1>(p, (LAS unsigned char*)sm_all); xcd_barrier(xb);
    run_phase<2>(p, bid, nblk, sm); xcd_barrier(xb);
    run_phase<3>(p, bid, nblk, sm);
    __syncthreads();
    { bf16_t* FQ_ = (bf16_t*)p.out; bf16_t* FK_ = (bf16_t*)(p.ws + OFF_R4);
      at64::run_all(FQ_, FK_, FK_ + (size_t)kT * 512, (const bf16_t*)(p.ws + OFF_AUG), FQ_ + (size_t)kT * 512, (char*)sm_all); }
    xcd_barrier(xb);
    run_phase<9>(p, bid, nblk, sm); xcd_barrier(xb);
    run_gemm<4>(p, (LAS unsigned char*)sm_all); xcd_barrier(xb);
    run_gemm<5>(p, (LAS unsigned char*)sm_all); xcd_barrier(xb);
    run_gemm<6>(p, (LAS unsigned char*)sm_all); xcd_barrier(xb);
    run_phase<7>(p, bid, nblk, sm); xcd_barrier(xb);
    run_phase<8>(p, bid, nblk, sm); xcd_barrier(xb);
    run_phase<10>(p, bid, nblk, sm);
}

extern "C" void kernel_launch(void* const* d_in, const int* in_sizes, int n_in, void* d_out, int out_size, void* d_ws, size_t ws_size, hipStream_t stream) {
    Params p{};
    p.x = (const float*)d_in[0]; p.nmw = (const float*)d_in[1]; p.w_in = (const float*)d_in[2]; p.lbl = (const float*)d_in[3];
    p.hnw = (const float*)d_in[4]; p.ffb = (const float*)d_in[5]; p.w_a = (const float*)d_in[6]; p.w_b = (const float*)d_in[7];
    p.w_out = (const float*)d_in[8]; p.nfw = (const float*)d_in[9]; p.w_q = (const float*)d_in[10]; p.sk = (const float*)d_in[11];
    p.pu = (const float*)d_in[12]; p.pv = (const float*)d_in[13]; p.nlw = (const float*)d_in[14];
    p.out = (float*)d_out; p.ws = (unsigned char*)d_ws;
    static int grid_blocks = 0;
    if (!grid_blocks) {
        int dev = 0, cus = 0, per_cu = 0;
        (void)hipGetDevice(&dev);
        (void)hipDeviceGetAttribute(&cus, hipDeviceAttributeMultiprocessorCount, dev);
        (void)hipOccupancyMaxActiveBlocksPerMultiprocessor(&per_cu, k_mega, 512, 0);
        if (per_cu > 1) per_cu = 1;
        if (per_cu < 1) per_cu = 1;
        grid_blocks = cus * per_cu;
        if (ws_size < 507 * MBy) fprintf(stderr, "workspace too small: %zu\n", ws_size);
    }
    (void)hipMemsetAsync((unsigned char*)d_ws + OFF_BAR, 0, XCD_BAR_WORDS * sizeof(unsigned), stream);
    (void)hipMemsetAsync((unsigned char*)d_ws + OFF_SW, 0, 5888 * sizeof(float), stream);
    void* args[] = {&p};
    hipError_t e = hipLaunchCooperativeKernel((void*)k_mega, dim3(grid_blocks), dim3(512), args, 0, stream);
    if (e != hipSuccess) fprintf(stderr, "cooperative launch failed: %s (grid %d)\n", hipGetErrorString(e), grid_blocks);
}
```

```cpp
#include <hip/hip_runtime.h>
#include <math.h>
#include <stdio.h>

#ifndef MEGA
#define MEGA 1
#endif

#define DI __device__ __forceinline__
__device__ __forceinline__ int vtid_opaque() { int t = (int)threadIdx.x; asm volatile("" : "+v"(t)); return t & 255; }
#define VTID (vtid_opaque())
constexpr int kB = 8, kS = 4096, kT = kB * kS, kD = 1024, kINW = 5640;
constexpr float kEps = 1e-6f;

struct Params {
    const float *x, *nmw, *w_in, *lbl, *hnw, *ffb, *w_a, *w_b, *w_out, *nfw, *w_q, *sk, *pu, *pv, *nlw;
    float* out; unsigned char* ws;
};
constexpr size_t MBy = 1u << 20;
constexpr size_t OFF_SW = 256 * 1024;
constexpr size_t OFF_RS1 = 0, OFF_SSQ = 1 * MBy, OFF_CFOX = 3 * MBy, OFF_LFF = 4 * MBy, OFF_DC = 5 * MBy, OFF_IDX = 6 * MBy, OFF_GATE = 22 * MBy;
constexpr size_t OFF_WTIN = 38 * MBy, OFF_WTA = 50 * MBy, OFF_WTB = 51 * MBy, OFF_WTOUT = 52 * MBy, OFF_WTQ = 54 * MBy, OFF_SKB = 58 * MBy, OFF_UB = 59 * MBy  , OFF_VB = 75 * MBy  , OFF_ABUF = 91 * MBy  , OFF_SU = 107 * MBy, OFF_SV = 107 * MBy + 65536;
constexpr size_t OFF_AUG = 44 * MBy;
constexpr size_t OFF_R1 = 123 * MBy;
constexpr size_t OFF_R2 = 187 * MBy;
constexpr size_t OFF_R3 = 251 * MBy;
constexpr size_t OFF_R4 = 315 * MBy;
constexpr size_t OFF_R6 = 379 * MBy;
constexpr int kINP = 5760;
constexpr float kLog2e = 1.4426950408889634f;

DI float sigmoidf_(float v) { return 1.f / (1.f + expf(-v)); }
DI float wave_max(float v) {
#pragma unroll
    for (int o = 32; o > 0; o >>= 1) v = fmaxf(v, __shfl_xor(v, o));
    return v;
}
DI float wave_sum(float v) {
#pragma unroll
    for (int o = 32; o > 0; o >>= 1) v += __shfl_xor(v, o);
    return v;
}

#define LAS __attribute__((address_space(3)))
typedef unsigned short bf16_t;
typedef short bf16x8 __attribute__((ext_vector_type(8)));
typedef float f32x4 __attribute__((ext_vector_type(4)));
typedef unsigned u32x4 __attribute__((ext_vector_type(4)));
typedef unsigned u32x2 __attribute__((ext_vector_type(2)));
typedef float f32x2_t __attribute__((ext_vector_type(2)));
typedef __bf16 bf16x2_t __attribute__((ext_vector_type(2)));
DI unsigned cvtpk(float lo, float hi) { f32x2_t v = {lo, hi}; bf16x2_t b = __builtin_convertvector(v, bf16x2_t); return __builtin_bit_cast(unsigned, b); }
DI float bf2f(bf16_t v) { return __uint_as_float(((unsigned)v) << 16); }


#define XB_TMO      128
#define XB_XCNT(j)  (256  + 64 * (j))
#define XB_XSUB(j)  (1280 + 64 * (j))
#define XB_XGEN(j)  (2304 + 64 * (j))
#define XB_TOP      3328
#define XB_TOPGEN   3392
#define XCD_BAR_WORDS 3456
#define XB_SPIN_CAP (1u << 18)
DI unsigned xb_ld(unsigned* p)              { return __hip_atomic_load(p, __ATOMIC_RELAXED, __HIP_MEMORY_SCOPE_AGENT); }
DI unsigned xb_add(unsigned* p, unsigned v) { return __hip_atomic_fetch_add(p, v, __ATOMIC_RELAXED, __HIP_MEMORY_SCOPE_AGENT); }
DI unsigned xb_xcc_id() { return (unsigned)__builtin_amdgcn_s_getreg((3 << 11) | 20) & 0xFu; }
#define XB_SPIN(cond, bar) do { unsigned _sp = 0; while (cond) { __builtin_amdgcn_s_sleep(1); \
    if ((++_sp & 255u) == 0u) { if (xb_ld(&(bar)[XB_TMO])) break; if (_sp > XB_SPIN_CAP) { atomicAdd(&(bar)[XB_TMO], 1u); break; } } } } while (0)
struct XcdBarrier { unsigned* bar; unsigned x; volatile LAS unsigned* st; };
DI XcdBarrier xcd_barrier_post(unsigned* bar, volatile LAS unsigned* st) {
    XcdBarrier b; b.bar = bar; b.x = xb_xcc_id(); b.st = st;
    if (threadIdx.x == 0) (void)xb_add(&bar[XB_XCNT(b.x)], 1u);
    return b;
}
DI void xcd_barrier_complete(unsigned* bar, unsigned x, unsigned& nloc, unsigned& nx) {
    const unsigned G = gridDim.x * gridDim.y * gridDim.z;
    unsigned sum, cnt, mine, sp = 0u;
    for (;;) {
        sum = 0u; cnt = 0u; mine = 0u;
#pragma unroll
        for (unsigned j = 0; j < 16; ++j) { const unsigned c = xb_ld(&bar[XB_XCNT(j)]); sum += c; cnt += (c > 0u) ? 1u : 0u; mine = (j == x) ? c : mine; }
        if (sum == G) break;
        __builtin_amdgcn_s_sleep(1);
        if ((++sp & 255u) == 0u) { if (xb_ld(&bar[XB_TMO])) break; if (sp > XB_SPIN_CAP) { atomicAdd(&bar[XB_TMO], 1u); break; } }
    }
    nloc = mine > 0u ? mine : 1u; nx = cnt > 0u ? cnt : 1u;
}
DI void xcd_barrier(const XcdBarrier& b) {
    asm volatile("s_waitcnt vmcnt(0)" ::: "memory");
    __syncthreads();
    if (threadIdx.x == 0) {
        unsigned* bar = b.bar;
        __builtin_amdgcn_s_waitcnt(0);
        unsigned nloc = b.st[0], nx = b.st[1];
        if (nloc == 0u) { xcd_barrier_complete(bar, b.x, nloc, nx); b.st[0] = nloc; b.st[1] = nx; }
        const unsigned old = xb_add(&bar[XB_XSUB(b.x)], 1u);
        const unsigned gen = old / nloc;
        if (old + 1u == (gen + 1u) * nloc) {
            __builtin_amdgcn_fence(__ATOMIC_RELEASE, "agent");
            asm volatile("s_waitcnt vmcnt(0)" ::: "memory");
            const unsigned og = xb_add(&bar[XB_TOP], 1u);
            const unsigned tg = og / nx;
            if (og + 1u == (tg + 1u) * nx) xb_add(&bar[XB_TOPGEN], 1u);
            else XB_SPIN(xb_ld(&bar[XB_TOPGEN]) == tg, bar);
            __builtin_amdgcn_fence(__ATOMIC_ACQUIRE, "agent");
            xb_add(&bar[XB_XGEN(b.x)], 1u);
            asm volatile("s_waitcnt vmcnt(0)" ::: "memory");
        } else {
            XB_SPIN(xb_ld(&bar[XB_XGEN(b.x)]) == gen, bar);
            __builtin_amdgcn_fence(__ATOMIC_ACQUIRE, "agent");
            asm volatile("s_waitcnt vmcnt(0)" ::: "memory");
        }
    }
    __syncthreads();
}

DI void ph_conv_x8(const float* X, unsigned char* X8, float* rsx, int bid, int nblk) {
    const int wid = VTID >> 6, lane = VTID & 63;
    for (int row0 = (bid * 4 + wid) * 2; row0 < kT; row0 += nblk * 8) {
        float4 v[2][4];
#pragma unroll
        for (int r = 0; r < 2; ++r)
#pragma unroll
            for (int i = 0; i < 4; ++i) v[r][i] = ((const float4*)(X + (size_t)(row0 + r) * kD))[lane + 64 * i];
#pragma unroll
        for (int r = 0; r < 2; ++r) {
            float s = 0.f, m = 0.f;
#pragma unroll
            for (int i = 0; i < 4; ++i) { const float4 w = v[r][i]; s += w.x * w.x + w.y * w.y + w.z * w.z + w.w * w.w; m = fmaxf(m, fmaxf(fmaxf(fabsf(w.x), fabsf(w.y)), fmaxf(fabsf(w.z), fabsf(w.w)))); }
            s = wave_sum(s); m = wave_max(m);
            const float inv = (m > 0.f) ? 127.f / m : 0.f;
#pragma unroll
            for (int i = 0; i < 4; ++i) { const float4 w = v[r][i];
                const int a = (int)rintf(w.x * inv), b = (int)rintf(w.y * inv), c = (int)rintf(w.z * inv), d = (int)rintf(w.w * inv);
                ((unsigned*)(X8 + (size_t)(row0 + r) * kD))[lane + 64 * i] = (unsigned)(a & 0xff) | ((unsigned)(b & 0xff) << 8) | ((unsigned)(c & 0xff) << 16) | ((unsigned)(d & 0xff) << 24); }
            if (lane == 0) rsx[row0 + r] = m * (1.0f / 127.f) / sqrtf(s * (1.0f / kD) + kEps);
        }
    }
}
DI void ph_colmax(const float* W, int ldw, int nsrc0, int Ncnt, int K, const float* kscale, float* cm, int bid, int nblk, float* smf) {
    float* cmx = smf;
    const int ntn = (Ncnt + 63) / 64, ntk = K / 64, tid = VTID;
    for (int tbase = 0; tbase < ntn * ntk; tbase += nblk) {
        const bool active = tbase + bid < ntn * ntk; const int tile = active ? tbase + bid : 0;
        const int n0 = (tile / ntk) * 64, k0 = (tile % ntk) * 64, r = tid >> 4, c4 = (tid & 15) * 4;
        float4 mx = make_float4(0.f, 0.f, 0.f, 0.f);
        if (n0 + c4 < Ncnt) {
#pragma unroll
            for (int i = 0; i < 4; ++i) { const int k = k0 + r + 16 * i; const float4 v = *(const float4*)(W + (size_t)k * ldw + nsrc0 + n0 + c4); const float ks = kscale ? kscale[k] : 1.f;
                mx.x = fmaxf(mx.x, fabsf(v.x * ks)); mx.y = fmaxf(mx.y, fabsf(v.y * ks)); mx.z = fmaxf(mx.z, fabsf(v.z * ks)); mx.w = fmaxf(mx.w, fabsf(v.w * ks)); }
        }
        __syncthreads();
        cmx[r * 64 + c4] = mx.x; cmx[r * 64 + c4 + 1] = mx.y; cmx[r * 64 + c4 + 2] = mx.z; cmx[r * 64 + c4 + 3] = mx.w;
        __syncthreads();
        if (tid < 64 && active && n0 + tid < Ncnt) { float m = 0.f;
#pragma unroll
            for (int i = 0; i < 16; ++i) m = fmaxf(m, cmx[i * 64 + tid]);
            atomicMax((unsigned*)cm + n0 + tid, __float_as_uint(m)); }
    }
}
DI void ph_conv_wt8(const float* W, int ldw, int nsrc0, int Ncnt, int K, const float* kscale, const float* cm, unsigned char* Wt8, int bid, int nblk, float* smf) {
    float(*tl)[65] = (float(*)[65])smf;
    const int ntn = (Ncnt + 63) / 64, ntk = K / 64, tid = VTID;
    for (int tbase = 0; tbase < ntn * ntk; tbase += nblk) {
        const bool active = tbase + bid < ntn * ntk; const int tile = active ? tbase + bid : 0;
        const int n0 = (tile / ntk) * 64, k0 = (tile % ntk) * 64;
        __syncthreads();
        {
            const int r = tid >> 4, c4 = (tid & 15) * 4;
#pragma unroll
            for (int i = 0; i < 4; ++i) {
                const int k = r + 16 * i;
                float4 v = make_float4(0.f, 0.f, 0.f, 0.f);
                if (n0 + c4 < Ncnt) v = *(const float4*)(W + (size_t)(k0 + k) * ldw + nsrc0 + n0 + c4);
                tl[k][c4] = v.x; tl[k][c4 + 1] = v.y; tl[k][c4 + 2] = v.z; tl[k][c4 + 3] = v.w;
            }
        }
        __syncthreads();
        {
            const int n = tid >> 2, kq = (tid & 3) * 16;
            if (active && n0 + n < Ncnt) {
                const float m = cm[n0 + n], inv = (m > 0.f) ? 127.f / m : 0.f;
                unsigned w[4];
#pragma unroll
                for (int j = 0; j < 4; ++j) { unsigned q = 0;
#pragma unroll
                    for (int b = 0; b < 4; ++b) { const int kk = kq + 4 * j + b; q |= ((unsigned)((int)rintf(tl[kk][n] * (kscale ? kscale[k0 + kk] : 1.f) * inv) & 0xff)) << (8 * b); }
                    w[j] = q; }
                *(uint4*)(Wt8 + (size_t)(n0 + n) * K + k0 + kq) = make_uint4(w[0], w[1], w[2], w[3]);
            }
        }
    }
}
DI void ph_conv_wt(const float* W, int ldw, int nsrc0, int Ncnt, int K, const float* kscale, bf16_t* Wt, int bid, int nblk, float* smf) {
    float(*tl)[65] = (float(*)[65])smf;
    const int ntn = (Ncnt + 63) / 64, ntk = K / 64, tid = VTID;
    for (int tbase = 0; tbase < ntn * ntk; tbase += nblk) {
        const bool active = tbase + bid < ntn * ntk; const int tile = active ? tbase + bid : 0;
        const int n0 = (tile / ntk) * 64, k0 = (tile % ntk) * 64;
        __syncthreads();
        {
            const int r = tid >> 4, c4 = (tid & 15) * 4;
#pragma unroll
            for (int i = 0; i < 4; ++i) {
                const int k = r + 16 * i;
                float4 v = make_float4(0.f, 0.f, 0.f, 0.f);
                if (n0 + c4 < Ncnt) v = *(const float4*)(W + (size_t)(k0 + k) * ldw + nsrc0 + n0 + c4);
                tl[k][c4] = v.x; tl[k][c4 + 1] = v.y; tl[k][c4 + 2] = v.z; tl[k][c4 + 3] = v.w;
            }
        }
        __syncthreads();
        {
            const int n = tid >> 2, kq = (tid & 3) * 16;
            if (active && n0 + n < Ncnt) {
                unsigned w[8];
#pragma unroll
                for (int j = 0; j < 8; ++j) {
                    const float s0 = kscale ? kscale[k0 + kq + 2 * j] : 1.f, s1 = kscale ? kscale[k0 + kq + 2 * j + 1] : 1.f;
                    w[j] = cvtpk(tl[kq + 2 * j][n] * s0, tl[kq + 2 * j + 1][n] * s1);
                }
                uint4* dst = (uint4*)(Wt + (size_t)(n0 + n) * K + k0 + kq);
                dst[0] = make_uint4(w[0], w[1], w[2], w[3]); dst[1] = make_uint4(w[4], w[5], w[6], w[7]);
            }
        }
    }
}
DI void ph_zero_bf16(bf16_t* p, size_t n  , int bid, int nblk) {
    for (size_t i = (size_t)bid * 256 + VTID; i < n / 8; i += (size_t)nblk * 256) ((uint4*)p)[i] = make_uint4(0, 0, 0, 0);
}

DI void ph_conv_plain(const float* src, bf16_t* dst, size_t n  , const float* colscale  , int bid, int nblk) {
    for (size_t i = (size_t)bid * 256 + VTID; i < n / 8; i += (size_t)nblk * 256) {
        float4 a = ((const float4*)src)[2 * i], b = ((const float4*)src)[2 * i + 1];
        if (colscale) { const int c = (int)((i * 8) & (kD - 1)); const float4 s0 = *(const float4*)(colscale + c), s1 = *(const float4*)(colscale + c + 4);
            a.x *= s0.x; a.y *= s0.y; a.z *= s0.z; a.w *= s0.w; b.x *= s1.x; b.y *= s1.y; b.z *= s1.z; b.w *= s1.w; }
        ((uint4*)dst)[i] = make_uint4(cvtpk(a.x, a.y), cvtpk(a.z, a.w), cvtpk(b.x, b.y), cvtpk(b.z, b.w));
    }
}

DI void acc_zero(f32x4 (&acc)[4][4]) {
#pragma unroll
    for (int m = 0; m < 4; ++m)
#pragma unroll
        for (int n = 0; n < 4; ++n) acc[m][n] = (f32x4){0.f, 0.f, 0.f, 0.f};
}
struct LaneId { int wr, wc, fr, fq; };
DI LaneId lane_id() { const int tid = VTID, wid = tid >> 6, lane = tid & 63; return LaneId{wid >> 1, wid & 1, lane & 15, lane >> 4}; }

DI float fsigmoid(float z) { return __builtin_amdgcn_rcpf(1.f + __builtin_amdgcn_exp2f(-z * kLog2e)); }
DI void store_bf4(bf16_t* p, f32x4 v) { *(uint2*)p = make_uint2(cvtpk(v[0], v[1]), cvtpk(v[2], v[3])); }
DI f32x4 load_bf4(const bf16_t* p) { const uint2 u = *(const uint2*)p; return (f32x4){__uint_as_float(u.x << 16), __uint_as_float(u.x & 0xffff0000u), __uint_as_float(u.y << 16), __uint_as_float(u.y & 0xffff0000u)}; }
DI void store_bf8(bf16_t* p, const f32x4& v0, const f32x4& v1) { *(uint4*)p = make_uint4(cvtpk(v0[0], v0[1]), cvtpk(v0[2], v0[3]), cvtpk(v1[0], v1[1]), cvtpk(v1[2], v1[3])); }
DI void load_bf8(const bf16_t* p, f32x4& v0, f32x4& v1) { const uint4 u = *(const uint4*)p;
    v0 = (f32x4){__uint_as_float(u.x << 16), __uint_as_float(u.x & 0xffff0000u), __uint_as_float(u.y << 16), __uint_as_float(u.y & 0xffff0000u)};
    v1 = (f32x4){__uint_as_float(u.z << 16), __uint_as_float(u.z & 0xffff0000u), __uint_as_float(u.w << 16), __uint_as_float(u.w & 0xffff0000u)}; }

namespace pg8 {
#define PG8_LAS __attribute__((address_space(3)))
constexpr int BM = 256, BK = 64, HALF = 128, HTB = HALF * BK * 2  , STAGE_BYTES = 8 * HTB, NXCD = 8, WGM = 8;

__host__ __device__ __forceinline__ int lds_byte(int r, int c) { const int st = (r >> 4) * 2 + (c >> 5), rr = r & 15, cc = c & 31, ob = rr * 64 + cc * 2; return st * 1024 + (ob ^ (((ob >> 9) & 1) << 5)); }
__host__ __device__ __forceinline__ void stage_rc(int b, int& R, int& C) { const int st = b / 1024, sb = b % 1024, swz = sb ^ (((sb >> 9) & 1) << 5); R = (st >> 1) * 16 + swz / 64; C = (st & 1) * 32 + (swz % 64) / 2; }
__host__ __device__ __forceinline__ int perm32(int rho) { const int n = rho >> 4, i = rho & 15; return 8 * (i >> 2) + 4 * n + (i & 3); }

struct Unit { int pm, pn; };
struct Gemm { const bf16_t* A; const bf16_t* Bt; int M, N, K; };

struct StaticOrder {
    int nM, nN, nwg, G, c;
    __host__ __device__ void init(int M, int N, int G_, int c_) { nM = M / BM; nN = N / BM; nwg = nM * nN; G = G_; c = c_; }
    __host__ __device__ bool next(int i, Unit& u) const {
        const long L = (long)i * G + c; if (L >= nwg) return false;
        int wgid = (int)L; { const int q = nwg / NXCD, r = nwg % NXCD, xcd = wgid % NXCD, off = wgid / NXCD; wgid = (xcd < r ? xcd * (q + 1) : r * (q + 1) + (xcd - r) * q) + off; }
        const int nig = WGM * nN, gid = wgid / nig, fm = gid * WGM, gsz = (nM - fm) < WGM ? (nM - fm) : WGM;
        u.pm = fm + ((wgid % nig) % gsz); u.pn = (wgid % nig) / gsz; return true;
    }
    __device__ __forceinline__ void a_ready(const Unit&) const {}
    __device__ __forceinline__ void done(const Unit&) const {}
};
__device__ __forceinline__ unsigned cvt_pk_bf16(float lo, float hi) { unsigned r; asm volatile("v_cvt_pk_bf16_f32 %0, %1, %2" : "=v"(r) : "v"(lo), "v"(hi)); return r; }
typedef float f32x2 __attribute__((ext_vector_type(2)));
template <class Epi, class Sched, bool ALIGN_EPI = false, bool SP2 = false>
__device__ __forceinline__ void gemm_phase(PG8_LAS unsigned char* lds, const Gemm g, const Sched& S, const Epi& E) {
    int tid_ = (int)threadIdx.x; asm volatile("" : "+v"(tid_));
    const int tid = tid_, wid = __builtin_amdgcn_readfirstlane(tid >> 6), lane = tid & 63, wr = wid >> 2, wc = wid & 3, fr = lane & 15, fq = lane >> 4;
    const int K = g.K, nt = K / BK;
    unsigned voffA[2], voffB[2];
#pragma unroll
    for (int i = 0; i < 2; ++i) { int R, C; stage_rc(tid * 16 + i * 8192, R, C); const int Rb = Epi::PERM ? ((R & ~31) + perm32(R & 31)) : R;
        voffA[i] = (unsigned)(R * K + C) * 2u; voffB[i] = (unsigned)(Rb * K + C) * 2u; }
    const size_t kstep = (size_t)(BK * 2);
    const size_t hstep = (size_t)HALF * K * 2;
    const size_t tstep = 2 * hstep;
    const unsigned ldsw = (unsigned)wid * 1024u;
    const int aoff = lds_byte(wr * 64 + fr, fq * 8), boff = lds_byte(wc * 32 + fr, fq * 8);
#define PG8_SA(b, h) (((b) * 2 + (h)) * HTB)
#define PG8_SB(b, h) ((4 + (b) * 2 + (h)) * HTB)
#define PG8_STAGE(bufoff, gbase, voff) do { _Pragma("unroll") for (int _i = 0; _i < 2; ++_i) \
        __builtin_amdgcn_global_load_lds((const unsigned*)((const char*)(gbase) + (voff)[_i]), (PG8_LAS unsigned*)(lds + (bufoff) + ldsw + _i * 8192), 16, 0, 0); } while (0)
#define PG8_LDA(dst, b, h) do { _Pragma("unroll") for (int m = 0; m < 4; ++m) _Pragma("unroll") for (int k = 0; k < 2; ++k) dst[m][k] = *(const PG8_LAS bf16x8*)(lds + PG8_SA(b, h) + aoff + m * 2048 + k * 1024); } while (0)
#define PG8_LDB(dst, b, h) do { _Pragma("unroll") for (int n = 0; n < 2; ++n) _Pragma("unroll") for (int k = 0; k < 2; ++k) dst[n][k] = *(const PG8_LAS bf16x8*)(lds + PG8_SB(b, h) + boff + n * 2048 + k * 1024); } while (0)
#define PG8_MMA(ai, bj, At, Bt) do { __builtin_amdgcn_s_setprio(1); _Pragma("unroll") for (int m = 0; m < 4; ++m) _Pragma("unroll") for (int n = 0; n < 2; ++n) _Pragma("unroll") for (int k = 0; k < 2; ++k) \
        acc[ai][bj][m][n] = __builtin_amdgcn_mfma_f32_16x16x32_bf16(Bt[n][k], At[m][k], acc[ai][bj][m][n], 0, 0, 0); __builtin_amdgcn_s_setprio(0); } while (0)
#define PG8_WAIT_V(n) asm volatile("s_waitcnt vmcnt(" #n ")" ::: "memory")
#define PG8_WAIT_L(n) asm volatile("s_waitcnt lgkmcnt(" #n ")" ::: "memory")
#define PG8_BAR __builtin_amdgcn_s_barrier()
#define PG8_SCHED __builtin_amdgcn_sched_barrier(0)
    Unit cur, nxt; int ui = 0;
    if (!S.next(0, cur)) return;
    f32x4 acc[2][2][4][2];
#pragma unroll
    for (int a = 0; a < 2; ++a)
#pragma unroll
        for (int b = 0; b < 2; ++b)
#pragma unroll
            for (int m = 0; m < 4; ++m)
#pragma unroll
                for (int n = 0; n < 2; ++n) acc[a][b][m][n] = (f32x4){0.f, 0.f, 0.f, 0.f};
    bf16x8 At[4][2], B0[2][2], B1[2][2];
    const char* cA = (const char*)g.A + (size_t)cur.pm * tstep; const char* cB = (const char*)g.Bt + (size_t)cur.pn * tstep;
    S.a_ready(cur);
    if constexpr (SP2) {
        PG8_STAGE(PG8_SB(0, 0), cB, voffB); PG8_STAGE(PG8_SB(0, 1), cB + hstep, voffB); PG8_STAGE(PG8_SA(0, 0), cA, voffA); PG8_STAGE(PG8_SA(0, 1), cA + hstep, voffA);
        if (wr == 1) PG8_BAR;
        PG8_WAIT_V(2); PG8_BAR;
        PG8_STAGE(PG8_SB(1, 0), cB + kstep, voffB); PG8_STAGE(PG8_SA(1, 0), cA + kstep, voffA); PG8_STAGE(PG8_SB(1, 1), cB + hstep + kstep, voffB);
        PG8_WAIT_V(6); PG8_BAR;
    } else {
        PG8_STAGE(PG8_SB(0, 0), cB, voffB); PG8_STAGE(PG8_SA(0, 0), cA, voffA); PG8_STAGE(PG8_SB(0, 1), cB + hstep, voffB); PG8_STAGE(PG8_SA(0, 1), cA + hstep, voffA);
        if (wr == 1) PG8_BAR;
        PG8_WAIT_V(4); PG8_BAR;
        PG8_STAGE(PG8_SB(1, 0), cB + kstep, voffB); PG8_STAGE(PG8_SA(1, 0), cA + kstep, voffA); PG8_STAGE(PG8_SB(1, 1), cB + hstep + kstep, voffB);
        PG8_WAIT_V(6); PG8_BAR;
    }
    for (;;) {
        const bool has_next = S.next(ui + 1, nxt);
        const char* nA = has_next ? (const char*)g.A + (size_t)nxt.pm * tstep : cA; const char* nB = has_next ? (const char*)g.Bt + (size_t)nxt.pn * tstep : cB;
        for (int t = 0; t < nt; t += 2) {
            const bool last = (t == nt - 2);
            const char* a1 = cA + (size_t)(t + 1) * kstep;
            const char* a2 = last ? nA : cA + (size_t)(t + 2) * kstep; const char* b2 = last ? nB : cB + (size_t)(t + 2) * kstep;
            const char* a3 = a2 + kstep; const char* b3 = b2 + kstep;
            if (last && has_next) S.a_ready(nxt);
            if constexpr (SP2) {
            PG8_LDB(B0, 0, 0); PG8_LDB(B1, 0, 1); PG8_SCHED; PG8_LDA(At, 0, 0); PG8_STAGE(PG8_SA(1, 1), a1 + hstep, voffA);
            PG8_WAIT_V(8); PG8_WAIT_L(0); PG8_BAR; PG8_MMA(0, 0, At, B0); PG8_MMA(0, 1, At, B1); PG8_BAR; PG8_SCHED;
            PG8_LDA(At, 0, 1); PG8_STAGE(PG8_SB(0, 0), b2, voffB); PG8_STAGE(PG8_SB(0, 1), b2 + hstep, voffB); PG8_STAGE(PG8_SA(0, 0), a2, voffA);
            PG8_WAIT_V(8); PG8_WAIT_L(0); PG8_BAR; PG8_MMA(1, 0, At, B0); PG8_MMA(1, 1, At, B1); PG8_BAR; PG8_SCHED;
            PG8_LDB(B0, 1, 0); PG8_LDB(B1, 1, 1); PG8_SCHED; PG8_LDA(At, 1, 0); PG8_STAGE(PG8_SA(0, 1), a2 + hstep, voffA);
            PG8_WAIT_V(8); PG8_WAIT_L(0); PG8_BAR; PG8_MMA(0, 0, At, B0); PG8_MMA(0, 1, At, B1); PG8_BAR; PG8_SCHED;
            PG8_LDA(At, 1, 1); PG8_STAGE(PG8_SB(1, 0), b3, voffB); PG8_STAGE(PG8_SB(1, 1), b3 + hstep, voffB); PG8_STAGE(PG8_SA(1, 0), a3, voffA);
            PG8_WAIT_V(8); PG8_WAIT_L(0); PG8_BAR; PG8_MMA(1, 0, At, B0); PG8_MMA(1, 1, At, B1); PG8_BAR; PG8_SCHED;
            } else {
            PG8_LDB(B0, 0, 0); PG8_SCHED; PG8_LDA(At, 0, 0); PG8_STAGE(PG8_SA(1, 1), a1 + hstep, voffA);
            PG8_WAIT_L(8); PG8_BAR; PG8_WAIT_L(0); PG8_MMA(0, 0, At, B0); PG8_BAR; PG8_SCHED;
            PG8_LDB(B1, 0, 1); PG8_STAGE(PG8_SB(0, 0), b2, voffB);
            PG8_BAR; PG8_WAIT_L(0); PG8_MMA(0, 1, At, B1); PG8_BAR;
            PG8_LDA(At, 0, 1); PG8_STAGE(PG8_SA(0, 0), a2, voffA);
            PG8_BAR; PG8_WAIT_L(0); PG8_MMA(1, 0, At, B0); PG8_BAR; PG8_SCHED;
            PG8_STAGE(PG8_SB(0, 1), b2 + hstep, voffB);
            PG8_WAIT_V(6); PG8_BAR; PG8_MMA(1, 1, At, B1); PG8_BAR;
            PG8_LDB(B0, 1, 0); PG8_SCHED; PG8_LDA(At, 1, 0); PG8_STAGE(PG8_SA(0, 1), a2 + hstep, voffA);
            PG8_WAIT_L(8); PG8_BAR; PG8_WAIT_L(0); PG8_MMA(0, 0, At, B0); PG8_BAR; PG8_SCHED;
            PG8_LDB(B1, 1, 1); PG8_STAGE(PG8_SB(1, 0), b3, voffB);
            PG8_BAR; PG8_WAIT_L(0); PG8_MMA(0, 1, At, B1); PG8_BAR;
            PG8_LDA(At, 1, 1); PG8_STAGE(PG8_SA(1, 0), a3, voffA);
            PG8_BAR; PG8_WAIT_L(0); PG8_MMA(1, 0, At, B0); PG8_BAR; PG8_SCHED;
            PG8_STAGE(PG8_SB(1, 1), b3 + hstep, voffB);
            PG8_WAIT_V(6); PG8_BAR; PG8_MMA(1, 1, At, B1); PG8_BAR;
            }
        }
        if constexpr (ALIGN_EPI) { if (wr == 0) PG8_BAR; }
        if constexpr (!Epi::AFTER_DRAIN) { E(acc, cur, wr, wc, fr, fq); S.done(cur); }
        if (!has_next) break;
#pragma unroll
        for (int a = 0; a < 2; ++a)
#pragma unroll
            for (int b = 0; b < 2; ++b)
#pragma unroll
                for (int m = 0; m < 4; ++m)
#pragma unroll
                    for (int n = 0; n < 2; ++n) acc[a][b][m][n] = (f32x4){0.f, 0.f, 0.f, 0.f};
        cur = nxt; cA = nA; cB = nB; ++ui;
        if constexpr (ALIGN_EPI) { if (wr == 1) PG8_BAR; }
    }
    PG8_WAIT_V(0);
    if constexpr (!ALIGN_EPI) { if (wr == 0) PG8_BAR; }
    PG8_BAR;
    if constexpr (Epi::AFTER_DRAIN) { E.fused(acc, cur, wr, wc, fr, fq, lds, wid, lane); S.done(cur); }
#undef PG8_SA
#undef PG8_SB
#undef PG8_STAGE
#undef PG8_LDA
#undef PG8_LDB
#undef PG8_MMA
#undef PG8_WAIT_V
#undef PG8_WAIT_L
#undef PG8_BAR
#undef PG8_SCHED
}
typedef int i32x4 __attribute__((ext_vector_type(4)));
template <class Epi, class Sched, bool ALIGN_EPI = false, bool SP2 = false>
__device__ __forceinline__ void gemm_phase_i8(PG8_LAS unsigned char* lds, const Gemm g, const Sched& S, const Epi& E) {
    int tid_ = (int)threadIdx.x; asm volatile("" : "+v"(tid_));
    const int tid = tid_, wid = __builtin_amdgcn_readfirstlane(tid >> 6), lane = tid & 63, wr = wid >> 2, wc = wid & 3, fr = lane & 15, fq = lane >> 4;
    const int K = g.K, nt = K / BK;
    unsigned voffA[2], voffB[2];
#pragma unroll
    for (int i = 0; i < 2; ++i) { int R, C; stage_rc(tid * 16 + i * 8192, R, C); const int Rb = Epi::PERM ? ((R & ~31) + perm32(R & 31)) : R;
        voffA[i] = (unsigned)(R * K + C) * 2u; voffB[i] = (unsigned)(Rb * K + C) * 2u; }
    const size_t kstep = (size_t)(BK * 2);
    const size_t hstep = (size_t)HALF * K * 2;
    const size_t tstep = 2 * hstep;
    const unsigned ldsw = (unsigned)wid * 1024u;
    const int aoff = lds_byte(wr * 64 + fr, fq * 8), boff = lds_byte(wc * 32 + fr, fq * 8);
#define PG8_SA(b, h) (((b) * 2 + (h)) * HTB)
#define PG8_SB(b, h) ((4 + (b) * 2 + (h)) * HTB)
#define PG8_STAGE(bufoff, gbase, voff) do { _Pragma("unroll") for (int _i = 0; _i < 2; ++_i) \
        __builtin_amdgcn_global_load_lds((const unsigned*)((const char*)(gbase) + (voff)[_i]), (PG8_LAS unsigned*)(lds + (bufoff) + ldsw + _i * 8192), 16, 0, 0); } while (0)
#define PG8_LDA(dst, b, h) do { _Pragma("unroll") for (int m = 0; m < 4; ++m) _Pragma("unroll") for (int k = 0; k < 2; ++k) dst[m][k] = *(const PG8_LAS bf16x8*)(lds + PG8_SA(b, h) + aoff + m * 2048 + k * 1024); } while (0)
#define PG8_LDB(dst, b, h) do { _Pragma("unroll") for (int n = 0; n < 2; ++n) _Pragma("unroll") for (int k = 0; k < 2; ++k) dst[n][k] = *(const PG8_LAS bf16x8*)(lds + PG8_SB(b, h) + boff + n * 2048 + k * 1024); } while (0)
#define PG8_MMA(ai, bj, At, Bt) do { __builtin_amdgcn_s_setprio(1); _Pragma("unroll") for (int m = 0; m < 4; ++m) _Pragma("unroll") for (int n = 0; n < 2; ++n) _Pragma("unroll") for (int k = 0; k < 2; ++k) \
        acc[ai][bj][m][n] = __builtin_amdgcn_mfma_i32_16x16x64_i8(__builtin_bit_cast(i32x4, Bt[n][k]), __builtin_bit_cast(i32x4, At[m][k]), acc[ai][bj][m][n], 0, 0, 0); __builtin_amdgcn_s_setprio(0); } while (0)
#define PG8_WAIT_V(n) asm volatile("s_waitcnt vmcnt(" #n ")" ::: "memory")
#define PG8_WAIT_L(n) asm volatile("s_waitcnt lgkmcnt(" #n ")" ::: "memory")
#define PG8_BAR __builtin_amdgcn_s_barrier()
#define PG8_SCHED __builtin_amdgcn_sched_barrier(0)
    Unit cur, nxt; int ui = 0;
    if (!S.next(0, cur)) return;
    i32x4 acc[2][2][4][2];
#pragma unroll
    for (int a = 0; a < 2; ++a)
#pragma unroll
        for (int b = 0; b < 2; ++b)
#pragma unroll
            for (int m = 0; m < 4; ++m)
#pragma unroll
                for (int n = 0; n < 2; ++n) acc[a][b][m][n] = (i32x4){0, 0, 0, 0};
    bf16x8 At[4][2], B0[2][2], B1[2][2];
    const char* cA = (const char*)g.A + (size_t)cur.pm * tstep; const char* cB = (const char*)g.Bt + (size_t)cur.pn * tstep;
    S.a_ready(cur);
    if constexpr (SP2) {
        PG8_STAGE(PG8_SB(0, 0), cB, voffB); PG8_STAGE(PG8_SB(0, 1), cB + hstep, voffB); PG8_STAGE(PG8_SA(0, 0), cA, voffA); PG8_STAGE(PG8_SA(0, 1), cA + hstep, voffA);
        if (wr == 1) PG8_BAR;
        PG8_WAIT_V(2); PG8_BAR;
        PG8_STAGE(PG8_SB(1, 0), cB + kstep, voffB); PG8_STAGE(PG8_SA(1, 0), cA + kstep, voffA); PG8_STAGE(PG8_SB(1, 1), cB + hstep + kstep, voffB);
        PG8_WAIT_V(6); PG8_BAR;
    } else {
        PG8_STAGE(PG8_SB(0, 0), cB, voffB); PG8_STAGE(PG8_SA(0, 0), cA, voffA); PG8_STAGE(PG8_SB(0, 1), cB + hstep, voffB); PG8_STAGE(PG8_SA(0, 1), cA + hstep, voffA);
        if (wr == 1) PG8_BAR;
        PG8_WAIT_V(4); PG8_BAR;
        PG8_STAGE(PG8_SB(1, 0), cB + kstep, voffB); PG8_STAGE(PG8_SA(1, 0), cA + kstep, voffA); PG8_STAGE(PG8_SB(1, 1), cB + hstep + kstep, voffB);
        PG8_WAIT_V(6); PG8_BAR;
    }
    for (;;) {
        const bool has_next = S.next(ui + 1, nxt);
        const char* nA = has_next ? (const char*)g.A + (size_t)nxt.pm * tstep : cA; const char* nB = has_next ? (const char*)g.Bt + (size_t)nxt.pn * tstep : cB;
        for (int t = 0; t < nt; t += 2) {
            const bool last = (t == nt - 2);
            const char* a1 = cA + (size_t)(t + 1) * kstep;
            const char* a2 = last ? nA : cA + (size_t)(t + 2) * kstep; const char* b2 = last ? nB : cB + (size_t)(t + 2) * kstep;
            const char* a3 = a2 + kstep; const char* b3 = b2 + kstep;
            if (last && has_next) S.a_ready(nxt);
            if constexpr (SP2) {
            PG8_LDB(B0, 0, 0); PG8_LDB(B1, 0, 1); PG8_SCHED; PG8_LDA(At, 0, 0); PG8_STAGE(PG8_SA(1, 1), a1 + hstep, voffA);
            PG8_WAIT_V(8); PG8_WAIT_L(0); PG8_BAR; PG8_MMA(0, 0, At, B0); PG8_MMA(0, 1, At, B1); PG8_BAR; PG8_SCHED;
            PG8_LDA(At, 0, 1); PG8_STAGE(PG8_SB(0, 0), b2, voffB); PG8_STAGE(PG8_SB(0, 1), b2 + hstep, voffB); PG8_STAGE(PG8_SA(0, 0), a2, voffA);
            PG8_WAIT_V(8); PG8_WAIT_L(0); PG8_BAR; PG8_MMA(1, 0, At, B0); PG8_MMA(1, 1, At, B1); PG8_BAR; PG8_SCHED;
            PG8_LDB(B0, 1, 0); PG8_LDB(B1, 1, 1); PG8_SCHED; PG8_LDA(At, 1, 0); PG8_STAGE(PG8_SA(0, 1), a2 + hstep, voffA);
            PG8_WAIT_V(8); PG8_WAIT_L(0); PG8_BAR; PG8_MMA(0, 0, At, B0); PG8_MMA(0, 1, At, B1); PG8_BAR; PG8_SCHED;
            PG8_LDA(At, 1, 1); PG8_STAGE(PG8_SB(1, 0), b3, voffB); PG8_STAGE(PG8_SB(1, 1), b3 + hstep, voffB); PG8_STAGE(PG8_SA(1, 0), a3, voffA);
            PG8_WAIT_V(8); PG8_WAIT_L(0); PG8_BAR; PG8_MMA(1, 0, At, B0); PG8_MMA(1, 1, At, B1); PG8_BAR; PG8_SCHED;
            } else {
            PG8_LDB(B0, 0, 0); PG8_SCHED; PG8_LDA(At, 0, 0); PG8_STAGE(PG8_SA(1, 1), a1 + hstep, voffA);
            PG8_WAIT_L(8); PG8_BAR; PG8_WAIT_L(0); PG8_MMA(0, 0, At, B0); PG8_BAR; PG8_SCHED;
            PG8_LDB(B1, 0, 1); PG8_STAGE(PG8_SB(0, 0), b2, voffB);
            PG8_BAR; PG8_WAIT_L(0); PG8_MMA(0, 1, At, B1); PG8_BAR;
            PG8_LDA(At, 0, 1); PG8_STAGE(PG8_SA(0, 0), a2, voffA);
            PG8_BAR; PG8_WAIT_L(0); PG8_MMA(1, 0, At, B0); PG8_BAR; PG8_SCHED;
            PG8_STAGE(PG8_SB(0, 1), b2 + hstep, voffB);
            PG8_WAIT_V(6); PG8_BAR; PG8_MMA(1, 1, At, B1); PG8_BAR;
            PG8_LDB(B0, 1, 0); PG8_SCHED; PG8_LDA(At, 1, 0); PG8_STAGE(PG8_SA(0, 1), a2 + hstep, voffA);
            PG8_WAIT_L(8); PG8_BAR; PG8_WAIT_L(0); PG8_MMA(0, 0, At, B0); PG8_BAR; PG8_SCHED;
            PG8_LDB(B1, 1, 1); PG8_STAGE(PG8_SB(1, 0), b3, voffB);
            PG8_BAR; PG8_WAIT_L(0); PG8_MMA(0, 1, At, B1); PG8_BAR;
            PG8_LDA(At, 1, 1); PG8_STAGE(PG8_SA(1, 0), a3, voffA);
            PG8_BAR; PG8_WAIT_L(0); PG8_MMA(1, 0, At, B0); PG8_BAR; PG8_SCHED;
            PG8_STAGE(PG8_SB(1, 1), b3 + hstep, voffB);
            PG8_WAIT_V(6); PG8_BAR; PG8_MMA(1, 1, At, B1); PG8_BAR;
            }
        }
        if constexpr (ALIGN_EPI) { if (wr == 0) PG8_BAR; }
        if constexpr (!Epi::AFTER_DRAIN) { E(acc, cur, wr, wc, fr, fq); S.done(cur); }
        if (!has_next) break;
#pragma unroll
        for (int a = 0; a < 2; ++a)
#pragma unroll
            for (int b = 0; b < 2; ++b)
#pragma unroll
                for (int m = 0; m < 4; ++m)
#pragma unroll
                    for (int n = 0; n < 2; ++n) acc[a][b][m][n] = (i32x4){0, 0, 0, 0};
        cur = nxt; cA = nA; cB = nB; ++ui;
        if constexpr (ALIGN_EPI) { if (wr == 1) PG8_BAR; }
    }
    PG8_WAIT_V(0);
    if constexpr (!ALIGN_EPI) { if (wr == 0) PG8_BAR; }
    PG8_BAR;
    if constexpr (Epi::AFTER_DRAIN) { E.fused(acc, cur, wr, wc, fr, fq, lds, wid, lane); S.done(cur); }
#undef PG8_SA
#undef PG8_SB
#undef PG8_STAGE
#undef PG8_LDA
#undef PG8_LDB
#undef PG8_MMA
#undef PG8_WAIT_V
#undef PG8_WAIT_L
#undef PG8_BAR
#undef PG8_SCHED
}
}

struct ProjOut { const float* rs1; const float* lbl; const float* ffb; bf16_t *QH, *LF, *VH, *GH, *FQ, *FK, *FV, *SGA, *SGB; float* LFF; };
DI float rs2_of(const float* SSQ, int row) {
    const f32x4* p = (const f32x4*)(SSQ + (size_t)row * 16); const f32x4 a = p[0], b = p[1], c = p[2], d = p[3];
    const float s = ((a[0] + a[1]) + (a[2] + a[3])) + ((b[0] + b[1]) + (b[2] + b[3])) + ((c[0] + c[1]) + (c[2] + c[3])) + ((d[0] + d[1]) + (d[2] + d[3]));
    return 1.0f / sqrtf(s * (1.0f / kD) + kEps);
}
constexpr int HG_TSTR = 144;
constexpr int HG_KSTR = 272;
DI void hg_load_vt(const bf16_t* VHc  , LAS unsigned char* vt) {
    const int tid = VTID, s = tid & 63, vq = tid >> 6;
#pragma unroll
    for (int i = 0; i < 4; ++i) {
        const int vc = 8 * (vq + 4 * i);
        const uint4 u = *(const uint4*)(VHc + (size_t)s * 512 + vc);
        const unsigned w[4] = {u.x, u.y, u.z, u.w};
#pragma unroll
        for (int j = 0; j < 4; ++j) {
            *(LAS unsigned short*)(vt + (vc + 2 * j) * HG_TSTR + s * 2) = (unsigned short)(w[j] & 0xffffu);
            *(LAS unsigned short*)(vt + (vc + 2 * j + 1) * HG_TSTR + s * 2) = (unsigned short)(w[j] >> 16);
        }
    }
}
DI void ph_hgrn1(const bf16_t* LF, const bf16_t* VH, bf16_t* ST, float* DC, int bid, int nblk, LAS unsigned char* lds) {
    LAS unsigned char* klt = lds;
    LAS unsigned char* vt = lds + 128 * HG_TSTR;
    LAS float* tot = (LAS float*)(lds + 256 * HG_TSTR);
    const int tid = VTID, k = tid & 127, half = tid >> 7; const LaneId li = lane_id();
    for (int ib = 0; ib < 2048; ib += nblk) {
        const int item = ib + bid;
        const int c = item & 63, bh = item >> 6, b = bh >> 2, h = bh & 3;
        const size_t rowbase = (size_t)(b * kS + c * 64) * 512 + h * 128;
        __syncthreads();
        float lf[32], cum[32];
        { float run = 0.f;
#pragma unroll
          for (int i = 0; i < 32; ++i) { lf[i] = bf2f(LF[rowbase + (size_t)(32 * half + i) * 512 + k]); run += lf[i]; cum[i] = run; }
          tot[half * 128 + k] = run; }
        hg_load_vt(VH + rowbase, vt);
        __syncthreads();
        {
            const float t0 = tot[k], t1 = tot[128 + k], r4 = t0 + t1, base = half ? t0 : 0.f;
            unsigned w[16];
#pragma unroll
            for (int i = 0; i < 32; i += 2) {
                const float a0 = (1.f - __builtin_amdgcn_exp2f(lf[i])) * __builtin_amdgcn_exp2f(r4 - (base + cum[i]));
                const float a1 = (1.f - __builtin_amdgcn_exp2f(lf[i + 1])) * __builtin_amdgcn_exp2f(r4 - (base + cum[i + 1]));
                w[i >> 1] = cvtpk(a0, a1);
            }
#pragma unroll
            for (int i = 0; i < 4; ++i) *(LAS u32x4*)(klt + k * HG_TSTR + half * 64 + i * 16) = (u32x4){w[4 * i], w[4 * i + 1], w[4 * i + 2], w[4 * i + 3]};
            if (half == 0) DC[(size_t)item * 128 + k] = __builtin_amdgcn_exp2f(r4);
        }
        __syncthreads();
        f32x4 acc[4][4]; acc_zero(acc);
#pragma unroll
        for (int ks = 0; ks < 2; ++ks) {
            bf16x8 af[4], bfr[4];
#pragma unroll
            for (int m = 0; m < 4; ++m) af[m] = *(const LAS bf16x8*)(vt + (li.wr * 64 + m * 16 + li.fr) * HG_TSTR + ks * 64 + li.fq * 16);
#pragma unroll
            for (int n = 0; n < 4; ++n) bfr[n] = *(const LAS bf16x8*)(klt + (li.wc * 64 + n * 16 + li.fr) * HG_TSTR + ks * 64 + li.fq * 16);
#pragma unroll
            for (int m = 0; m < 4; ++m)
#pragma unroll
                for (int n = 0; n < 4; ++n) acc[m][n] = __builtin_amdgcn_mfma_f32_16x16x32_bf16(bfr[n], af[m], acc[m][n], 0, 0, 0);
        }
        bf16_t* dst = ST + (size_t)item * 16384;
#pragma unroll
        for (int m = 0; m < 4; ++m)
#pragma unroll
            for (int n = 0; n < 4; ++n) store_bf4(dst + (li.wr * 64 + m * 16 + li.fr) * 128 + li.wc * 64 + n * 16 + li.fq * 4, acc[m][n]);
    }
}
DI void ph_hgrn2(bf16_t* ST, const float* DC, int bid, int nblk) {
    for (int u = bid * 256 + VTID; u < 32 * 2048; u += nblk * 256) {
        const int bh = u >> 11, vk = u & 2047, k8 = (vk & 15) * 8;
        float S[8];
#pragma unroll
        for (int j = 0; j < 8; ++j) S[j] = 0.f;
        bf16_t* p = ST + (size_t)bh * 64 * 16384 + (size_t)vk * 8;
        const float* d = DC + (size_t)bh * 64 * 128 + k8;
#pragma unroll 8
        for (int c = 0; c < 64; ++c) {
            const uint4 lt = *(const uint4*)(p + (size_t)c * 16384);
            const float4 d0 = *(const float4*)(d + c * 128), d1 = *(const float4*)(d + c * 128 + 4);
            *(uint4*)(p + (size_t)c * 16384) = make_uint4(cvtpk(S[0], S[1]), cvtpk(S[2], S[3]), cvtpk(S[4], S[5]), cvtpk(S[6], S[7]));
            const float dd[8] = {d0.x, d0.y, d0.z, d0.w, d1.x, d1.y, d1.z, d1.w};
            const unsigned lw[4] = {lt.x, lt.y, lt.z, lt.w};
#pragma unroll
            for (int j = 0; j < 4; ++j) { S[2 * j] = dd[2 * j] * S[2 * j] + __uint_as_float(lw[j] << 16); S[2 * j + 1] = dd[2 * j + 1] * S[2 * j + 1] + __uint_as_float(lw[j] & 0xffff0000u); }
        }
    }
}
DI bf16x8 hg_scale_frag(bf16x8 q, const LAS float* ra, const LAS float* rb  ) {
    const f32x4 a0 = *(const LAS f32x4*)ra, a1 = *(const LAS f32x4*)(ra + 4);
    f32x4 b0 = (f32x4){0.f, 0.f, 0.f, 0.f}, b1 = b0;
    if (rb) { b0 = *(const LAS f32x4*)rb; b1 = *(const LAS f32x4*)(rb + 4); }
    const u32x4 u = __builtin_bit_cast(u32x4, q);
    unsigned w[4];
#pragma unroll
    for (int j = 0; j < 4; ++j) {
        const float ea = (j < 2) ? a0[2 * j] - b0[2 * j] : a1[2 * j - 4] - b1[2 * j - 4];
        const float eb = (j < 2) ? a0[2 * j + 1] - b0[2 * j + 1] : a1[2 * j - 3] - b1[2 * j - 3];
        w[j] = cvtpk(__uint_as_float(u[j] << 16) * __builtin_amdgcn_exp2f(ea), __uint_as_float(u[j] & 0xffff0000u) * __builtin_amdgcn_exp2f(eb));
    }
    return __builtin_bit_cast(bf16x8, (u32x4){w[0], w[1], w[2], w[3]});
}
constexpr int HG3_QH = 0, HG3_KE = 64 * HG_KSTR, HG3_VT = 128 * HG_KSTR, HG3_AM = HG3_VT + 128 * HG_TSTR, HG3_R = HG3_AM + 64 * HG_TSTR, HG3_TOT = HG3_R + 5 * 512, HG3_BYTES = HG3_TOT + 1024;
DI void ph_hgrn3(const bf16_t* QH, const bf16_t* LF, const bf16_t* VH, const bf16_t* GH, const bf16_t* ST, const float* normw, bf16_t* Aout, int bid, int nblk, LAS unsigned char* lds) {
    LAS unsigned char* qh = lds + HG3_QH; LAS unsigned char* ke = lds + HG3_KE; LAS unsigned char* vt = lds + HG3_VT; LAS unsigned char* am = lds + HG3_AM;
    LAS float* R = (LAS float*)(lds + HG3_R); LAS float* tot = (LAS float*)(lds + HG3_TOT);
    const int tid = VTID, k = tid & 127, half = tid >> 7, lane = tid & 63, I = tid >> 6, fr = lane & 15, fq = lane >> 4;
    for (int ib = 0; ib < 2048; ib += nblk) {
        const int item = ib + bid;
        const int c = item & 63, bh = item >> 6, b = bh >> 2, h = bh & 3;
        const size_t rowbase = (size_t)(b * kS + c * 64) * 512 + h * 128;
        uint4 stg[8];
#pragma unroll
        for (int i = 0; i < 8; ++i) stg[i] = *(const uint4*)(ST + (size_t)item * 16384 + (size_t)(tid + 256 * i) * 8);
        __syncthreads();
        float lf[32], cum[32];
        { float run = 0.f;
#pragma unroll
          for (int i = 0; i < 32; ++i) { lf[i] = bf2f(LF[rowbase + (size_t)(32 * half + i) * 512 + k]); run += lf[i]; cum[i] = run; }
          tot[half * 128 + k] = run; }
        hg_load_vt(VH + rowbase, vt);
        __syncthreads();
        {
            const float t0 = tot[k], base = half ? t0 : 0.f;
            const float rmid = base + cum[15], rend = base + cum[31];
            if (half == 0) { R[k] = 0.f; R[128 + k] = rmid; R[256 + k] = rend; } else { R[384 + k] = rmid; R[512 + k] = rend; }
#pragma unroll
            for (int i = 0; i < 32; ++i) {
                const float cf_ = base + cum[i], rI = (i < 16) ? base : rmid, rI1 = (i < 16) ? rmid : rend;
                const float qv = bf2f(QH[rowbase + (size_t)(32 * half + i) * 512 + k]);
                const float qhv = qv * __builtin_amdgcn_exp2f(cf_ - rI);
                const float kev = (1.f - __builtin_amdgcn_exp2f(lf[i])) * __builtin_amdgcn_exp2f(rI1 - cf_);
                *(LAS unsigned short*)(qh + (32 * half + i) * HG_KSTR + k * 2) = (unsigned short)(cvtpk(qhv, 0.f) & 0xffffu);
                *(LAS unsigned short*)(ke + (32 * half + i) * HG_KSTR + k * 2) = (unsigned short)(cvtpk(kev, 0.f) & 0xffffu);
            }
        }
        __syncthreads();
        bf16x8 qf[4];
#pragma unroll
        for (int ks = 0; ks < 4; ++ks) qf[ks] = *(const LAS bf16x8*)(qh + (16 * I + fr) * HG_KSTR + ks * 64 + fq * 16);
        for (int J = 0; J <= I; ++J) {
            f32x4 d = (f32x4){0.f, 0.f, 0.f, 0.f};
#pragma unroll
            for (int ks = 0; ks < 4; ++ks) {
                const bf16x8 kf = *(const LAS bf16x8*)(ke + (16 * J + fr) * HG_KSTR + ks * 64 + fq * 16);
                const bf16x8 qs = (J == I - 1) ? qf[ks] : hg_scale_frag(qf[ks], R + I * 128 + ks * 32 + fq * 8, R + (J + 1) * 128 + ks * 32 + fq * 8);
                d = __builtin_amdgcn_mfma_f32_16x16x32_bf16(kf, qs, d, 0, 0, 0);
            }
            if (J == I) {
#pragma unroll
                for (int j = 0; j < 4; ++j) if (4 * fq + j > fr) d[j] = 0.f;
            }
            *(LAS u32x2*)(am + (16 * I + fr) * HG_TSTR + (16 * J + 4 * fq) * 2) = (u32x2){cvtpk(d[0], d[1]), cvtpk(d[2], d[3])};
        }
        if ((I & 1) == 0) *(LAS u32x2*)(am + (16 * I + fr) * HG_TSTR + (16 * (I + 1) + 4 * fq) * 2) = (u32x2){0u, 0u};
        f32x4 o[8];
#pragma unroll
        for (int n = 0; n < 8; ++n) o[n] = (f32x4){0.f, 0.f, 0.f, 0.f};
        for (int ks = 0; ks <= (I >> 1); ++ks) {
            const bf16x8 af = *(const LAS bf16x8*)(am + (16 * I + fr) * HG_TSTR + ks * 64 + fq * 16);
#pragma unroll
            for (int n = 0; n < 8; ++n) { const bf16x8 vf = *(const LAS bf16x8*)(vt + (n * 16 + fr) * HG_TSTR + ks * 64 + fq * 16); o[n] = __builtin_amdgcn_mfma_f32_16x16x32_bf16(vf, af, o[n], 0, 0, 0); }
        }
        __syncthreads();
#pragma unroll
        for (int i = 0; i < 8; ++i) { const int pc = tid + 256 * i, row = pc >> 4, ch = pc & 15;
            *(LAS u32x4*)(lds + HG3_QH + row * 256 + ((ch ^ (row & 15)) << 4)) = (u32x4){stg[i].x, stg[i].y, stg[i].z, stg[i].w}; }
        __syncthreads();
#pragma unroll
        for (int ks = 0; ks < 4; ++ks) {
            const bf16x8 qc = hg_scale_frag(qf[ks], R + I * 128 + ks * 32 + fq * 8, nullptr);
#pragma unroll
            for (int n = 0; n < 8; ++n) { const bf16x8 sf = *(const LAS bf16x8*)(lds + HG3_QH + (n * 16 + fr) * 256 + (((ks * 4 + fq) ^ fr) << 4)); o[n] = __builtin_amdgcn_mfma_f32_16x16x32_bf16(sf, qc, o[n], 0, 0, 0); }
        }
        float ss = 0.f;
#pragma unroll
        for (int n = 0; n < 8; ++n) ss += o[n][0] * o[n][0] + o[n][1] * o[n][1] + o[n][2] * o[n][2] + o[n][3] * o[n][3];
        ss += __shfl_xor(ss, 16); ss += __shfl_xor(ss, 32);
        const float rstd = 1.0f / sqrtf(ss * (1.0f / 128.f) + kEps);
        const size_t orow = rowbase + (size_t)(16 * I + fr) * 512;
#pragma unroll
        for (int n = 0; n < 8; ++n) {
            const int v0 = n * 16 + 4 * fq;
            const f32x4 g = load_bf4(GH + orow + v0); const f32x4 w = *(const f32x4*)(normw + h * 128 + v0);
            store_bf4(Aout + orow + v0, o[n] * rstd * w * g);
        }
    }
}

DI void ph_cfox(const float* LFF, float* cf, bf16_t* aug, int bid, int nblk, float* sm) {
    const int tid = VTID, lane = tid & 63, wid = tid >> 6;
    for (int seq = bid; seq < 64; seq += nblk) {
        const int b = seq >> 3, h = seq & 7;
        float v[16]; float run = 0.f;
#pragma unroll
        for (int i = 0; i < 16; ++i) { run += LFF[(size_t)(b * kS + tid * 16 + i) * 8 + h]; v[i] = run; }
        float inc = run;
#pragma unroll
        for (int o = 1; o < 64; o <<= 1) { const float n = __shfl_up(inc, o); if (lane >= o) inc += n; }
        __syncthreads();
        if (lane == 63) sm[wid] = inc;
        __syncthreads();
        float base = inc - run;
        for (int w = 0; w < wid; ++w) base += sm[w];
#pragma unroll
        for (int i = 0; i < 16; i += 4) *(float4*)(cf + (size_t)seq * kS + tid * 16 + i) = make_float4(base + v[i], base + v[i + 1], base + v[i + 2], base + v[i + 3]);
#pragma unroll
        for (int i = 0; i < 16; ++i) {
            const float xx = -(base + v[i]); const unsigned b1 = cvtpk(xx, 0.f) & 0xffffu; const float r1 = xx - __uint_as_float(b1 << 16);
            const unsigned b2 = cvtpk(r1, 0.f) & 0xffffu; const float r2 = r1 - __uint_as_float(b2 << 16); const unsigned b3 = cvtpk(r2, 0.f) & 0xffffu;
            *(uint4*)(aug + ((size_t)seq * kS + tid * 16 + i) * 8) = make_uint4(b1 | (b2 << 16), b3 | 0xBF800000u, 0xBF80BF80u, 0u);
        }
    }
}
DI float max3f(float a, float b, float c) { float r; asm("v_max3_f32 %0, %1, %2, %3" : "=v"(r) : "v"(a), "v"(b), "v"(c)); return r; }
DI float max2f(float a, float b) { float r; asm("v_max_f32_e32 %0, %1, %2" : "=v"(r) : "v"(a), "v"(b)); return r; }
typedef float f32x16 __attribute__((ext_vector_type(16)));
typedef short s16x4 __attribute__((ext_vector_type(4)));
namespace at64 {
using bf16 = bf16_t;
constexpr int SEQ = kS, NHEAD = 8, D = 64, DM = NHEAD * D;
constexpr int NW = 8, QBLK = 32, QB = QBLK * NW, KVBLK = 64, NQB = SEQ / QB;
constexpr float C2 = 1.0f;
constexpr int SLOTB = 8192, LDS_K = 0, LDS_V = 3 * SLOTB, LDS_WS = 6 * SLOTB, LDS_OST = LDS_WS + NW * 256, LDS_AUG = LDS_OST + NW * 4096, LDS_BYTES = LDS_AUG + SEQ * 16;
#define ATTN64_THR 8
#define ATTN64_BROKEN 0
#define SBAR() __builtin_amdgcn_sched_barrier(0)
#define PIN(x) asm volatile("" : "+v"(x))
#define MFMA(a, b, c) __builtin_amdgcn_mfma_f32_32x32x16_bf16(a, b, c, 0, 0, 0)
#define WAIT_BAR(N) asm volatile("s_waitcnt vmcnt(" #N ") lgkmcnt(0)\n\ts_barrier" ::: "memory")

__device__ __forceinline__ int crow(int r, int hi) { return (r & 3) + 8 * (r >> 2) + 4 * hi; }
__device__ __forceinline__ unsigned cvtpk(float lo, float hi) { unsigned r; asm("v_cvt_pk_bf16_f32 %0, %1, %2" : "=v"(r) : "v"(lo), "v"(hi)); return r; }
__device__ __forceinline__ void glds16(const void* sbase, unsigned voff, unsigned lds_base) {
    unsigned sv; asm volatile("s_mov_b32 %0, m0\n\ts_mov_b32 m0, %3\n\ts_nop 0\n\tglobal_load_lds_dwordx4 %1, %2\n\ts_mov_b32 m0, %0" : "=&s"(sv) : "v"(voff), "s"(sbase), "s"(lds_base) : "memory"); }
typedef __attribute__((address_space(3))) const char* lds_cptr;
typedef short v4i16_t __attribute__((ext_vector_type(4)));
__device__ __forceinline__ void kload2(bf16x8* kf, lds_cptr kp, int d0) { kf[2 * d0] = *(const __attribute__((address_space(3))) bf16x8*)(kp + d0 * 2048); kf[2 * d0 + 1] = *(const __attribute__((address_space(3))) bf16x8*)(kp + d0 * 2048 + 512); }
__device__ __forceinline__ s16x4 vtr(lds_cptr p) { return __builtin_bit_cast(s16x4, __builtin_amdgcn_ds_read_tr16_b64_v4i16((__attribute__((address_space(3))) v4i16_t*)p)); }
#define MX3(a, b, c) __builtin_fmaxf(__builtin_fmaxf((a), (b)), (c))
__device__ __forceinline__ float rowmax(const f32x16& p0, const f32x16& p1) {
    float a = MX3(p0[0], p0[1], p1[0]), b = MX3(p0[2], p0[3], p1[1]); a = MX3(a, p1[2], p1[3]);
#pragma unroll
    for (int r = 4; r < 16; r += 4) { a = MX3(a, p0[r], p0[r + 1]); b = MX3(b, p0[r + 2], p0[r + 3]); a = MX3(a, p1[r], p1[r + 1]); b = MX3(b, p1[r + 2], p1[r + 3]); }
    float m = __builtin_fmaxf(a, b); auto rr = __builtin_amdgcn_permlane32_swap(__float_as_uint(m), __float_as_uint(m), false, false);
    return __builtin_fmaxf(__uint_as_float(rr[0]), __uint_as_float(rr[1])); }
__device__ __forceinline__ void cmask(f32x16& p0, f32x16& p1, int jb, int qrel, int hi) {
    const int kb = 64 * jb + 4 * hi;
#pragma unroll
    for (int r = 0; r < 16; ++r) { const int kv = kb + (r & 3) + 8 * (r >> 2); if (kv > qrel) p0[r] = -INFINITY; if (kv + 32 > qrel) p1[r] = -INFINITY; } }

__device__ __forceinline__ void attn64_unit(int b, int h, int qb, bool fill, const bf16* Q, const bf16* __restrict__ K, const bf16* __restrict__ V, const bf16* __restrict__ AUG, bf16* O, char* lds) {
    const int tid = threadIdx.x, lane = tid & 63, r32 = lane & 31, hi = lane >> 5; const int wid = __builtin_amdgcn_readfirstlane(tid >> 6);
    const long rowbase = (long)b * SEQ; const int q0 = qb * QB, NT = (q0 + QB) / KVBLK;
    const bf16* Qw = Q + (rowbase + q0 + wid * QBLK) * DM + h * D;
    const unsigned lds0 = (unsigned)(uintptr_t)lds; float* wsf = (float*)(lds + LDS_WS) + wid * 64;
    if (fill) { const char* ag = (const char*)(AUG + ((long)(b * NHEAD + h) * SEQ) * 8); const int nby = (q0 + QB) * 16;
      for (int of = tid * 16; of < nby; of += 64 * NW * 16) *(__attribute__((address_space(3))) u32x4*)((lds_cptr)lds + LDS_AUG + of) = *(const u32x4*)(ag + of); }
    const lds_cptr augp = (lds_cptr)lds + LDS_AUG + r32 * 16;
    bf16x8 qaug = __builtin_bit_cast(bf16x8, (u32x4){hi == 0 ? 0x3F803F80u : 0u, hi == 0 ? 0x00003F80u : 0u, 0u, 0u});
    float mf = 0.f;
#define SETQ() do { const unsigned m1_ = cvtpk(mf, 0.f) & 0xffffu; const float r1_ = mf - __uint_as_float(m1_ << 16); const unsigned m2_ = cvtpk(r1_, 0.f) & 0xffffu; \
        const float r2_ = r1_ - __uint_as_float(m2_ << 16); const unsigned m3_ = cvtpk(r2_, 0.f) & 0xffffu; \
        qaug = __builtin_bit_cast(bf16x8, (u32x4){hi == 0 ? 0x3F803F80u : 0u, hi == 0 ? (0x3F80u | (m1_ << 16)) : 0u, hi == 0 ? (m2_ | (m3_ << 16)) : 0u, 0u}); } while (0)
    bf16x8 ka0, ka1;
#define KAR(st) do { ka0 = *(const __attribute__((address_space(3))) bf16x8*)(augp + (NT - 1 - (st)) * 1024); ka1 = *(const __attribute__((address_space(3))) bf16x8*)(augp + (NT - 1 - (st)) * 1024 + 512); } while (0)
#define KAF(v) (v)
    const bf16* kbase = K + rowbase * DM + h * D + wid * 8; const unsigned koff = (unsigned)lane * (DM * 2);
    const bf16* vbase = V + rowbase * DM + h * D + (long)(16 * (wid & 3)) * DM + (wid >> 2) * 32; const unsigned voff = (unsigned)((lane >> 2) * (DM * 2) + (lane & 3) * 16);
    const unsigned kdst = lds0 + LDS_K + wid * 1024, vdst = lds0 + LDS_V + wid * 1024;
#define DMA_K(t, slot) glds16(kbase + (long)(NT - 1 - (t)) * KVBLK * DM, koff, (unsigned)__builtin_amdgcn_readfirstlane(kdst + (slot)))
#define DMA_V(t, slot) glds16(vbase + (long)(NT - 1 - (t)) * KVBLK * DM, voff, (unsigned)__builtin_amdgcn_readfirstlane(vdst + (slot)))
    const lds_cptr vp0 = (lds_cptr)lds + LDS_V + ((lane >> 4) & 1) * 32 + (lane & 3) * 8 + (4 * hi + ((lane & 15) >> 2)) * 64;
    const lds_cptr kp0 = (lds_cptr)lds + LDS_K + hi * 1024 + r32 * 16;
    DMA_K(0, 0); DMA_V(0, 0); DMA_K(1, SLOTB);
    bf16x8 qr[4];
#pragma unroll
    for (int d0 = 0; d0 < 4; ++d0) qr[d0] = *reinterpret_cast<const bf16x8*>(&Qw[(long)r32 * DM + d0 * 16 + hi * 8]);
    float mhat = 0.f, l_reg = 0.f; f32x16 o[2]; o[0] = f32x16{}; o[1] = f32x16{};
    const f32x16 zero16 = f32x16{};
    const int qrel = wid * QBLK + r32; bool resc = false;
    f32x16 pA0, pA1, pB0, pB1; bf16x8 kf[8]; s16x4 vlo[8], vhi[8]; u32x4 pw0, pw1, pw2, pw3;
    int sl_prev = 0, sl_cur = 0, sl_next = SLOTB;
#define ROT() do { sl_prev = sl_cur; sl_cur = sl_next; sl_next = (sl_next == 2 * SLOTB) ? 0 : sl_next + SLOTB; } while (0)
#define EX0(v) __builtin_amdgcn_exp2f(__builtin_fmaf((v), C2, nmh))
#define EX(v) __builtin_amdgcn_exp2f(v)
#define RESC() do { if (resc && !ATTN64_BROKEN) { _Pragma("unroll") for (int d_ = 0; d_ < 2; ++d_) _Pragma("unroll") for (int r = 0; r < 16; ++r) o[d_][r] *= wsf[crow(r, hi)]; } } while (0)
    DMA_K(2, 2 * SLOTB);
    WAIT_BAR(3);
    _Pragma("unroll") for (int d0 = 0; d0 < 4; ++d0) kload2(kf, kp0, d0);
    pA0 = MFMA(kf[0], qr[0], zero16); pA1 = MFMA(kf[1], qr[0], zero16); pA0 = MFMA(kf[2], qr[1], pA0); pA1 = MFMA(kf[3], qr[1], pA1);
    pA0 = MFMA(kf[4], qr[2], pA0); pA1 = MFMA(kf[5], qr[2], pA1); pA0 = MFMA(kf[6], qr[3], pA0); pA1 = MFMA(kf[7], qr[3], pA1);
    KAR(0); pA0 = MFMA(KAF(ka0), qaug, pA0); pA1 = MFMA(KAF(ka1), qaug, pA1);
    cmask(pA0, pA1, 3, qrel, hi);
    { const float rm = rowmax(pA0, pA1); mhat = __builtin_fmaxf(rm, -1e30f) * C2; const float nmh = -mhat;
#pragma unroll
      for (int r = 0; r < 16; ++r) { pA0[r] = EX0(pA0[r]); pA1[r] = EX0(pA1[r]); }
      mf = (mhat < -0.5e30f) ? 0.f : mhat; SETQ(); }
    WAIT_BAR(0);
    DMA_K(3, 0); DMA_V(1, SLOTB); ROT();
    _Pragma("unroll") for (int d0 = 0; d0 < 4; ++d0) kload2(kf, kp0 + sl_cur, d0);
    WAIT_BAR(2);
#define PKW(P, i) cvtpk(P[i], P[i + 1])
#define PAF(k) __builtin_bit_cast(bf16x8, pw##k)
#define VFR(i) (bf16x8){vlo[i][0], vlo[i][1], vlo[i][2], vlo[i][3], vhi[i][0], vhi[i][1], vhi[i][2], vhi[i][3]}
#define VRD(i) do { vlo[i] = vtr(vp_ + (((i) >> 2) * 4096 + ((i) & 3) * 1024)); vhi[i] = vtr(vp_ + (((i) >> 2) * 4096 + ((i) & 3) * 1024 + 512)); } while (0)
#define KRD(G, d0) do { if (G) { kload2(kf, kp0 + sl_next, d0); SBAR(); } } while (0)
#define GAPA(MF, a0, a1, a2, a3, W0, W1, PW) do { MF; sacc += a0; sacc += a1; sacc += a2; sacc += a3; W0; W1; PIN(PW); PIN(sacc); SBAR(); } while (0)
#define GAPB(MF, X, i) do { MF; X[i] = EX(X[i]); X[i + 1] = EX(X[i + 1]); X[i + 2] = EX(X[i + 2]); X[i + 3] = EX(X[i + 3]); PIN(X); SBAR(); } while (0)
#define STEP(C0, C1, P0, P1, t, MASK, GK, GV, GL) do { SBAR(); \
    const lds_cptr vp_ = vp0 + sl_prev; \
    VRD(0); SBAR(); float sacc = P0[0] + P0[1];                                                                                                       \
                    GAPA(C0 = MFMA(kf[0], qr[0], zero16), P0[2], P0[3], P0[4], P0[5],     pw0[0] = PKW(P0, 0),  pw0[1] = PKW(P0, 2),  pw0); \
    VRD(4); SBAR(); GAPA(C1 = MFMA(kf[1], qr[0], zero16), P0[6], P0[7], P0[8], P0[9],     pw0[2] = PKW(P0, 4),  pw0[3] = PKW(P0, 6),  pw0); \
    VRD(1); SBAR(); GAPA(C0 = MFMA(kf[2], qr[1], C0),    P0[10], P0[11], P0[12], P0[13], pw1[0] = PKW(P0, 8),  pw1[1] = PKW(P0, 10), pw1); \
    VRD(5); SBAR(); GAPA(C1 = MFMA(kf[3], qr[1], C1),    P0[14], P0[15], P1[0], P1[1],   pw1[2] = PKW(P0, 12), pw1[3] = PKW(P0, 14), pw1); \
    VRD(2); SBAR(); GAPA(C0 = MFMA(kf[4], qr[2], C0),    P1[2], P1[3], P1[4], P1[5],     pw2[0] = PKW(P1, 0),  pw2[1] = PKW(P1, 2),  pw2); \
    KAR(t); SBAR();                                                                                                                                    \
    VRD(6); SBAR(); GAPA(C1 = MFMA(kf[5], qr[2], C1),    P1[6], P1[7], P1[8], P1[9],     pw2[2] = PKW(P1, 4),  pw2[3] = PKW(P1, 6),  pw2); \
    VRD(3); SBAR(); GAPA(C0 = MFMA(kf[6], qr[3], C0),    P1[10], P1[11], P1[12], P1[13], pw3[0] = PKW(P1, 8),  pw3[1] = PKW(P1, 10), pw3); \
    VRD(7); SBAR(); GAPA(C1 = MFMA(kf[7], qr[3], C1),    P1[14], P1[15], 0.f, 0.f,       pw3[2] = PKW(P1, 12), pw3[3] = PKW(P1, 14), pw3); \
    C0 = MFMA(KAF(ka0), qaug, C0); C1 = MFMA(KAF(ka1), qaug, C1); SBAR();                                                  \
    l_reg += sacc; \
    if (GK) DMA_K((t) + 3, sl_cur); if (GV) DMA_V((t) + 1, sl_next);                                                       \
    if ((t) <= 3) cmask(C0, C1, 3 - (t), qrel, hi);                                                                         \
    { const float rmx = rowmax(C0, C1), rm = rmx + (mf - mhat); resc = false;                                               \
      if (__builtin_expect(__any(rm > (float)ATTN64_THR), 0)) { const float dl = __builtin_fmaxf(rm, 0.f);                    \
          const float mnew = (mhat < -0.5e30f) ? ((dl > 0.f) ? rmx + mf : mhat) : mhat + dl; \
          const float f = __builtin_amdgcn_exp2f(-dl); l_reg *= f; if (hi == 0) wsf[r32] = f; resc = true; \
          const float mfn = (mnew < -0.5e30f) ? 0.f : mnew, adj = mfn - mf;                                                   \
          _Pragma("unroll") for (int r = 0; r < 16; ++r) { C0[r] -= adj; C1[r] -= adj; } \
          mhat = mnew; mf = mfn; SETQ(); } } \
    SBAR(); \
    GAPB(o[0] = MFMA(PAF(0), VFR(0), o[0]), C0, 0);              GAPB(o[1] = MFMA(PAF(0), VFR(4), o[1]), C0, 4); \
    KRD(GL, 0); GAPB(o[0] = MFMA(PAF(1), VFR(1), o[0]), C0, 8);  KRD(GL, 1); GAPB(o[1] = MFMA(PAF(1), VFR(5), o[1]), C0, 12);                                     \
    KRD(GL, 2); GAPB(o[0] = MFMA(PAF(2), VFR(2), o[0]), C1, 0);  KRD(GL, 3); GAPB(o[1] = MFMA(PAF(2), VFR(6), o[1]), C1, 4); \
    GAPB(o[0] = MFMA(PAF(3), VFR(3), o[0]), C1, 8);              GAPB(o[1] = MFMA(PAF(3), VFR(7), o[1]), C1, 12); \
    } while (0)
    int t = 1;
    for (; t + 5 < NT; t += 2) {
        STEP(pB0, pB1, pA0, pA1, t, false, true, true, true);     WAIT_BAR(2); RESC(); ROT();
        STEP(pA0, pA1, pB0, pB1, t + 1, false, true, true, true); WAIT_BAR(2); RESC(); ROT();
    }
#define ENDW(tt) do { if ((tt) + 3 < NT) { WAIT_BAR(2); } else if ((tt) + 2 < NT) { WAIT_BAR(1); } else { WAIT_BAR(0); } } while (0)
    for (; t + 1 < NT; t += 2) {
        STEP(pB0, pB1, pA0, pA1, t, true, (t + 3 < NT), (t + 1 < NT), (t + 1 < NT));         ENDW(t);     RESC(); ROT();
        STEP(pA0, pA1, pB0, pB1, t + 1, true, (t + 4 < NT), (t + 2 < NT), (t + 2 < NT));     ENDW(t + 1); RESC(); ROT();
    }
    STEP(pB0, pB1, pA0, pA1, NT - 1, true, false, false, false); RESC();
    { float sacc = pB0[0] + pB0[1];
#pragma unroll
      for (int r = 2; r < 16; ++r) sacc += pB0[r];
#pragma unroll
      for (int r = 0; r < 16; ++r) sacc += pB1[r];
      l_reg += sacc;
      pw0 = (u32x4){PKW(pB0, 0), PKW(pB0, 2), PKW(pB0, 4), PKW(pB0, 6)}; pw1 = (u32x4){PKW(pB0, 8), PKW(pB0, 10), PKW(pB0, 12), PKW(pB0, 14)};
      pw2 = (u32x4){PKW(pB1, 0), PKW(pB1, 2), PKW(pB1, 4), PKW(pB1, 6)}; pw3 = (u32x4){PKW(pB1, 8), PKW(pB1, 10), PKW(pB1, 12), PKW(pB1, 14)};
      const lds_cptr vp_ = vp0 + sl_cur; _Pragma("unroll") for (int i = 0; i < 8; ++i) VRD(i);
      o[0] = MFMA(PAF(0), VFR(0), o[0]); o[1] = MFMA(PAF(0), VFR(4), o[1]); o[0] = MFMA(PAF(1), VFR(1), o[0]); o[1] = MFMA(PAF(1), VFR(5), o[1]);
      o[0] = MFMA(PAF(2), VFR(2), o[0]); o[1] = MFMA(PAF(2), VFR(6), o[1]); o[0] = MFMA(PAF(3), VFR(3), o[0]); o[1] = MFMA(PAF(3), VFR(7), o[1]); }
    { auto rr = __builtin_amdgcn_permlane32_swap(__float_as_uint(l_reg), __float_as_uint(l_reg), false, false); l_reg = __uint_as_float(rr[0]) + __uint_as_float(rr[1]); }
    if (hi == 0) wsf[32 + r32] = l_reg; asm volatile("s_waitcnt lgkmcnt(0)" ::: "memory");
    float rli[16];
#pragma unroll
    for (int r = 0; r < 16; ++r) rli[r] = __builtin_amdgcn_rcpf(wsf[32 + crow(r, hi)]);
    bf16* Ow = O + (rowbase + q0 + wid * QBLK) * DM + h * D; bf16* stg = (bf16*)(lds + LDS_OST) + wid * 2048;
#pragma unroll
    for (int r = 0; r < 16; ++r) { const int orow = crow(r, hi);
#pragma unroll
        for (int d0 = 0; d0 < 2; ++d0) stg[orow * 64 + d0 * 32 + r32] = (bf16)(cvtpk(o[d0][r] * rli[r], 0.f) & 0xffffu); }
    asm volatile("s_waitcnt lgkmcnt(0)" ::: "memory");
#pragma unroll
    for (int i = 0; i < 4; ++i) { const int row = i * 8 + (lane >> 3), ch = lane & 7; *(u32x4*)(Ow + (long)row * DM + ch * 8) = *(const u32x4*)(stg + row * 64 + ch * 8); }
    asm volatile("s_waitcnt lgkmcnt(0)\n\ts_barrier" ::: "memory");
#undef DMA_K
#undef DMA_V
#undef ROT
#undef EX
#undef RESC
#undef PKW
#undef PAF
#undef VFR
#undef VRD
#undef KRD
#undef ENDW
#undef GAPA
#undef GAPB
#undef STEP
#undef KAR
#undef KAF
#undef SETQ
#undef EX0
}
#undef SBAR
#undef PIN
#undef MFMA
#undef WAIT_BAR
#undef MX3
__device__ __forceinline__ void run_all(const bf16* Q, const bf16* K, const bf16* V, const bf16* AUG, bf16* O, char* lds) {
    constexpr int NPAIR = NQB / 2;
    for (int i = (int)blockIdx.x; i < kB * NHEAD * NPAIR; i += (int)gridDim.x) {
        const int x = i & 7, kk = i >> 3, bh = x + 8 * (kk / NPAIR), j = kk % NPAIR;
        attn64_unit(bh / NHEAD, bh % NHEAD, NQB - 1 - j, true, Q, K, V, AUG, O, lds);
        attn64_unit(bh / NHEAD, bh % NHEAD, j, false, Q, K, V, AUG, O, lds);
    }
}
}

DI float min2f(float a, float b) { float r; asm("v_min_f32_e32 %0, %1, %2" : "=v"(r) : "v"(a), "v"(b)); return r; }
#define CE_DESC(a, b) do { const float hi_ = max2f(a, b), lo_ = min2f(a, b); a = hi_; b = lo_; } while (0)
template <int N> DI void bitonic_sort_desc(float* v) {
#pragma unroll
    for (int k = 2; k <= N; k <<= 1)
#pragma unroll
        for (int j = k >> 1; j > 0; j >>= 1)
#pragma unroll
            for (int i = 0; i < N; ++i) { const int l = i ^ j; if (l > i) { if ((i & k) == 0) CE_DESC(v[i], v[l]); else CE_DESC(v[l], v[i]); } }
}
DI void bitonic_merge16_desc(float* c) {
#pragma unroll
    for (int j = 8; j > 0; j >>= 1)
#pragma unroll
        for (int i = 0; i < 16; ++i) { const int l = i ^ j; if (l > i) CE_DESC(c[i], c[l]); }
}
DI void top16_merge(float* a, const float* b) {
#pragma unroll
    for (int i = 0; i < 16; ++i) a[i] = max2f(a[i], b[15 - i]);
    bitonic_merge16_desc(a);
}
DI void top16_xlane(float* a, int mask) {
    float o[16];
#pragma unroll
    for (int i = 0; i < 16; ++i) o[i] = __shfl_xor(a[i], mask);
    top16_merge(a, o);
}
template <bool STAGE, bool LOOP>
DI void ph_topk2(const bf16_t* Q, const bf16_t* SKb, int* idx, float* gate, int bid, int nblk, LAS unsigned char* lds) {
    const int tid = VTID, lane = tid & 63, wid = tid >> 6, fr = lane & 15, fq = lane >> 4;
    LAS unsigned* tab = (LAS unsigned*)(lds + 65536 + wid * 2304) + fr * 33;
    const int h = bid & 7;
    if (STAGE) {
        const bf16_t* src = SKb + (size_t)h * 2 * 128 * 128;
#pragma unroll 4
        for (int i = 0; i < 16; ++i) {
            const int pc = tid + 256 * i, row = pc >> 4, ch = pc & 15;
            const uint4 v = *(const uint4*)(src + (size_t)row * 128 + ch * 8);
            *(LAS u32x4*)(lds + row * 256 + ((ch ^ (row & 15)) << 4)) = (u32x4){v.x, v.y, v.z, v.w};
        }
    }
    if (STAGE) __syncthreads();
    if (!LOOP) return;
    const int ntile = kT / 16, hw = (bid >> 3) * 4 + wid, nhw = (nblk >> 3) * 4;
    for (int tile = hw; tile < ntile; tile += nhw) {
        const int t0 = tile * 16;
        float L[2][16];
#pragma unroll
        for (int p = 0; p < 2; ++p) {
            f32x4 acc[8];
#pragma unroll
            for (int n = 0; n < 8; ++n) acc[n] = (f32x4){0.f, 0.f, 0.f, 0.f};
            const bf16_t* qp = Q + (size_t)(t0 + fr) * 2048 + h * 256 + p * 128 + fq * 8;
#pragma unroll
            for (int ks = 0; ks < 4; ++ks) {
                const bf16x8 af = *(const bf16x8*)(qp + ks * 32);
#pragma unroll
                for (int n = 0; n < 8; ++n) { const bf16x8 kf = *(const LAS bf16x8*)(lds + (p * 128 + n * 16 + fr) * 256 + (((ks * 4 + fq) ^ fr) << 4)); acc[n] = __builtin_amdgcn_mfma_f32_16x16x32_bf16(kf, af, acc[n], 0, 0, 0); }
            }
            float v[32];
#pragma unroll
            for (int n = 0; n < 8; ++n)
#pragma unroll
                for (int j = 0; j < 4; ++j) v[n * 4 + j] = __uint_as_float((__float_as_uint(acc[n][j]) & ~0x7fu) | (unsigned)(n * 16 + 4 * fq + j));
            bitonic_sort_desc<16>(v); bitonic_sort_desc<16>(v + 16);
            top16_merge(v, v + 16);
            top16_xlane(v, 16); top16_xlane(v, 32);
#pragma unroll
            for (int i = 0; i < 16; ++i) L[p][i] = v[i];
        }
        if (fq == 0) {
#pragma unroll
            for (int i = 0; i < 16; ++i) { tab[i] = __float_as_uint(L[0][i]) & 0x7fu; tab[16 + i] = __float_as_uint(L[1][i]) & 0x7fu; }
        }
        float c[64]; int cnt = 0;
#pragma unroll
        for (int a = 0; a < 16; ++a)
#pragma unroll
            for (int b = 0; b < 16; ++b)
                if ((a + 1) * (b + 1) <= 16) {
                    const float s = __uint_as_float(__float_as_uint(L[0][a]) & ~0x7fu) + __uint_as_float(__float_as_uint(L[1][b]) & ~0x7fu);
                    c[cnt++] = __uint_as_float((__float_as_uint(s) & ~0xffu) | (unsigned)(a * 16 + b));
                }
#pragma unroll
        for (int i = 50; i < 64; ++i) c[i] = -1e30f;
        bitonic_sort_desc<16>(c); bitonic_sort_desc<16>(c + 16); bitonic_sort_desc<16>(c + 32); bitonic_sort_desc<16>(c + 48);
        top16_merge(c, c + 16); top16_merge(c + 32, c + 48); top16_merge(c, c + 32);
        float e[16]; int id[16]; float sum = 0.f;
        const float mx = __uint_as_float(__float_as_uint(c[0]) & ~0xffu);
#pragma unroll
        for (int r = 0; r < 16; ++r) {
            const unsigned bits = __float_as_uint(c[r]); const int a = (bits >> 4) & 15, b = bits & 15;
            id[r] = (int)(tab[a] * 128u + tab[16 + b]);
            e[r] = __builtin_amdgcn_exp2f((__uint_as_float(bits & ~0xffu) - mx) * kLog2e); sum += e[r];
        }
        const float inv = 1.f / sum;
        if (fq == 0) {
            int* ip = idx + (size_t)(t0 + fr) * 128 + h * 16; float* gp = gate + (size_t)(t0 + fr) * 128 + h * 16;
#pragma unroll
            for (int r = 0; r < 16; r += 4) { *(int4*)(ip + r) = make_int4(id[r], id[r + 1], id[r + 2], id[r + 3]); *(float4*)(gp + r) = make_float4(e[r] * inv, e[r + 1] * inv, e[r + 2] * inv, e[r + 3] * inv); }
        }
    }
}

typedef int i32x4 __attribute__((ext_vector_type(4)));
template <int SLICED> DI void ph_quant_rows(const float* src, const float* colscale, unsigned char* dst, float* scale, int bias, int bid, int nblk) {
    const int wid = VTID >> 6, lane = VTID & 63;
    for (int row0 = (bid * 4 + wid) * 2; row0 < 16384; row0 += nblk * 8) {
        float4 v[2][4];
#pragma unroll
        for (int r = 0; r < 2; ++r)
#pragma unroll
            for (int i = 0; i < 4; ++i) v[r][i] = ((const float4*)(src + (size_t)(row0 + r) * kD))[lane + 64 * i];
#pragma unroll
        for (int r = 0; r < 2; ++r) {
            const int row = row0 + r; float m = 0.f;
#pragma unroll
            for (int i = 0; i < 4; ++i) {
                if (colscale) { const float4 sc = ((const float4*)colscale)[lane + 64 * i]; v[r][i].x *= sc.x; v[r][i].y *= sc.y; v[r][i].z *= sc.z; v[r][i].w *= sc.w; }
                m = fmaxf(m, fmaxf(fmaxf(fabsf(v[r][i].x), fabsf(v[r][i].y)), fmaxf(fabsf(v[r][i].z), fabsf(v[r][i].w))));
            }
            m = wave_max(m);
            const float inv = (m > 0.f) ? 127.f / m : 0.f;
#pragma unroll
            for (int i = 0; i < 4; ++i) {
                const int a = (int)rintf(v[r][i].x * inv) + bias, b = (int)rintf(v[r][i].y * inv) + bias, c = (int)rintf(v[r][i].z * inv) + bias, d = (int)rintf(v[r][i].w * inv) + bias;
                const unsigned pk_ = (unsigned)(a & 0xff) | ((unsigned)(b & 0xff) << 8) | ((unsigned)(c & 0xff) << 16) | ((unsigned)(d & 0xff) << 24);
                const int col_ = (lane + 64 * i) * 4;
                if (SLICED) *(unsigned*)(dst + ((size_t)(col_ >> 7) * 16384 + row) * 128 + (col_ & 127)) = pk_;
                else ((unsigned*)(dst + (size_t)row * kD))[lane + 64 * i] = pk_;
            }
            if (lane == 0) scale[row] = (m > 0.f) ? m * (1.0f / 127.f) : 1.f;
        }
    }
}
DI float gelu_fast(float v) {
    const float av = fabsf(v), t = __builtin_amdgcn_rcpf(av * 0.2316418882f + 1.0f);
    float q = t * 0.5307027145f + (-0.7265760135f); q = q * t + 0.7107068705f; q = q * t + (-0.142248368f); q = q * t + 0.127414796f; q = q * t;
    const float m = v * (q * __builtin_amdgcn_exp2f((v * v) * (-0.72134752044f)));
    return v < 0.f ? m : v - m;
}
constexpr int EXW_BYTES = 19584;
constexpr int EX6_LIST = 8192, EX6_TOT = EX6_LIST + 4096, EX6_SXR = EX6_TOT + 4096;
DI void ph_exp_u7(const bf16_t* Hb, const float* SSQ, const unsigned char* U8, const float* su, const float* sv, const int* idx, const float* gate, float* abuf,
                  int bid, int nblk, LAS unsigned char* lds) {
    const int tid = VTID, lane = tid & 63, wid = tid >> 6, fr = lane & 15;
    LAS unsigned char* wl = lds + wid * EXW_BYTES;
    LAS unsigned* list = (LAS unsigned*)(wl + EX6_LIST); LAS int* tot = (LAS int*)(wl + EX6_TOT); LAS float* sxr = (LAS float*)(wl + EX6_SXR);
    const unsigned long long lt = (1ull << lane) - 1ull;
    const unsigned lane16 = (unsigned)lane * 16u;
    for (int tg = bid * 4 + wid; tg < kT / 8; tg += nblk * 4) {
        const int t0 = tg * 8;
#pragma unroll 4
        for (int tl = 0; tl < 8; ++tl) {
            const size_t t = (size_t)(t0 + tl);
            const uint4 x0 = *(const uint4*)(Hb + t * kD + lane * 16), x1 = *(const uint4*)(Hb + t * kD + lane * 16 + 8);
            float sq = SSQ[t * 16 + fr];
            float xf[16];
            { const unsigned ww[8] = {x0.x, x0.y, x0.z, x0.w, x1.x, x1.y, x1.z, x1.w};
#pragma unroll
              for (int j = 0; j < 8; ++j) { xf[2 * j] = __uint_as_float(ww[j] << 16); xf[2 * j + 1] = __uint_as_float(ww[j] & 0xffff0000u); } }
            float m = 0.f;
#pragma unroll
            for (int j = 0; j < 16; ++j) m = fmaxf(m, fabsf(xf[j]));
            m = wave_max(m);
            const float inv = (m > 0.f) ? 127.f / m : 0.f;
            unsigned pk[4];
#pragma unroll
            for (int j = 0; j < 4; ++j) {
                const int a = (int)rintf(xf[4 * j] * inv), b = (int)rintf(xf[4 * j + 1] * inv), c = (int)rintf(xf[4 * j + 2] * inv), d = (int)rintf(xf[4 * j + 3] * inv);
                pk[j] = (unsigned)(a & 0xff) | ((unsigned)(b & 0xff) << 8) | ((unsigned)(c & 0xff) << 16) | ((unsigned)(d & 0xff) << 24);
            }
            *(LAS u32x4*)(wl + tl * 1024 + lane * 16) = (u32x4){pk[0], pk[1], pk[2], pk[3]};
            sq += __shfl_xor(sq, 1); sq += __shfl_xor(sq, 2); sq += __shfl_xor(sq, 4); sq += __shfl_xor(sq, 8);
            if (lane == 0) sxr[tl] = m * (1.0f / 127.f) / sqrtf(sq * (1.0f / kD) + kEps);
        }
        {
            int ev[16];
#pragma unroll
            for (int k = 0; k < 8; ++k) { const size_t t = (size_t)(t0 + k); ev[2 * k] = idx[t * 128 + lane]; ev[2 * k + 1] = idx[t * 128 + 64 + lane]; }
            int n = 0;
#pragma unroll 1
            for (int r = 0; r < 8; ++r) {
#pragma unroll
                for (int k = 0; k < 16; ++k) {
                    const bool in = (ev[k] >> 11) == r;
                    const unsigned long long b = __ballot(in);
                    if (in) list[n + __popcll(b & lt)] = (unsigned)ev[k] | ((unsigned)(k >> 1) << 14) | ((unsigned)((k & 1) * 64 + lane) << 18);
                    n += __popcll(b);
                }
            }
        }
#define EU7_LOAD(ub, en, sb_) do { const unsigned lv_ = list[min((sb_) * 8 + (lane & 7), 1023)]; \
            _Pragma("unroll") for (int j_ = 0; j_ < 8; ++j_) { en[j_] = (unsigned)__builtin_amdgcn_readlane((int)lv_, j_); \
                ub[j_] = *(const uint4*)(U8 + (size_t)(en[j_] & 16383u) * kD + lane16); } } while (0)
#define EU7_COMP(ub, en, sb_) do { i32x4 xq_[8]; int p_[8]; \
            _Pragma("unroll") for (int j_ = 0; j_ < 8; ++j_) xq_[j_] = *(const LAS i32x4*)(wl + ((en[j_] >> 14) & 7u) * 1024u + lane16); \
            _Pragma("unroll") for (int j_ = 0; j_ < 8; ++j_) p_[j_] = __builtin_amdgcn_sdot4((int)ub[j_].x, xq_[j_][0], 0, false); \
            _Pragma("unroll") for (int j_ = 0; j_ < 8; ++j_) p_[j_] = __builtin_amdgcn_sdot4((int)ub[j_].y, xq_[j_][1], p_[j_], false); \
            _Pragma("unroll") for (int j_ = 0; j_ < 8; ++j_) p_[j_] = __builtin_amdgcn_sdot4((int)ub[j_].z, xq_[j_][2], p_[j_], false); \
            _Pragma("unroll") for (int j_ = 0; j_ < 8; ++j_) p_[j_] = __builtin_amdgcn_sdot4((int)ub[j_].w, xq_[j_][3], p_[j_], false); \
            _Pragma("unroll") for (int j_ = 0; j_ < 4; ++j_) { \
                const int hi_ = p_[j_ + 4] + __builtin_amdgcn_update_dpp(0, p_[j_ + 4], 0x114, 0xF, 0xF, true), lo_ = p_[j_] + __builtin_amdgcn_update_dpp(0, p_[j_], 0x104, 0xF, 0xF, true); \
                p_[j_] = (lane & 4) ? hi_ : lo_; } \
            _Pragma("unroll") for (int j_ = 0; j_ < 2; ++j_) { \
                const int hi_ = p_[j_ + 2] + __builtin_amdgcn_update_dpp(0, p_[j_ + 2], 0x4E, 0xF, 0xF, true), lo_ = p_[j_] + __builtin_amdgcn_update_dpp(0, p_[j_], 0x4E, 0xF, 0xF, true); \
                p_[j_] = (lane & 2) ? hi_ : lo_; } \
            { const int hi_ = p_[1] + __builtin_amdgcn_update_dpp(0, p_[1], 0xB1, 0xF, 0xF, true), lo_ = p_[0] + __builtin_amdgcn_update_dpp(0, p_[0], 0xB1, 0xF, 0xF, true); \
              p_[0] = (lane & 1) ? hi_ : lo_; } \
            int s_ = p_[0] + __builtin_amdgcn_update_dpp(0, p_[0], 0x128, 0xF, 0xF, true); \
            { const auto r_ = __builtin_amdgcn_permlane16_swap((unsigned)s_, (unsigned)s_, false, false); s_ = (int)(r_[0] + r_[1]); } \
            { const auto r_ = __builtin_amdgcn_permlane32_swap((unsigned)s_, (unsigned)s_, false, false); s_ = (int)(r_[0] + r_[1]); } \
            if (lane < 8) tot[(sb_) * 8 + lane] = s_; } while (0)
        uint4 uA[8], uB[8], uC[8]; unsigned eA[8], eB[8], eC[8];
        EU7_LOAD(uA, eA, 0); __builtin_amdgcn_sched_barrier(0); EU7_LOAD(uB, eB, 1); __builtin_amdgcn_sched_barrier(0);
#pragma unroll 1
        for (int sb = 0; sb < 128; sb += 3) {
            EU7_LOAD(uC, eC, sb + 2); EU7_COMP(uA, eA, sb);
            EU7_LOAD(uA, eA, sb + 3); if (sb + 1 < 128) EU7_COMP(uB, eB, sb + 1);
            EU7_LOAD(uB, eB, sb + 4); if (sb + 2 < 128) EU7_COMP(uC, eC, sb + 2);
        }
#undef EU7_LOAD
#undef EU7_COMP
#pragma unroll 1
        for (int i0 = lane; i0 < 1024; i0 += 512) {
            float su8[8], sv8[8], g8[8]; unsigned en8[8];
#pragma unroll
            for (int q = 0; q < 8; ++q) {
                en8[q] = list[i0 + 64 * q]; const int e = en8[q] & 16383;
                su8[q] = su[e]; sv8[q] = sv[e]; g8[q] = gate[(size_t)(t0 + ((en8[q] >> 14) & 7)) * 128 + (en8[q] >> 18)];
            }
#pragma unroll
            for (int q = 0; q < 8; ++q) {
                const int tl = (en8[q] >> 14) & 7, slot = en8[q] >> 18;
                const float sdot = (float)tot[i0 + 64 * q] * (su8[q] * sxr[tl]);
                abuf[(size_t)(t0 + tl) * 128 + slot] = gelu_fast(sdot) * g8[q] * sv8[q];
            }
        }
    }
}
DI void tr4x4(unsigned r0, unsigned r1, unsigned r2, unsigned r3, unsigned (&c)[4]) {
    const unsigned t0 = __builtin_amdgcn_perm(r1, r0, 0x05010400u), t1 = __builtin_amdgcn_perm(r1, r0, 0x07030602u);
    const unsigned t2 = __builtin_amdgcn_perm(r3, r2, 0x05010400u), t3 = __builtin_amdgcn_perm(r3, r2, 0x07030602u);
    c[0] = __builtin_amdgcn_perm(t2, t0, 0x05040100u); c[1] = __builtin_amdgcn_perm(t2, t0, 0x07060302u);
    c[2] = __builtin_amdgcn_perm(t3, t1, 0x05040100u); c[3] = __builtin_amdgcn_perm(t3, t1, 0x07060302u);
}
constexpr int EV8_ACC = 0, EV8_LIST = 16384, EV8_SA = EV8_LIST + 2560;
DI void ph_exp_v8(const bf16_t* Hres, const unsigned char* V8, const int* idx, const float* abuf, const float* nlw, float* out, int bid, int nblk, LAS unsigned char* lds) {
    const int tid = VTID, lane = tid & 63, wid = tid >> 6;
    LAS unsigned char* wl = lds + wid * EXW_BYTES;
    LAS unsigned* list = (LAS unsigned*)(wl + EV8_LIST); LAS float* sal = (LAS float*)(wl + EV8_SA); LAS int* acc = (LAS int*)(wl + EV8_ACC);
    const unsigned long long lt = (1ull << lane) - 1ull;
    const unsigned lane16 = (unsigned)lane * 16u;
    for (int tg = bid * 4 + wid; tg < kT / 4; tg += nblk * 4) {
        const int t0 = tg * 4;
        int n = 0;
        {
            int ev[8], a8[8];
#pragma unroll
            for (int tl = 0; tl < 4; ++tl) {
                const size_t t = (size_t)(t0 + tl);
                const float a0 = abuf[t * 128 + lane], a1 = abuf[t * 128 + 64 + lane];
                ev[2 * tl] = idx[t * 128 + lane]; ev[2 * tl + 1] = idx[t * 128 + 64 + lane];
                const float m = wave_max(fmaxf(fabsf(a0), fabsf(a1)));
                const float inv = (m > 0.f) ? 127.f / m : 0.f;
                a8[2 * tl] = (int)rintf(a0 * inv); a8[2 * tl + 1] = (int)rintf(a1 * inv);
                if (lane == 0) sal[tl] = m * (1.0f / 127.f);
#pragma unroll
                for (int q = 0; q < 4; ++q) *(LAS u32x4*)(wl + EV8_ACC + tl * 4096 + q * 1024 + lane16) = (u32x4){0u, 0u, 0u, 0u};
            }
#pragma unroll 1
            for (int r = 0; r < 8; ++r) {
#pragma unroll
                for (int k = 0; k < 8; ++k) {
                    const bool in = (ev[k] >> 11) == r;
                    const unsigned long long b = __ballot(in);
                    if (in) list[n + __popcll(b & lt)] = (unsigned)ev[k] | ((unsigned)(k >> 1) << 14) | ((unsigned)(a8[k] & 0xff) << 16);
                    n += __popcll(b);
                    if (k & 1) { const int pad = (-n) & 3; if (lane < pad) list[n + lane] = ((unsigned)r << 11) | ((unsigned)(k >> 1) << 14); n += pad; }
                }
            }
        }
        int yi[16];
#pragma unroll
        for (int j = 0; j < 16; ++j) yi[j] = 0;
        int cur = 0;
        const int nsb = (n + 7) >> 3, last = n - 1;
#define EV8_FLUSH() do { _Pragma("unroll") for (int j_ = 0; j_ < 16; ++j_) { atomicAdd((int*)(acc + cur * 1024 + j_ * 64 + lane), yi[j_]); yi[j_] = 0; } } while (0)
#define EV8_LOAD(ub, en, sb_) do { const int i_ = (sb_) * 8 + (lane & 7); unsigned lv_ = list[min(i_, last)]; lv_ = (i_ > last) ? (lv_ & 0xff00ffffu) : lv_; \
            _Pragma("unroll") for (int j_ = 0; j_ < 8; ++j_) { en[j_] = (unsigned)__builtin_amdgcn_readlane((int)lv_, j_); \
                ub[j_] = *(const uint4*)(V8 + (size_t)(en[j_] & 16383u) * kD + lane16); } } while (0)
#define EV8_COMP(ub, en) do { _Pragma("unroll") for (int h_ = 0; h_ < 2; ++h_) { \
            const int tlh_ = (int)((en[4 * h_] >> 14) & 3u); \
            if (tlh_ != cur) { EV8_FLUSH(); cur = tlh_; } \
            const int aw_ = (int)(((en[4 * h_] >> 16) & 0xffu) | (((en[4 * h_ + 1] >> 16) & 0xffu) << 8) | (((en[4 * h_ + 2] >> 16) & 0xffu) << 16) | ((en[4 * h_ + 3] >> 16) << 24)); \
            unsigned c_[4]; \
            tr4x4(ub[4 * h_].x, ub[4 * h_ + 1].x, ub[4 * h_ + 2].x, ub[4 * h_ + 3].x, c_); \
            _Pragma("unroll") for (int k_ = 0; k_ < 4; ++k_) yi[k_] = __builtin_amdgcn_sdot4((int)c_[k_], aw_, yi[k_], false); \
            tr4x4(ub[4 * h_].y, ub[4 * h_ + 1].y, ub[4 * h_ + 2].y, ub[4 * h_ + 3].y, c_); \
            _Pragma("unroll") for (int k_ = 0; k_ < 4; ++k_) yi[4 + k_] = __builtin_amdgcn_sdot4((int)c_[k_], aw_, yi[4 + k_], false); \
            tr4x4(ub[4 * h_].z, ub[4 * h_ + 1].z, ub[4 * h_ + 2].z, ub[4 * h_ + 3].z, c_); \
            _Pragma("unroll") for (int k_ = 0; k_ < 4; ++k_) yi[8 + k_] = __builtin_amdgcn_sdot4((int)c_[k_], aw_, yi[8 + k_], false); \
            tr4x4(ub[4 * h_].w, ub[4 * h_ + 1].w, ub[4 * h_ + 2].w, ub[4 * h_ + 3].w, c_); \
            _Pragma("unroll") for (int k_ = 0; k_ < 4; ++k_) yi[12 + k_] = __builtin_amdgcn_sdot4((int)c_[k_], aw_, yi[12 + k_], false); } } while (0)
        uint4 uA[8], uB[8], uC[8]; unsigned eA[8], eB[8], eC[8];
        EV8_LOAD(uA, eA, 0); __builtin_amdgcn_sched_barrier(0); EV8_LOAD(uB, eB, 1); __builtin_amdgcn_sched_barrier(0);
#pragma unroll 1
        for (int sb = 0; sb < nsb; sb += 3) {
            EV8_LOAD(uC, eC, sb + 2); EV8_COMP(uA, eA);
            EV8_LOAD(uA, eA, sb + 3); if (sb + 1 < nsb) EV8_COMP(uB, eB);
            EV8_LOAD(uB, eB, sb + 4); if (sb + 2 < nsb) EV8_COMP(uC, eC);
        }
        EV8_FLUSH();
#undef EV8_LOAD
#undef EV8_COMP
#undef EV8_FLUSH
        uint4 hres[4][2];
#pragma unroll
        for (int tl = 0; tl < 4; ++tl) { hres[tl][0] = *(const uint4*)(Hres + (size_t)(t0 + tl) * kD + lane * 16); hres[tl][1] = *(const uint4*)(Hres + (size_t)(t0 + tl) * kD + lane * 16 + 8); }
#pragma unroll
        for (int tl = 0; tl < 4; ++tl) {
            const size_t t = (size_t)(t0 + tl);
            const float sa = sal[tl];
            const uint4 h0 = hres[tl][0], h1 = hres[tl][1];
            const unsigned hw[8] = {h0.x, h0.y, h0.z, h0.w, h1.x, h1.y, h1.z, h1.w};
            float y[16]; float ss = 0.f;
#pragma unroll
            for (int j = 0; j < 16; ++j) {
                const float hv = (j & 1) ? __uint_as_float(hw[j >> 1] & 0xffff0000u) : __uint_as_float(hw[j >> 1] << 16);
                y[j] = (float)acc[tl * 1024 + j * 64 + lane] * sa + hv; ss += y[j] * y[j];
            }
            ss += __shfl_xor(ss, 1); ss += __shfl_xor(ss, 2); ss += __shfl_xor(ss, 4); ss += __shfl_xor(ss, 8); ss += __shfl_xor(ss, 16); ss += __shfl_xor(ss, 32);
            const float rr = 1.0f / sqrtf(ss * (1.0f / kD) + kEps);
            float* op = out + t * kD + lane * 16;
#pragma unroll
            for (int q = 0; q < 4; ++q) {
                const float4 w4 = *(const float4*)(nlw + lane * 16 + 4 * q);
                *(float4*)(op + 4 * q) = make_float4(y[4 * q] * rr * w4.x, y[4 * q + 1] * rr * w4.y, y[4 * q + 2] * rr * w4.z, y[4 * q + 3] * rr * w4.w);
            }
        }
    }
}

constexpr int EPI_LDS_OFF = 131072, EPI_LDS_WAVE = 2048;
DI void epi_strip(const f32x4& a0, const f32x4& a1, LAS unsigned char* wl, int fr, int fq, f32x4& v0, f32x4& v1) {
    *(LAS f32x4*)(wl + fr * 128 + (((0 + fq) ^ (fr & 7)) << 4)) = a0;
    *(LAS f32x4*)(wl + fr * 128 + (((4 + fq) ^ (fr & 7)) << 4)) = a1;
    const int lane = fr + 16 * fq, r = lane >> 2, c = lane & 3;
    v0 = *(const LAS f32x4*)(wl + r * 128 + (((2 * c) ^ (r & 7)) << 4));
    v1 = *(const LAS f32x4*)(wl + r * 128 + (((2 * c + 1) ^ (r & 7)) << 4));
}
struct Epi8Proj {
    static constexpr bool PERM = false, AFTER_DRAIN = false;
    ProjOut o; const float* sw; LAS unsigned char* lds_epi;
    template <int KIND> DI void half(const pg8::i32x4 (&acc)[2][2][4][2], int bj, int rowb  , int colp  , int cl0  , bf16_t* dst, float sc, int fr, int fq, LAS unsigned char* wl) const {
        const int lane = fr + 16 * fq, r = lane >> 2, cl = cl0 + 8 * (lane & 3);
        float lb[8] = {0.f, 0.f, 0.f, 0.f, 0.f, 0.f, 0.f, 0.f};
        if (KIND == 1) {
#pragma unroll
            for (int j = 0; j < 8; ++j) lb[j] = fsigmoid(o.lbl[cl + j] - o.lbl[512 + cl + j]);
        }
        const f32x4 sw0 = *(const f32x4*)(sw + colp + 8 * (lane & 3)), sw1 = *(const f32x4*)(sw + colp + 8 * (lane & 3) + 4);
        float rsn = o.rs1[rowb + r];
#pragma unroll
        for (int ai = 0; ai < 2; ++ai)
#pragma unroll
            for (int m = 0; m < 4; ++m) {
                f32x4 v0, v1;
                epi_strip(__builtin_convertvector(ai == 0 ? acc[0][bj][m][0] : acc[1][bj][m][0], f32x4), __builtin_convertvector(ai == 0 ? acc[0][bj][m][1] : acc[1][bj][m][1], f32x4), wl, fr, fq, v0, v1);
                const int row = rowb + ai * 128 + m * 16 + r;
                const float rs = rsn * (sc * (1.0f / 127.f));
                { const int nb_ = ai * 4 + m + 1; if (nb_ < 8) rsn = o.rs1[rowb + (nb_ >> 2) * 128 + (nb_ & 3) * 16 + r]; }
                v0 = v0 * sw0 * rs; v1 = v1 * sw1 * rs;
                if (KIND == 0) { for (int j = 0; j < 4; ++j) { v0[j] = v0[j] * fsigmoid(v0[j]); v1[j] = v1[j] * fsigmoid(v1[j]); } store_bf8((bf16_t*)((unsigned char*)dst + (size_t)(unsigned)((row * 512 + cl) * 2)), v0, v1); }
                else if (KIND == 1) { for (int j = 0; j < 4; ++j) { v0[j] = __builtin_amdgcn_logf(lb[j] + (1.f - lb[j]) * fsigmoid(v0[j])); v1[j] = __builtin_amdgcn_logf(lb[4 + j] + (1.f - lb[4 + j]) * fsigmoid(v1[j])); }
                    store_bf8((bf16_t*)((unsigned char*)dst + (size_t)(unsigned)((row * 512 + cl) * 2)), v0, v1); }
                else if (KIND == 2) store_bf8((bf16_t*)((unsigned char*)dst + (size_t)(unsigned)((row * 512 + cl) * 2)), v0, v1);
                else { for (int j = 0; j < 4; ++j) { v0[j] = fsigmoid(v0[j]); v1[j] = fsigmoid(v1[j]); } store_bf8((bf16_t*)((unsigned char*)dst + (size_t)(unsigned)((row * 1024 + cl) * 2)), v0, v1); }
                asm volatile("" ::: "memory");
            }
    }
    DI void half_fv(const pg8::i32x4 (&acc)[2][2][4][2], int bj, int row00, int colp0, int cl0, int fr, int fq, int wc) const {
#pragma unroll
        for (int n = 0; n < 2; ++n) {
            const int cl = cl0 + wc * 32 + n * 16 + fq * 4;
            const f32x4 swv = *(const f32x4*)(sw + colp0 + wc * 32 + n * 16 + fq * 4);
#pragma unroll
            for (int ai = 0; ai < 2; ++ai)
#pragma unroll
                for (int m = 0; m < 4; ++m) {
                    const int row = row00 + ai * 128 + m * 16;
                    const f32x4 z = __builtin_convertvector(ai == 0 ? acc[0][bj][m][n] : acc[1][bj][m][n], f32x4) * swv * (o.rs1[row] * (1.0f / 127.f));
                    bf16_t* d = o.FV + ((size_t)((row >> 12) * 512 + cl)) * kS + (row & (kS - 1));
                    for (int j = 0; j < 4; ++j) d[(size_t)j * kS] = (bf16_t)(cvtpk(z[j], 0.f) & 0xffffu);
                }
        }
    }
    DI void operator()(const pg8::i32x4 (&acc)[2][2][4][2], const pg8::Unit& u, int wr, int wc, int fr_in, int fq_in) const {
        int fr = fr_in, fq = fq_in; asm volatile("" : "+v"(fr), "+v"(fq));
        const int rowb = u.pm * 256 + wr * 64;
        LAS unsigned char* wl = lds_epi + (wr * 4 + wc) * EPI_LDS_WAVE;
#pragma unroll
        for (int bj = 0; bj < 2; ++bj) {
            const int colh = u.pn * 256 + bj * 128, cw = wc * 32, cp = colh + cw;
            if (colh < 512) half<0>(acc, bj, rowb, cp, colh + cw, o.QH, 1.f, fr, fq, wl);
            else if (colh < 1024) half<1>(acc, bj, rowb, cp, colh - 512 + cw, o.LF, 1.f, fr, fq, wl);
            else if (colh < 1536) half<2>(acc, bj, rowb, cp, colh - 1024 + cw, o.VH, 1.f, fr, fq, wl);
            else if (colh < 2048) half<0>(acc, bj, rowb, cp, colh - 1536 + cw, o.GH, 1.f, fr, fq, wl);
            else if (colh < 2560) half<2>(acc, bj, rowb, cp, colh - 2048 + cw, o.FQ, 0.125f * kLog2e, fr, fq, wl);
            else if (colh < 3072) half<2>(acc, bj, rowb, cp, colh - 2560 + cw, o.FK, 1.f, fr, fq, wl);
            else if (colh < 3584) half<2>(acc, bj, rowb, cp, colh - 3072 + cw, o.FV, 1.f, fr, fq, wl);
            else if (colh < 3712) { if (wc == 0 && fq < 2) {
                    const f32x4 swv = *(const f32x4*)(sw + colh + fq * 4);
#pragma unroll
                    for (int ai = 0; ai < 2; ++ai)
#pragma unroll
                        for (int m = 0; m < 4; ++m) { const int row = rowb + fr + ai * 128 + m * 16; const f32x4 z = __builtin_convertvector(ai == 0 ? acc[0][bj][m][0] : acc[1][bj][m][0], f32x4) * swv * (o.rs1[row] * (1.0f / 127.f)); f32x4 q;
                            for (int j = 0; j < 4; ++j) q[j] = -__builtin_amdgcn_logf(1.f + __builtin_amdgcn_exp2f(-(z[j] + o.ffb[fq * 4 + j]) * kLog2e));
                            *(f32x4*)(o.LFF + (size_t)row * 8 + fq * 4) = q; } } }
            else if (colh < 4736) half<5>(acc, bj, rowb, cp, colh - 3712 + cw, o.SGA, 1.f, fr, fq, wl);
            else if (colh < kINP) half<5>(acc, bj, rowb, cp, colh - 4736 + cw, o.SGB, 1.f, fr, fq, wl);
        }
    }
};
DI void unpack_bf8(const uint4& u, f32x4& v0, f32x4& v1) {
    v0 = (f32x4){__uint_as_float(u.x << 16), __uint_as_float(u.x & 0xffff0000u), __uint_as_float(u.y << 16), __uint_as_float(u.y & 0xffff0000u)};
    v1 = (f32x4){__uint_as_float(u.z << 16), __uint_as_float(u.z & 0xffff0000u), __uint_as_float(u.w << 16), __uint_as_float(u.w & 0xffff0000u)}; }
struct Epi8Gate {
    static constexpr bool PERM = false, AFTER_DRAIN = false;
    const bf16_t* G; bf16_t* Mg; int mode; LAS unsigned char* lds_epi;
    DI void operator()(const f32x4 (&acc)[2][2][4][2], const pg8::Unit& u, int wr, int wc, int fr, int fq) const {
        LAS unsigned char* wl = lds_epi + (wr * 4 + wc) * EPI_LDS_WAVE; const int lane = fr + 16 * fq, r = lane >> 2, c8 = 8 * (lane & 3);
        const size_t base = (size_t)(u.pm * 256 + wr * 64 + r) * 1024 + u.pn * 256 + wc * 32 + c8;
#define EPG_OFF(blk) (base + (size_t)((((blk) >> 3) * 128 + (((blk) >> 1) & 3) * 16) * 1024 + ((blk) & 1) * 128))
        uint4 gn = *(const uint4*)(G + EPG_OFF(0)), pn = make_uint4(0u, 0u, 0u, 0u);
        if (mode) pn = *(const uint4*)(Mg + EPG_OFF(0));
#pragma unroll
        for (int blk = 0; blk < 16; ++blk) {
            const int ai = blk >> 3, m = (blk >> 1) & 3, bj = blk & 1;
            const uint4 gc = gn, pc = pn;
            if (blk + 1 < 16) { gn = *(const uint4*)(G + EPG_OFF(blk + 1)); if (mode) pn = *(const uint4*)(Mg + EPG_OFF(blk + 1)); }
            f32x4 v0, v1; epi_strip(acc[ai][bj][m][0], acc[ai][bj][m][1], wl, fr, fq, v0, v1);
            f32x4 g0, g1; unpack_bf8(gc, g0, g1); v0 = v0 * g0; v1 = v1 * g1;
            if (mode) { f32x4 p0, p1; unpack_bf8(pc, p0, p1); v0 += p0; v1 += p1; }
            store_bf8(Mg + EPG_OFF(blk), v0, v1);
        }
#undef EPG_OFF
    }
};
struct Epi8Wout {
    static constexpr bool PERM = false, AFTER_DRAIN = false;
    const float* X; bf16_t* Hb; float* SSQ; LAS unsigned char* lds_epi;
    DI void operator()(const f32x4 (&acc)[2][2][4][2], const pg8::Unit& u, int wr, int wc, int fr, int fq) const {
        LAS unsigned char* wl = lds_epi + (wr * 4 + wc) * EPI_LDS_WAVE; const int lane = fr + 16 * fq, r = lane >> 2, c8 = 8 * (lane & 3);
        const int row0 = u.pm * 256 + wr * 64 + r;
        const size_t base = (size_t)row0 * 1024 + u.pn * 256 + wc * 32 + c8;
#define EPO_OFF(blk) (base + (size_t)((((blk) >> 3) * 128 + (((blk) >> 1) & 3) * 16) * 1024 + ((blk) & 1) * 128))
        f32x4 xn0 = *(const f32x4*)(X + EPO_OFF(0)), xn1 = *(const f32x4*)(X + EPO_OFF(0) + 4);
        float ss = 0.f;
#pragma unroll
        for (int blk = 0; blk < 16; ++blk) {
            const int ai = blk >> 3, m = (blk >> 1) & 3, bj = blk & 1;
            const f32x4 x0 = xn0, x1 = xn1;
            if (blk + 1 < 16) { xn0 = *(const f32x4*)(X + EPO_OFF(blk + 1)); xn1 = *(const f32x4*)(X + EPO_OFF(blk + 1) + 4); }
            f32x4 v0, v1; epi_strip(acc[ai][bj][m][0], acc[ai][bj][m][1], wl, fr, fq, v0, v1);
            v0 += x0; v1 += x1;
            store_bf8(Hb + EPO_OFF(blk), v0, v1);
            ss += (v0[0] * v0[0] + v0[1] * v0[1]) + (v0[2] * v0[2] + v0[3] * v0[3]) + (v1[0] * v1[0] + v1[1] * v1[1]) + (v1[2] * v1[2] + v1[3] * v1[3]);
            if (bj == 1) {
                ss += __shfl_xor(ss, 1); ss += __shfl_xor(ss, 2);
                if ((lane & 3) == 0) SSQ[(size_t)(row0 + ai * 128 + m * 16) * 16 + u.pn * 4 + wc] = ss;
                ss = 0.f;
            }
        }
#undef EPO_OFF
    }
};
struct Epi8Wq {
    static constexpr bool PERM = false, AFTER_DRAIN = false;
    const float* SSQ; bf16_t* Q; LAS unsigned char* lds_epi;
    DI void operator()(const f32x4 (&acc)[2][2][4][2], const pg8::Unit& u, int wr, int wc, int fr, int fq) const {
        LAS unsigned char* wl = lds_epi + (wr * 4 + wc) * EPI_LDS_WAVE; const int lane = fr + 16 * fq, r = lane >> 2, c8 = 8 * (lane & 3);
        const int row0 = u.pm * 256 + wr * 64 + r;
        f32x4 sp[8];
#pragma unroll
        for (int q = 0; q < 8; ++q) sp[q] = *(const f32x4*)(SSQ + (size_t)(row0 + (q >> 2) * 128 + (q & 3) * 16) * 16 + 4 * (lane & 3));
#pragma unroll
        for (int ai = 0; ai < 2; ++ai)
#pragma unroll
            for (int m = 0; m < 4; ++m) {
                const int row = row0 + ai * 128 + m * 16;
                const f32x4 a = sp[ai * 4 + m];
                float s4 = (a[0] + a[1]) + (a[2] + a[3]); s4 += __shfl_xor(s4, 1); s4 += __shfl_xor(s4, 2);
                const float r2 = 1.0f / sqrtf(s4 * (1.0f / kD) + kEps);
#pragma unroll
                for (int bj = 0; bj < 2; ++bj) {
                    f32x4 v0, v1; epi_strip(acc[ai][bj][m][0], acc[ai][bj][m][1], wl, fr, fq, v0, v1);
                    store_bf8(Q + (size_t)row * 2048 + u.pn * 256 + bj * 128 + wc * 32 + c8, v0 * r2, v1 * r2);
                }
            }
    }
};

constexpr int NPHASE = 9;
template <int PH>
DI void run_phase(const Params& p, int bid, int nblk, float* sm) {
    unsigned char* ws = p.ws;
    float* rs1 = (float*)(ws + OFF_RS1); float* SSQ = (float*)(ws + OFF_SSQ); float* cf = (float*)(ws + OFF_CFOX); float* LFF = (float*)(ws + OFF_LFF);
    int* idx = (int*)(ws + OFF_IDX); float* gate = (float*)(ws + OFF_GATE);
    bf16_t* Wtin = (bf16_t*)(ws + OFF_WTIN); bf16_t* Wta = (bf16_t*)(ws + OFF_WTA); bf16_t* Wtb = (bf16_t*)(ws + OFF_WTB); bf16_t* Wto = (bf16_t*)(ws + OFF_WTOUT); bf16_t* Wtq = (bf16_t*)(ws + OFF_WTQ); bf16_t* SKb = (bf16_t*)(ws + OFF_SKB); unsigned char* U8 = ws + OFF_UB; unsigned char* V8 = ws + OFF_VB; float* abuf = (float*)(ws + OFF_ABUF); float* su = (float*)(ws + OFF_SU); float* sv = (float*)(ws + OFF_SV);
    bf16_t* Xb = (bf16_t*)(ws + OFF_R1); bf16_t* ST = Xb; float* DC = (float*)(ws + OFF_DC);
    bf16_t* QH = (bf16_t*)(ws + OFF_R2); bf16_t* LF = QH + (size_t)kT * 512; bf16_t* Mg = QH;
    bf16_t* VH = (bf16_t*)(ws + OFF_R3); bf16_t* GH = VH + (size_t)kT * 512; bf16_t* Hb = VH;
    bf16_t* FK = (bf16_t*)(ws + OFF_R4); bf16_t* FV = FK + (size_t)kT * 512;
    bf16_t* SGA = (bf16_t*)(ws + OFF_R6); bf16_t* SGB = SGA + (size_t)kT * 1024; bf16_t* Qp = SGA;
    bf16_t* FQ = (bf16_t*)p.out; bf16_t* Bb = FQ + (size_t)kT * 512; bf16_t* Ab = Bb + (size_t)kT * 512;
    LAS unsigned char* lds = (LAS unsigned char*)sm;
    if (PH == 0) {
        unsigned char* X8 = (unsigned char*)Xb; float* cmp = (float*)(ws + OFF_SW);
        ph_conv_x8(p.x, X8, rs1, bid, nblk);
        ph_colmax(p.w_in, kINW, 0, 3592, kD, p.nmw, cmp, bid, nblk, sm);
        ph_colmax(p.w_in, kINW, 3592, 2048, kD, p.nmw, cmp + 3712, bid, nblk, sm);
        ph_conv_wt(p.w_a, kD, 0, 1024, 512, nullptr, Wta, bid, nblk, sm);
        ph_conv_wt(p.w_b, kD, 0, 1024, 512, nullptr, Wtb, bid, nblk, sm);
        ph_conv_wt(p.w_out, kD, 0, 1024, kD, nullptr, Wto, bid, nblk, sm);
        ph_conv_wt(p.w_q, 2048, 0, 2048, kD, p.nfw, Wtq, bid, nblk, sm);
        ph_conv_plain(p.sk, SKb, (size_t)8 * 2 * 128 * 128, nullptr, bid, nblk);
    }
    else if (PH == 11) {
        unsigned char* W8 = (unsigned char*)Wtin; const float* cmp = (const float*)(ws + OFF_SW);
        ph_conv_wt8(p.w_in, kINW, 0, 3592, kD, p.nmw, cmp, W8, bid, nblk, sm);
        ph_conv_wt8(p.w_in, kINW, 3592, 2048, kD, p.nmw, cmp + 3712, W8 + (size_t)3712 * kD, bid, nblk, sm);
        ph_zero_bf16((bf16_t*)(W8 + (size_t)3592 * kD), (size_t)120 * kD / 2, bid, nblk);
        ph_zero_bf16((bf16_t*)(W8 + (size_t)5760 * kD), (size_t)128 * kD / 2, bid, nblk);
    }
    else if (PH == 2) { ph_cfox(LFF, cf, (bf16_t*)(ws + OFF_AUG), nblk - 1 - bid, nblk, sm); ph_hgrn1(LF, VH, ST, DC, bid, nblk, lds); }
    else if (PH == 3) { ph_hgrn2(ST, DC, bid, nblk); }
    else if (PH == 9) ph_hgrn3(QH, LF, VH, GH, ST, p.hnw, Ab, bid, nblk, lds);
    else if (PH == 7) {
        ph_topk2<true, false>(Qp, SKb, idx, gate, bid, nblk, lds);
        if (bid & 1) { ph_topk2<false, true>(Qp, SKb, idx, gate, bid, nblk, lds); ph_quant_rows<0>(p.pu, p.nfw, U8, su, 0, bid, nblk); ph_quant_rows<0>(p.pv, nullptr, V8, sv, 0, bid, nblk); }
        else { ph_quant_rows<0>(p.pu, p.nfw, U8, su, 0, bid, nblk); ph_quant_rows<0>(p.pv, nullptr, V8, sv, 0, bid, nblk); ph_topk2<false, true>(Qp, SKb, idx, gate, bid, nblk, lds); }
    }
    else if (PH == 8) ph_exp_u7(Hb, SSQ, U8, su, sv, idx, gate, abuf, bid, nblk, lds);
    else if (PH == 10) ph_exp_v8(Hb, V8, idx, abuf, p.nlw, p.out, bid, nblk, lds);
}

template <int PH>
DI void run_gemm(const Params& p, LAS unsigned char* lds) {
    unsigned char* ws = p.ws;
    float* rs1 = (float*)(ws + OFF_RS1); float* SSQ = (float*)(ws + OFF_SSQ); float* LFF = (float*)(ws + OFF_LFF);
    bf16_t* Wtin = (bf16_t*)(ws + OFF_WTIN); bf16_t* Wta = (bf16_t*)(ws + OFF_WTA); bf16_t* Wtb = (bf16_t*)(ws + OFF_WTB); bf16_t* Wto = (bf16_t*)(ws + OFF_WTOUT); bf16_t* Wtq = (bf16_t*)(ws + OFF_WTQ);
    bf16_t* Xb = (bf16_t*)(ws + OFF_R1);
    bf16_t* QH = (bf16_t*)(ws + OFF_R2); bf16_t* LF = QH + (size_t)kT * 512; bf16_t* Mg = QH;
    bf16_t* VH = (bf16_t*)(ws + OFF_R3); bf16_t* GH = VH + (size_t)kT * 512; bf16_t* Hb = VH;
    bf16_t* FK = (bf16_t*)(ws + OFF_R4); bf16_t* FV = FK + (size_t)kT * 512;
    bf16_t* SGA = (bf16_t*)(ws + OFF_R6); bf16_t* SGB = SGA + (size_t)kT * 1024; bf16_t* Qp = SGA;
    bf16_t* FQ = (bf16_t*)p.out; bf16_t* Bb = FQ + (size_t)kT * 512; bf16_t* Ab = Bb + (size_t)kT * 512;
    const int G = (int)gridDim.x, c = (int)blockIdx.x;
    if (PH == 1) {
        pg8::Gemm g{Xb, Wtin, kT, 5888, kD / 2}; pg8::StaticOrder S; S.init(kT, 5888, G, c);
        Epi8Proj E{ProjOut{rs1, p.lbl, p.ffb, QH, LF, VH, GH, FQ, FK, FV, SGA, SGB, LFF}, (const float*)(ws + OFF_SW), lds + EPI_LDS_OFF};
        pg8::gemm_phase_i8<Epi8Proj, pg8::StaticOrder, true, true>(lds, g, S, E);
    } else if (PH == 4) {
        { pg8::Gemm g{Ab, Wta, kT, 1024, 512}; pg8::StaticOrder S; S.init(kT, 1024, G, c); Epi8Gate E{SGA, Mg, 0, lds + EPI_LDS_OFF}; pg8::gemm_phase<Epi8Gate, pg8::StaticOrder, true, true>(lds, g, S, E); }
        { pg8::Gemm g{Bb, Wtb, kT, 1024, 512}; pg8::StaticOrder S; S.init(kT, 1024, G, c); Epi8Gate E{SGB, Mg, 1, lds + EPI_LDS_OFF}; pg8::gemm_phase<Epi8Gate, pg8::StaticOrder, true, true>(lds, g, S, E); }
    } else if (PH == 5) {
        pg8::Gemm g{Mg, Wto, kT, 1024, kD}; pg8::StaticOrder S; S.init(kT, 1024, G, c); Epi8Wout E{p.x, Hb, SSQ, lds + EPI_LDS_OFF};
        pg8::gemm_phase<Epi8Wout, pg8::StaticOrder, true, true>(lds, g, S, E);
    } else if (PH == 6) {
        pg8::Gemm g{Hb, Wtq, kT, 2048, kD}; pg8::StaticOrder S; S.init(kT, 2048, G, c); Epi8Wq E{SSQ, Qp, lds + EPI_LDS_OFF};
        pg8::gemm_phase<Epi8Wq, pg8::StaticOrder, true, true>(lds, g, S, E);
    }
}

constexpr int SM_FLOATS = 19584;
constexpr size_t OFF_BAR = 512 * 1024;

__global__ void __launch_bounds__(512, 2) k_mega(Params p) {
    __shared__ __attribute__((aligned(16))) float sm_all[2 * SM_FLOATS + 4];
    volatile LAS unsigned* st = (volatile LAS unsigned*)(LAS float*)(sm_all + 2 * SM_FLOATS);
    if (threadIdx.x == 0) { st[0] = 0u; st[1] = 0u; }
    __syncthreads();
    const XcdBarrier xb = xcd_barrier_post((unsigned*)(p.ws + OFF_BAR), st);
    const int half = __builtin_amdgcn_readfirstlane((int)(threadIdx.x >> 8));
    float* sm = sm_all + half * SM_FLOATS;
    const int bid = blockIdx.x * 2 + half, nblk = gridDim.x * 2;
    run_phase<0>(p, bid, nblk, sm); xcd_barrier(xb);
    run_phase<11>(p, bid, nblk, sm); xcd_barrier(xb);
    run_gemm<1>(p, (LAS unsigned char*)sm_all); xcd_barrier(xb);
    run_phase<2>(p, bid, nblk, sm); xcd_barrier(xb);
    run_phase<3>(p, bid, nblk, sm);
    __syncthreads();
    { bf16_t* FQ_ = (bf16_t*)p.out; bf16_t* FK_ = (bf16_t*)(p.ws + OFF_R4);
      at64::run_all(FQ_, FK_, FK_ + (size_t)kT * 512, (const bf16_t*)(p.ws + OFF_AUG), FQ_ + (size_t)kT * 512, (char*)sm_all); }
    xcd_barrier(xb);
    run_phase<9>(p, bid, nblk, sm); xcd_barrier(xb);
    run_gemm<4>(p, (LAS unsigned char*)sm_all); xcd_barrier(xb);
    run_gemm<5>(p, (LAS unsigned char*)sm_all); xcd_barrier(xb);
    run_gemm<6>(p, (LAS unsigned char*)sm_all); xcd_barrier(xb);
    run_phase<7>(p, bid, nblk, sm); xcd_barrier(xb);
    run_phase<8>(p, bid, nblk, sm); xcd_barrier(xb);
    run_phase<10>(p, bid, nblk, sm);
}

extern "C" void kernel_launch(void* const* d_in, const int* in_sizes, int n_in, void* d_out, int out_size, void* d_ws, size_t ws_size, hipStream_t stream) {
    Params p{};
    p.x = (const float*)d_in[0]; p.nmw = (const float*)d_in[1]; p.w_in = (const float*)d_in[2]; p.lbl = (const float*)d_in[3];
    p.hnw = (const float*)d_in[4]; p.ffb = (const float*)d_in[5]; p.w_a = (const float*)d_in[6]; p.w_b = (const float*)d_in[7];
    p.w_out = (const float*)d_in[8]; p.nfw = (const float*)d_in[9]; p.w_q = (const float*)d_in[10]; p.sk = (const float*)d_in[11];
    p.pu = (const float*)d_in[12]; p.pv = (const float*)d_in[13]; p.nlw = (const float*)d_in[14];
    p.out = (float*)d_out; p.ws = (unsigned char*)d_ws;
    static int grid_blocks = 0;
    if (!grid_blocks) {
        int dev = 0, cus = 0, per_cu = 0;
        (void)hipGetDevice(&dev);
        (void)hipDeviceGetAttribute(&cus, hipDeviceAttributeMultiprocessorCount, dev);
        (void)hipOccupancyMaxActiveBlocksPerMultiprocessor(&per_cu, k_mega, 512, 0);
        if (per_cu > 1) per_cu = 1;
        if (per_cu < 1) per_cu = 1;
        grid_blocks = cus * per_cu;
        if (ws_size < 507 * MBy) fprintf(stderr, "workspace too small: %zu\n", ws_size);
    }
    (void)hipMemsetAsync((unsigned char*)d_ws + OFF_BAR, 0, XCD_BAR_WORDS * sizeof(unsigned), stream);
    (void)hipMemsetAsync((unsigned char*)d_ws + OFF_SW, 0, 5888 * sizeof(float), stream);
    void* args[] = {&p};
    hipError_t e = hipLaunchCooperativeKernel((void*)k_mega, dim3(grid_blocks), dim3(512), args, 0, stream);
    if (e != hipSuccess) fprintf(stderr, "cooperative launch failed: %s (grid %d)\n", hipGetErrorString(e), grid_blocks);
}
```

```cpp
#include <hip/hip_runtime.h>
#include <math.h>
#include <stdio.h>

#ifndef MEGA
#define MEGA 1
#endif

#define DI __device__ __forceinline__
__device__ __forceinline__ int vtid_opaque() { int t = (int)threadIdx.x; asm volatile("" : "+v"(t)); return t & 255; }
#define VTID (vtid_opaque())
constexpr int kB = 8, kS = 4096, kT = kB * kS, kD = 1024, kINW = 5640;
constexpr float kEps = 1e-6f;

struct Params {
    const float *x, *nmw, *w_in, *lbl, *hnw, *ffb, *w_a, *w_b, *w_out, *nfw, *w_q, *sk, *pu, *pv, *nlw;
    float* out; unsigned char* ws;
};
constexpr size_t MBy = 1u << 20;
constexpr size_t OFF_SW = 256 * 1024;
constexpr size_t OFF_RS1 = 0, OFF_SSQ = 1 * MBy, OFF_CFOX = 3 * MBy, OFF_LFF = 4 * MBy, OFF_DC = 5 * MBy, OFF_IDX = 6 * MBy, OFF_GATE = 22 * MBy;
constexpr size_t OFF_WTIN = 38 * MBy, OFF_WTA = 50 * MBy, OFF_WTB = 51 * MBy, OFF_WTOUT = 52 * MBy, OFF_WTQ = 54 * MBy, OFF_SKB = 58 * MBy, OFF_UB = 59 * MBy  , OFF_VB = 75 * MBy  , OFF_ABUF = 91 * MBy  , OFF_SU = 107 * MBy, OFF_SV = 107 * MBy + 65536;
constexpr size_t OFF_AUG = 44 * MBy;
constexpr size_t OFF_R1 = 123 * MBy;
constexpr size_t OFF_R2 = 187 * MBy;
constexpr size_t OFF_R3 = 251 * MBy;
constexpr size_t OFF_R4 = 315 * MBy;
constexpr size_t OFF_R6 = 379 * MBy;
constexpr int kINP = 5760;
constexpr float kLog2e = 1.4426950408889634f;

DI float sigmoidf_(float v) { return 1.f / (1.f + expf(-v)); }
DI float wave_max(float v) {
#pragma unroll
    for (int o = 32; o > 0; o >>= 1) v = fmaxf(v, __shfl_xor(v, o));
    return v;
}
DI float wave_sum(float v) {
#pragma unroll
    for (int o = 32; o > 0; o >>= 1) v += __shfl_xor(v, o);
    return v;
}

#define LAS __attribute__((address_space(3)))
typedef unsigned short bf16_t;
typedef short bf16x8 __attribute__((ext_vector_type(8)));
typedef float f32x4 __attribute__((ext_vector_type(4)));
typedef unsigned u32x4 __attribute__((ext_vector_type(4)));
typedef unsigned u32x2 __attribute__((ext_vector_type(2)));
typedef float f32x2_t __attribute__((ext_vector_type(2)));
typedef __bf16 bf16x2_t __attribute__((ext_vector_type(2)));
DI unsigned cvtpk(float lo, float hi) { f32x2_t v = {lo, hi}; bf16x2_t b = __builtin_convertvector(v, bf16x2_t); return __builtin_bit_cast(unsigned, b); }
DI float bf2f(bf16_t v) { return __uint_as_float(((unsigned)v) << 16); }


#define XB_TMO      128
#define XB_XCNT(j)  (256  + 64 * (j))
#define XB_XSUB(j)  (1280 + 64 * (j))
#define XB_XGEN(j)  (2304 + 64 * (j))
#define XB_TOP      3328
#define XB_TOPGEN   3392
#define XCD_BAR_WORDS 3456
#define XB_SPIN_CAP (1u << 18)
DI unsigned xb_ld(unsigned* p)              { return __hip_atomic_load(p, __ATOMIC_RELAXED, __HIP_MEMORY_SCOPE_AGENT); }
DI unsigned xb_add(unsigned* p, unsigned v) { return __hip_atomic_fetch_add(p, v, __ATOMIC_RELAXED, __HIP_MEMORY_SCOPE_AGENT); }
DI unsigned xb_xcc_id() { return (unsigned)__builtin_amdgcn_s_getreg((3 << 11) | 20) & 0xFu; }
#define XB_SPIN(cond, bar) do { unsigned _sp = 0; while (cond) { __builtin_amdgcn_s_sleep(1); \
    if ((++_sp & 255u) == 0u) { if (xb_ld(&(bar)[XB_TMO])) break; if (_sp > XB_SPIN_CAP) { atomicAdd(&(bar)[XB_TMO], 1u); break; } } } } while (0)
struct XcdBarrier { unsigned* bar; unsigned x; volatile LAS unsigned* st; };
DI XcdBarrier xcd_barrier_post(unsigned* bar, volatile LAS unsigned* st) {
    XcdBarrier b; b.bar = bar; b.x = xb_xcc_id(); b.st = st;
    if (threadIdx.x == 0) (void)xb_add(&bar[XB_XCNT(b.x)], 1u);
    return b;
}
DI void xcd_barrier_complete(unsigned* bar, unsigned x, unsigned& nloc, unsigned& nx) {
    const unsigned G = gridDim.x * gridDim.y * gridDim.z;
    unsigned sum, cnt, mine, sp = 0u;
    for (;;) {
        sum = 0u; cnt = 0u; mine = 0u;
#pragma unroll
        for (unsigned j = 0; j < 16; ++j) { const unsigned c = xb_ld(&bar[XB_XCNT(j)]); sum += c; cnt += (c > 0u) ? 1u : 0u; mine = (j == x) ? c : mine; }
        if (sum == G) break;
        __builtin_amdgcn_s_sleep(1);
        if ((++sp & 255u) == 0u) { if (xb_ld(&bar[XB_TMO])) break; if (sp > XB_SPIN_CAP) { atomicAdd(&bar[XB_TMO], 1u); break; } }
    }
    nloc = mine > 0u ? mine : 1u; nx = cnt > 0u ? cnt : 1u;
}
DI void xcd_barrier(const XcdBarrier& b) {
    asm volatile("s_waitcnt vmcnt(0)" ::: "memory");
    __syncthreads();
    if (threadIdx.x == 0) {
        unsigned* bar = b.bar;
        __builtin_amdgcn_s_waitcnt(0);
        unsigned nloc = b.st[0], nx = b.st[1];
        if (nloc == 0u) { xcd_barrier_complete(bar, b.x, nloc, nx); b.st[0] = nloc; b.st[1] = nx; }
        const unsigned old = xb_add(&bar[XB_XSUB(b.x)], 1u);
        const unsigned gen = old / nloc;
        if (old + 1u == (gen + 1u) * nloc) {
            __builtin_amdgcn_fence(__ATOMIC_RELEASE, "agent");
            asm volatile("s_waitcnt vmcnt(0)" ::: "memory");
            const unsigned og = xb_add(&bar[XB_TOP], 1u);
            const unsigned tg = og / nx;
            if (og + 1u == (tg + 1u) * nx) xb_add(&bar[XB_TOPGEN], 1u);
            else XB_SPIN(xb_ld(&bar[XB_TOPGEN]) == tg, bar);
            __builtin_amdgcn_fence(__ATOMIC_ACQUIRE, "agent");
            xb_add(&bar[XB_XGEN(b.x)], 1u);
            asm volatile("s_waitcnt vmcnt(0)" ::: "memory");
        } else {
            XB_SPIN(xb_ld(&bar[XB_XGEN(b.x)]) == gen, bar);
            __builtin_amdgcn_fence(__ATOMIC_ACQUIRE, "agent");
            asm volatile("s_waitcnt vmcnt(0)" ::: "memory");
        }
    }
    __syncthreads();
}

DI void ph_conv_x8(const float* X, unsigned char* X8, float* rsx, int bid, int nblk) {
    const int wid = VTID >> 6, lane = VTID & 63;
    for (int row0 = (bid * 4 + wid) * 2; row0 < kT; row0 += nblk * 8) {
        float4 v[2][4];
#pragma unroll
        for (int r = 0; r < 2; ++r)
#pragma unroll
            for (int i = 0; i < 4; ++i) v[r][i] = ((const float4*)(X + (size_t)(row0 + r) * kD))[lane + 64 * i];
#pragma unroll
        for (int r = 0; r < 2; ++r) {
            float s = 0.f, m = 0.f;
#pragma unroll
            for (int i = 0; i < 4; ++i) { const float4 w = v[r][i]; s += w.x * w.x + w.y * w.y + w.z * w.z + w.w * w.w; m = fmaxf(m, fmaxf(fmaxf(fabsf(w.x), fabsf(w.y)), fmaxf(fabsf(w.z), fabsf(w.w)))); }
            s = wave_sum(s); m = wave_max(m);
            const float inv = (m > 0.f) ? 127.f / m : 0.f;
#pragma unroll
            for (int i = 0; i < 4; ++i) { const float4 w = v[r][i];
                const int a = (int)rintf(w.x * inv), b = (int)rintf(w.y * inv), c = (int)rintf(w.z * inv), d = (int)rintf(w.w * inv);
                ((unsigned*)(X8 + (size_t)(row0 + r) * kD))[lane + 64 * i] = (unsigned)(a & 0xff) | ((unsigned)(b & 0xff) << 8) | ((unsigned)(c & 0xff) << 16) | ((unsigned)(d & 0xff) << 24); }
            if (lane == 0) rsx[row0 + r] = m * (1.0f / 127.f) / sqrtf(s * (1.0f / kD) + kEps);
        }
    }
}
DI void ph_colmax(const float* W, int ldw, int nsrc0, int Ncnt, int K, const float* kscale, float* cm, int bid, int nblk, float* smf) {
    float* cmx = smf;
    const int ntn = (Ncnt + 63) / 64, ntk = K / 64, tid = VTID;
    for (int tbase = 0; tbase < ntn * ntk; tbase += nblk) {
        const bool active = tbase + bid < ntn * ntk; const int tile = active ? tbase + bid : 0;
        const int n0 = (tile / ntk) * 64, k0 = (tile % ntk) * 64, r = tid >> 4, c4 = (tid & 15) * 4;
        float4 mx = make_float4(0.f, 0.f, 0.f, 0.f);
        if (n0 + c4 < Ncnt) {
#pragma unroll
            for (int i = 0; i < 4; ++i) { const int k = k0 + r + 16 * i; const float4 v = *(const float4*)(W + (size_t)k * ldw + nsrc0 + n0 + c4); const float ks = kscale ? kscale[k] : 1.f;
                mx.x = fmaxf(mx.x, fabsf(v.x * ks)); mx.y = fmaxf(mx.y, fabsf(v.y * ks)); mx.z = fmaxf(mx.z, fabsf(v.z * ks)); mx.w = fmaxf(mx.w, fabsf(v.w * ks)); }
        }
        __syncthreads();
        cmx[r * 64 + c4] = mx.x; cmx[r * 64 + c4 + 1] = mx.y; cmx[r * 64 + c4 + 2] = mx.z; cmx[r * 64 + c4 + 3] = mx.w;
        __syncthreads();
        if (tid < 64 && active && n0 + tid < Ncnt) { float m = 0.f;
#pragma unroll
            for (int i = 0; i < 16; ++i) m = fmaxf(m, cmx[i * 64 + tid]);
            atomicMax((unsigned*)cm + n0 + tid, __float_as_uint(m)); }
    }
}
DI void ph_conv_wt8(const float* W, int ldw, int nsrc0, int Ncnt, int K, const float* kscale, const float* cm, unsigned char* Wt8, int bid, int nblk, float* smf) {
    float(*tl)[65] = (float(*)[65])smf;
    const int ntn = (Ncnt + 63) / 64, ntk = K / 64, tid = VTID;
    for (int tbase = 0; tbase < ntn * ntk; tbase += nblk) {
        const bool active = tbase + bid < ntn * ntk; const int tile = active ? tbase + bid : 0;
        const int n0 = (tile / ntk) * 64, k0 = (tile % ntk) * 64;
        __syncthreads();
        {
            const int r = tid >> 4, c4 = (tid & 15) * 4;
#pragma unroll
            for (int i = 0; i < 4; ++i) {
                const int k = r + 16 * i;
                float4 v = make_float4(0.f, 0.f, 0.f, 0.f);
                if (n0 + c4 < Ncnt) v = *(const float4*)(W + (size_t)(k0 + k) * ldw + nsrc0 + n0 + c4);
                tl[k][c4] = v.x; tl[k][c4 + 1] = v.y; tl[k][c4 + 2] = v.z; tl[k][c4 + 3] = v.w;
            }
        }
        __syncthreads();
        {
            const int n = tid >> 2, kq = (tid & 3) * 16;
            if (active && n0 + n < Ncnt) {
                const float m = cm[n0 + n], inv = (m > 0.f) ? 127.f / m : 0.f;
                unsigned w[4];
#pragma unroll
                for (int j = 0; j < 4; ++j) { unsigned q = 0;
#pragma unroll
                    for (int b = 0; b < 4; ++b) { const int kk = kq + 4 * j + b; q |= ((unsigned)((int)rintf(tl[kk][n] * (kscale ? kscale[k0 + kk] : 1.f) * inv) & 0xff)) << (8 * b); }
                    w[j] = q; }
                *(uint4*)(Wt8 + (size_t)(n0 + n) * K + k0 + kq) = make_uint4(w[0], w[1], w[2], w[3]);
            }
        }
    }
}
DI void ph_conv_wt(const float* W, int ldw, int nsrc0, int Ncnt, int K, const float* kscale, bf16_t* Wt, int bid, int nblk, float* smf) {
    float(*tl)[65] = (float(*)[65])smf;
    const int ntn = (Ncnt + 63) / 64, ntk = K / 64, tid = VTID;
    for (int tbase = 0; tbase < ntn * ntk; tbase += nblk) {
        const bool active = tbase + bid < ntn * ntk; const int tile = active ? tbase + bid : 0;
        const int n0 = (tile / ntk) * 64, k0 = (tile % ntk) * 64;
        __syncthreads();
        {
            const int r = tid >> 4, c4 = (tid & 15) * 4;
#pragma unroll
            for (int i = 0; i < 4; ++i) {
                const int k = r + 16 * i;
                float4 v = make_float4(0.f, 0.f, 0.f, 0.f);
                if (n0 + c4 < Ncnt) v = *(const float4*)(W + (size_t)(k0 + k) * ldw + nsrc0 + n0 + c4);
                tl[k][c4] = v.x; tl[k][c4 + 1] = v.y; tl[k][c4 + 2] = v.z; tl[k][c4 + 3] = v.w;
            }
        }
        __syncthreads();
        {
            const int n = tid >> 2, kq = (tid & 3) * 16;
            if (active && n0 + n < Ncnt) {
                unsigned w[8];
#pragma unroll
                for (int j = 0; j < 8; ++j) {
                    const float s0 = kscale ? kscale[k0 + kq + 2 * j] : 1.f, s1 = kscale ? kscale[k0 + kq + 2 * j + 1] : 1.f;
                    w[j] = cvtpk(tl[kq + 2 * j][n] * s0, tl[kq + 2 * j + 1][n] * s1);
                }
                uint4* dst = (uint4*)(Wt + (size_t)(n0 + n) * K + k0 + kq);
                dst[0] = make_uint4(w[0], w[1], w[2], w[3]); dst[1] = make_uint4(w[4], w[5], w[6], w[7]);
            }
        }
    }
}
DI void ph_zero_bf16(bf16_t* p, size_t n  , int bid, int nblk) {
    for (size_t i = (size_t)bid * 256 + VTID; i < n / 8; i += (size_t)nblk * 256) ((uint4*)p)[i] = make_uint4(0, 0, 0, 0);
}

DI void ph_conv_plain(const float* src, bf16_t* dst, size_t n  , const float* colscale  , int bid, int nblk) {
    for (size_t i = (size_t)bid * 256 + VTID; i < n / 8; i += (size_t)nblk * 256) {
        float4 a = ((const float4*)src)[2 * i], b = ((const float4*)src)[2 * i + 1];
        if (colscale) { const int c = (int)((i * 8) & (kD - 1)); const float4 s0 = *(const float4*)(colscale + c), s1 = *(const float4*)(colscale + c + 4);
            a.x *= s0.x; a.y *= s0.y; a.z *= s0.z; a.w *= s0.w; b.x *= s1.x; b.y *= s1.y; b.z *= s1.z; b.w *= s1.w; }
        ((uint4*)dst)[i] = make_uint4(cvtpk(a.x, a.y), cvtpk(a.z, a.w), cvtpk(b.x, b.y), cvtpk(b.z, b.w));
    }
}

DI void acc_zero(f32x4 (&acc)[4][4]) {
#pragma unroll
    for (int m = 0; m < 4; ++m)
#pragma unroll
        for (int n = 0; n < 4; ++n) acc[m][n] = (f32x4){0.f, 0.f, 0.f, 0.f};
}
struct LaneId { int wr, wc, fr, fq; };
DI LaneId lane_id() { const int tid = VTID, wid = tid >> 6, lane = tid & 63; return LaneId{wid >> 1, wid & 1, lane & 15, lane >> 4}; }

DI float fsigmoid(float z) { return __builtin_amdgcn_rcpf(1.f + __builtin_amdgcn_exp2f(-z * kLog2e)); }
DI void store_bf4(bf16_t* p, f32x4 v) { *(uint2*)p = make_uint2(cvtpk(v[0], v[1]), cvtpk(v[2], v[3])); }
DI f32x4 load_bf4(const bf16_t* p) { const uint2 u = *(const uint2*)p; return (f32x4){__uint_as_float(u.x << 16), __uint_as_float(u.x & 0xffff0000u), __uint_as_float(u.y << 16), __uint_as_float(u.y & 0xffff0000u)}; }
DI void store_bf8(bf16_t* p, const f32x4& v0, const f32x4& v1) { *(uint4*)p = make_uint4(cvtpk(v0[0], v0[1]), cvtpk(v0[2], v0[3]), cvtpk(v1[0], v1[1]), cvtpk(v1[2], v1[3])); }
DI void load_bf8(const bf16_t* p, f32x4& v0, f32x4& v1) { const uint4 u = *(const uint4*)p;
    v0 = (f32x4){__uint_as_float(u.x << 16), __uint_as_float(u.x & 0xffff0000u), __uint_as_float(u.y << 16), __uint_as_float(u.y & 0xffff0000u)};
    v1 = (f32x4){__uint_as_float(u.z << 16), __uint_as_float(u.z & 0xffff0000u), __uint_as_float(u.w << 16), __uint_as_float(u.w & 0xffff0000u)}; }

namespace pg8 {
#define PG8_LAS __attribute__((address_space(3)))
constexpr int BM = 256, BK = 64, HALF = 128, HTB = HALF * BK * 2  , STAGE_BYTES = 8 * HTB, NXCD = 8, WGM = 8;

__host__ __device__ __forceinline__ int lds_byte(int r, int c) { const int st = (r >> 4) * 2 + (c >> 5), rr = r & 15, cc = c & 31, ob = rr * 64 + cc * 2; return st * 1024 + (ob ^ (((ob >> 9) & 1) << 5)); }
__host__ __device__ __forceinline__ void stage_rc(int b, int& R, int& C) { const int st = b / 1024, sb = b % 1024, swz = sb ^ (((sb >> 9) & 1) << 5); R = (st >> 1) * 16 + swz / 64; C = (st & 1) * 32 + (swz % 64) / 2; }
__host__ __device__ __forceinline__ int perm32(int rho) { const int n = rho >> 4, i = rho & 15; return 8 * (i >> 2) + 4 * n + (i & 3); }

struct Unit { int pm, pn; };
struct Gemm { const bf16_t* A; const bf16_t* Bt; int M, N, K; };

struct StaticOrder {
    int nM, nN, nwg, G, c;
    __host__ __device__ void init(int M, int N, int G_, int c_) { nM = M / BM; nN = N / BM; nwg = nM * nN; G = G_; c = c_; }
    __host__ __device__ bool next(int i, Unit& u) const {
        const long L = (long)i * G + c; if (L >= nwg) return false;
        int wgid = (int)L; { const int q = nwg / NXCD, r = nwg % NXCD, xcd = wgid % NXCD, off = wgid / NXCD; wgid = (xcd < r ? xcd * (q + 1) : r * (q + 1) + (xcd - r) * q) + off; }
        const int nig = WGM * nN, gid = wgid / nig, fm = gid * WGM, gsz = (nM - fm) < WGM ? (nM - fm) : WGM;
        u.pm = fm + ((wgid % nig) % gsz); u.pn = (wgid % nig) / gsz; return true;
    }
    __device__ __forceinline__ void a_ready(const Unit&) const {}
    __device__ __forceinline__ void done(const Unit&) const {}
};
__device__ __forceinline__ unsigned cvt_pk_bf16(float lo, float hi) { unsigned r; asm volatile("v_cvt_pk_bf16_f32 %0, %1, %2" : "=v"(r) : "v"(lo), "v"(hi)); return r; }
typedef float f32x2 __attribute__((ext_vector_type(2)));
template <class Epi, class Sched, bool ALIGN_EPI = false, bool SP2 = false>
__device__ __forceinline__ void gemm_phase(PG8_LAS unsigned char* lds, const Gemm g, const Sched& S, const Epi& E) {
    int tid_ = (int)threadIdx.x; asm volatile("" : "+v"(tid_));
    const int tid = tid_, wid = __builtin_amdgcn_readfirstlane(tid >> 6), lane = tid & 63, wr = wid >> 2, wc = wid & 3, fr = lane & 15, fq = lane >> 4;
    const int K = g.K, nt = K / BK;
    unsigned voffA[2], voffB[2];
#pragma unroll
    for (int i = 0; i < 2; ++i) { int R, C; stage_rc(tid * 16 + i * 8192, R, C); const int Rb = Epi::PERM ? ((R & ~31) + perm32(R & 31)) : R;
        voffA[i] = (unsigned)(R * K + C) * 2u; voffB[i] = (unsigned)(Rb * K + C) * 2u; }
    const size_t kstep = (size_t)(BK * 2);
    const size_t hstep = (size_t)HALF * K * 2;
    const size_t tstep = 2 * hstep;
    const unsigned ldsw = (unsigned)wid * 1024u;
    const int aoff = lds_byte(wr * 64 + fr, fq * 8), boff = lds_byte(wc * 32 + fr, fq * 8);
#define PG8_SA(b, h) (((b) * 2 + (h)) * HTB)
#define PG8_SB(b, h) ((4 + (b) * 2 + (h)) * HTB)
#define PG8_STAGE(bufoff, gbase, voff) do { _Pragma("unroll") for (int _i = 0; _i < 2; ++_i) \
        __builtin_amdgcn_global_load_lds((const unsigned*)((const char*)(gbase) + (voff)[_i]), (PG8_LAS unsigned*)(lds + (bufoff) + ldsw + _i * 8192), 16, 0, 0); } while (0)
#define PG8_LDA(dst, b, h) do { _Pragma("unroll") for (int m = 0; m < 4; ++m) _Pragma("unroll") for (int k = 0; k < 2; ++k) dst[m][k] = *(const PG8_LAS bf16x8*)(lds + PG8_SA(b, h) + aoff + m * 2048 + k * 1024); } while (0)
#define PG8_LDB(dst, b, h) do { _Pragma("unroll") for (int n = 0; n < 2; ++n) _Pragma("unroll") for (int k = 0; k < 2; ++k) dst[n][k] = *(const PG8_LAS bf16x8*)(lds + PG8_SB(b, h) + boff + n * 2048 + k * 1024); } while (0)
#define PG8_MMA(ai, bj, At, Bt) do { __builtin_amdgcn_s_setprio(1); _Pragma("unroll") for (int m = 0; m < 4; ++m) _Pragma("unroll") for (int n = 0; n < 2; ++n) _Pragma("unroll") for (int k = 0; k < 2; ++k) \
        acc[ai][bj][m][n] = __builtin_amdgcn_mfma_f32_16x16x32_bf16(Bt[n][k], At[m][k], acc[ai][bj][m][n], 0, 0, 0); __builtin_amdgcn_s_setprio(0); } while (0)
#define PG8_WAIT_V(n) asm volatile("s_waitcnt vmcnt(" #n ")" ::: "memory")
#define PG8_WAIT_L(n) asm volatile("s_waitcnt lgkmcnt(" #n ")" ::: "memory")
#define PG8_BAR __builtin_amdgcn_s_barrier()
#define PG8_SCHED __builtin_amdgcn_sched_barrier(0)
    Unit cur, nxt; int ui = 0;
    if (!S.next(0, cur)) return;
    f32x4 acc[2][2][4][2];
#pragma unroll
    for (int a = 0; a < 2; ++a)
#pragma unroll
        for (int b = 0; b < 2; ++b)
#pragma unroll
            for (int m = 0; m < 4; ++m)
#pragma unroll
                for (int n = 0; n < 2; ++n) acc[a][b][m][n] = (f32x4){0.f, 0.f, 0.f, 0.f};
    bf16x8 At[4][2], B0[2][2], B1[2][2];
    const char* cA = (const char*)g.A + (size_t)cur.pm * tstep; const char* cB = (const char*)g.Bt + (size_t)cur.pn * tstep;
    S.a_ready(cur);
    if constexpr (SP2) {
        PG8_STAGE(PG8_SB(0, 0), cB, voffB); PG8_STAGE(PG8_SB(0, 1), cB + hstep, voffB); PG8_STAGE(PG8_SA(0, 0), cA, voffA); PG8_STAGE(PG8_SA(0, 1), cA + hstep, voffA);
        if (wr == 1) PG8_BAR;
        PG8_WAIT_V(2); PG8_BAR;
        PG8_STAGE(PG8_SB(1, 0), cB + kstep, voffB); PG8_STAGE(PG8_SA(1, 0), cA + kstep, voffA); PG8_STAGE(PG8_SB(1, 1), cB + hstep + kstep, voffB);
        PG8_WAIT_V(6); PG8_BAR;
    } else {
        PG8_STAGE(PG8_SB(0, 0), cB, voffB); PG8_STAGE(PG8_SA(0, 0), cA, voffA); PG8_STAGE(PG8_SB(0, 1), cB + hstep, voffB); PG8_STAGE(PG8_SA(0, 1), cA + hstep, voffA);
        if (wr == 1) PG8_BAR;
        PG8_WAIT_V(4); PG8_BAR;
        PG8_STAGE(PG8_SB(1, 0), cB + kstep, voffB); PG8_STAGE(PG8_SA(1, 0), cA + kstep, voffA); PG8_STAGE(PG8_SB(1, 1), cB + hstep + kstep, voffB);
        PG8_WAIT_V(6); PG8_BAR;
    }
    for (;;) {
        const bool has_next = S.next(ui + 1, nxt);
        const char* nA = has_next ? (const char*)g.A + (size_t)nxt.pm * tstep : cA; const char* nB = has_next ? (const char*)g.Bt + (size_t)nxt.pn * tstep : cB;
        for (int t = 0; t < nt; t += 2) {
            const bool last = (t == nt - 2);
            const char* a1 = cA + (size_t)(t + 1) * kstep;
            const char* a2 = last ? nA : cA + (size_t)(t + 2) * kstep; const char* b2 = last ? nB : cB + (size_t)(t + 2) * kstep;
            const char* a3 = a2 + kstep; const char* b3 = b2 + kstep;
            if (last && has_next) S.a_ready(nxt);
            if constexpr (SP2) {
            PG8_LDB(B0, 0, 0); PG8_LDB(B1, 0, 1); PG8_SCHED; PG8_LDA(At, 0, 0); PG8_STAGE(PG8_SA(1, 1), a1 + hstep, voffA);
            PG8_WAIT_V(8); PG8_WAIT_L(0); PG8_BAR; PG8_MMA(0, 0, At, B0); PG8_MMA(0, 1, At, B1); PG8_BAR; PG8_SCHED;
            PG8_LDA(At, 0, 1); PG8_STAGE(PG8_SB(0, 0), b2, voffB); PG8_STAGE(PG8_SB(0, 1), b2 + hstep, voffB); PG8_STAGE(PG8_SA(0, 0), a2, voffA);
            PG8_WAIT_V(8); PG8_WAIT_L(0); PG8_BAR; PG8_MMA(1, 0, At, B0); PG8_MMA(1, 1, At, B1); PG8_BAR; PG8_SCHED;
            PG8_LDB(B0, 1, 0); PG8_LDB(B1, 1, 1); PG8_SCHED; PG8_LDA(At, 1, 0); PG8_STAGE(PG8_SA(0, 1), a2 + hstep, voffA);
            PG8_WAIT_V(8); PG8_WAIT_L(0); PG8_BAR; PG8_MMA(0, 0, At, B0); PG8_MMA(0, 1, At, B1); PG8_BAR; PG8_SCHED;
            PG8_LDA(At, 1, 1); PG8_STAGE(PG8_SB(1, 0), b3, voffB); PG8_STAGE(PG8_SB(1, 1), b3 + hstep, voffB); PG8_STAGE(PG8_SA(1, 0), a3, voffA);
            PG8_WAIT_V(8); PG8_WAIT_L(0); PG8_BAR; PG8_MMA(1, 0, At, B0); PG8_MMA(1, 1, At, B1); PG8_BAR; PG8_SCHED;
            } else {
            PG8_LDB(B0, 0, 0); PG8_SCHED; PG8_LDA(At, 0, 0); PG8_STAGE(PG8_SA(1, 1), a1 + hstep, voffA);
            PG8_WAIT_L(8); PG8_BAR; PG8_WAIT_L(0); PG8_MMA(0, 0, At, B0); PG8_BAR; PG8_SCHED;
            PG8_LDB(B1, 0, 1); PG8_STAGE(PG8_SB(0, 0), b2, voffB);
            PG8_BAR; PG8_WAIT_L(0); PG8_MMA(0, 1, At, B1); PG8_BAR;
            PG8_LDA(At, 0, 1); PG8_STAGE(PG8_SA(0, 0), a2, voffA);
            PG8_BAR; PG8_WAIT_L(0); PG8_MMA(1, 0, At, B0); PG8_BAR; PG8_SCHED;
            PG8_STAGE(PG8_SB(0, 1), b2 + hstep, voffB);
            PG8_WAIT_V(6); PG8_BAR; PG8_MMA(1, 1, At, B1); PG8_BAR;
            PG8_LDB(B0, 1, 0); PG8_SCHED; PG8_LDA(At, 1, 0); PG8_STAGE(PG8_SA(0, 1), a2 + hstep, voffA);
            PG8_WAIT_L(8); PG8_BAR; PG8_WAIT_L(0); PG8_MMA(0, 0, At, B0); PG8_BAR; PG8_SCHED;
            PG8_LDB(B1, 1, 1); PG8_STAGE(PG8_SB(1, 0), b3, voffB);
            PG8_BAR; PG8_WAIT_L(0); PG8_MMA(0, 1, At, B1); PG8_BAR;
            PG8_LDA(At, 1, 1); PG8_STAGE(PG8_SA(1, 0), a3, voffA);
            PG8_BAR; PG8_WAIT_L(0); PG8_MMA(1, 0, At, B0); PG8_BAR; PG8_SCHED;
            PG8_STAGE(PG8_SB(1, 1), b3 + hstep, voffB);
            PG8_WAIT_V(6); PG8_BAR; PG8_MMA(1, 1, At, B1); PG8_BAR;
            }
        }
        if constexpr (ALIGN_EPI) { if (wr == 0) PG8_BAR; }
        if constexpr (!Epi::AFTER_DRAIN) { E(acc, cur, wr, wc, fr, fq); S.done(cur); }
        if (!has_next) break;
#pragma unroll
        for (int a = 0; a < 2; ++a)
#pragma unroll
            for (int b = 0; b < 2; ++b)
#pragma unroll
                for (int m = 0; m < 4; ++m)
#pragma unroll
                    for (int n = 0; n < 2; ++n) acc[a][b][m][n] = (f32x4){0.f, 0.f, 0.f, 0.f};
        cur = nxt; cA = nA; cB = nB; ++ui;
        if constexpr (ALIGN_EPI) { if (wr == 1) PG8_BAR; }
    }
    PG8_WAIT_V(0);
    if constexpr (!ALIGN_EPI) { if (wr == 0) PG8_BAR; }
    PG8_BAR;
    if constexpr (Epi::AFTER_DRAIN) { E.fused(acc, cur, wr, wc, fr, fq, lds, wid, lane); S.done(cur); }
#undef PG8_SA
#undef PG8_SB
#undef PG8_STAGE
#undef PG8_LDA
#undef PG8_LDB
#undef PG8_MMA
#undef PG8_WAIT_V
#undef PG8_WAIT_L
#undef PG8_BAR
#undef PG8_SCHED
}
typedef int i32x4 __attribute__((ext_vector_type(4)));
template <class Epi, class Sched, bool ALIGN_EPI = false, bool SP2 = false>
__device__ __forceinline__ void gemm_phase_i8(PG8_LAS unsigned char* lds, const Gemm g, const Sched& S, const Epi& E) {
    int tid_ = (int)threadIdx.x; asm volatile("" : "+v"(tid_));
    const int tid = tid_, wid = __builtin_amdgcn_readfirstlane(tid >> 6), lane = tid & 63, wr = wid >> 2, wc = wid & 3, fr = lane & 15, fq = lane >> 4;
    const int K = g.K, nt = K / BK;
    unsigned voffA[2], voffB[2];
#pragma unroll
    for (int i = 0; i < 2; ++i) { int R, C; stage_rc(tid * 16 + i * 8192, R, C); const int Rb = Epi::PERM ? ((R & ~31) + perm32(R & 31)) : R;
        voffA[i] = (unsigned)(R * K + C) * 2u; voffB[i] = (unsigned)(Rb * K + C) * 2u; }
    const size_t kstep = (size_t)(BK * 2);
    const size_t hstep = (size_t)HALF * K * 2;
    const size_t tstep = 2 * hstep;
    const unsigned ldsw = (unsigned)wid * 1024u;
    const int aoff = lds_byte(wr * 64 + fr, fq * 8), boff = lds_byte(wc * 32 + fr, fq * 8);
#define PG8_SA(b, h) (((b) * 2 + (h)) * HTB)
#define PG8_SB(b, h) ((4 + (b) * 2 + (h)) * HTB)
#define PG8_STAGE(bufoff, gbase, voff) do { _Pragma("unroll") for (int _i = 0; _i < 2; ++_i) \
        __builtin_amdgcn_global_load_lds((const unsigned*)((const char*)(gbase) + (voff)[_i]), (PG8_LAS unsigned*)(lds + (bufoff) + ldsw + _i * 8192), 16, 0, 0); } while (0)
#define PG8_LDA(dst, b, h) do { _Pragma("unroll") for (int m = 0; m < 4; ++m) _Pragma("unroll") for (int k = 0; k < 2; ++k) dst[m][k] = *(const PG8_LAS bf16x8*)(lds + PG8_SA(b, h) + aoff + m * 2048 + k * 1024); } while (0)
#define PG8_LDB(dst, b, h) do { _Pragma("unroll") for (int n = 0; n < 2; ++n) _Pragma("unroll") for (int k = 0; k < 2; ++k) dst[n][k] = *(const PG8_LAS bf16x8*)(lds + PG8_SB(b, h) + boff + n * 2048 + k * 1024); } while (0)
#define PG8_MMA(ai, bj, At, Bt) do { __builtin_amdgcn_s_setprio(1); _Pragma("unroll") for (int m = 0; m < 4; ++m) _Pragma("unroll") for (int n = 0; n < 2; ++n) _Pragma("unroll") for (int k = 0; k < 2; ++k) \
        acc[ai][bj][m][n] = __builtin_amdgcn_mfma_i32_16x16x64_i8(__builtin_bit_cast(i32x4, Bt[n][k]), __builtin_bit_cast(i32x4, At[m][k]), acc[ai][bj][m][n], 0, 0, 0); __builtin_amdgcn_s_setprio(0); } while (0)
#define PG8_WAIT_V(n) asm volatile("s_waitcnt vmcnt(" #n ")" ::: "memory")
#define PG8_WAIT_L(n) asm volatile("s_waitcnt lgkmcnt(" #n ")" ::: "memory")
#define PG8_BAR __builtin_amdgcn_s_barrier()
#define PG8_SCHED __builtin_amdgcn_sched_barrier(0)
    Unit cur, nxt; int ui = 0;
    if (!S.next(0, cur)) return;
    i32x4 acc[2][2][4][2];
#pragma unroll
    for (int a = 0; a < 2; ++a)
#pragma unroll
        for (int b = 0; b < 2; ++b)
#pragma unroll
            for (int m = 0; m < 4; ++m)
#pragma unroll
                for (int n = 0; n < 2; ++n) acc[a][b][m][n] = (i32x4){0, 0, 0, 0};
    bf16x8 At[4][2], B0[2][2], B1[2][2];
    const char* cA = (const char*)g.A + (size_t)cur.pm * tstep; const char* cB = (const char*)g.Bt + (size_t)cur.pn * tstep;
    S.a_ready(cur);
    if constexpr (SP2) {
        PG8_STAGE(PG8_SB(0, 0), cB, voffB); PG8_STAGE(PG8_SB(0, 1), cB + hstep, voffB); PG8_STAGE(PG8_SA(0, 0), cA, voffA); PG8_STAGE(PG8_SA(0, 1), cA + hstep, voffA);
        if (wr == 1) PG8_BAR;
        PG8_WAIT_V(2); PG8_BAR;
        PG8_STAGE(PG8_SB(1, 0), cB + kstep, voffB); PG8_STAGE(PG8_SA(1, 0), cA + kstep, voffA); PG8_STAGE(PG8_SB(1, 1), cB + hstep + kstep, voffB);
        PG8_WAIT_V(6); PG8_BAR;
    } else {
        PG8_STAGE(PG8_SB(0, 0), cB, voffB); PG8_STAGE(PG8_SA(0, 0), cA, voffA); PG8_STAGE(PG8_SB(0, 1), cB + hstep, voffB); PG8_STAGE(PG8_SA(0, 1), cA + hstep, voffA);
        if (wr == 1) PG8_BAR;
        PG8_WAIT_V(4); PG8_BAR;
        PG8_STAGE(PG8_SB(1, 0), cB + kstep, voffB); PG8_STAGE(PG8_SA(1, 0), cA + kstep, voffA); PG8_STAGE(PG8_SB(1, 1), cB + hstep + kstep, voffB);
        PG8_WAIT_V(6); PG8_BAR;
    }
    for (;;) {
        const bool has_next = S.next(ui + 1, nxt);
        const char* nA = has_next ? (const char*)g.A + (size_t)nxt.pm * tstep : cA; const char* nB = has_next ? (const char*)g.Bt + (size_t)nxt.pn * tstep : cB;
        for (int t = 0; t < nt; t += 2) {
            const bool last = (t == nt - 2);
            const char* a1 = cA + (size_t)(t + 1) * kstep;
            const char* a2 = last ? nA : cA + (size_t)(t + 2) * kstep; const char* b2 = last ? nB : cB + (size_t)(t + 2) * kstep;
            const char* a3 = a2 + kstep; const char* b3 = b2 + kstep;
            if (last && has_next) S.a_ready(nxt);
            if constexpr (SP2) {
            PG8_LDB(B0, 0, 0); PG8_LDB(B1, 0, 1); PG8_SCHED; PG8_LDA(At, 0, 0); PG8_STAGE(PG8_SA(1, 1), a1 + hstep, voffA);
            PG8_WAIT_V(8); PG8_WAIT_L(0); PG8_BAR; PG8_MMA(0, 0, At, B0); PG8_MMA(0, 1, At, B1); PG8_BAR; PG8_SCHED;
            PG8_LDA(At, 0, 1); PG8_STAGE(PG8_SB(0, 0), b2, voffB); PG8_STAGE(PG8_SB(0, 1), b2 + hstep, voffB); PG8_STAGE(PG8_SA(0, 0), a2, voffA);
            PG8_WAIT_V(8); PG8_WAIT_L(0); PG8_BAR; PG8_MMA(1, 0, At, B0); PG8_MMA(1, 1, At, B1); PG8_BAR; PG8_SCHED;
            PG8_LDB(B0, 1, 0); PG8_LDB(B1, 1, 1); PG8_SCHED; PG8_LDA(At, 1, 0); PG8_STAGE(PG8_SA(0, 1), a2 + hstep, voffA);
            PG8_WAIT_V(8); PG8_WAIT_L(0); PG8_BAR; PG8_MMA(0, 0, At, B0); PG8_MMA(0, 1, At, B1); PG8_BAR; PG8_SCHED;
            PG8_LDA(At, 1, 1); PG8_STAGE(PG8_SB(1, 0), b3, voffB); PG8_STAGE(PG8_SB(1, 1), b3 + hstep, voffB); PG8_STAGE(PG8_SA(1, 0), a3, voffA);
            PG8_WAIT_V(8); PG8_WAIT_L(0); PG8_BAR; PG8_MMA(1, 0, At, B0); PG8_MMA(1, 1, At, B1); PG8_BAR; PG8_SCHED;
            } else {
            PG8_LDB(B0, 0, 0); PG8_SCHED; PG8_LDA(At, 0, 0); PG8_STAGE(PG8_SA(1, 1), a1 + hstep, voffA);
            PG8_WAIT_L(8); PG8_BAR; PG8_WAIT_L(0); PG8_MMA(0, 0, At, B0); PG8_BAR; PG8_SCHED;
            PG8_LDB(B1, 0, 1); PG8_STAGE(PG8_SB(0, 0), b2, voffB);
            PG8_BAR; PG8_WAIT_L(0); PG8_MMA(0, 1, At, B1); PG8_BAR;
            PG8_LDA(At, 0, 1); PG8_STAGE(PG8_SA(0, 0), a2, voffA);
            PG8_BAR; PG8_WAIT_L(0); PG8_MMA(1, 0, At, B0); PG8_BAR; PG8_SCHED;
            PG8_STAGE(PG8_SB(0, 1), b2 + hstep, voffB);
            PG8_WAIT_V(6); PG8_BAR; PG8_MMA(1, 1, At, B1); PG8_BAR;
            PG8_LDB(B0, 1, 0); PG8_SCHED; PG8_LDA(At, 1, 0); PG8_STAGE(PG8_SA(0, 1), a2 + hstep, voffA);
            PG8_WAIT_L(8); PG8_BAR; PG8_WAIT_L(0); PG8_MMA(0, 0, At, B0); PG8_BAR; PG8_SCHED;
            PG8_LDB(B1, 1, 1); PG8_STAGE(PG8_SB(1, 0), b3, voffB);
            PG8_BAR; PG8_WAIT_L(0); PG8_MMA(0, 1, At, B1); PG8_BAR;
            PG8_LDA(At, 1, 1); PG8_STAGE(PG8_SA(1, 0), a3, voffA);
            PG8_BAR; PG8_WAIT_L(0); PG8_MMA(1, 0, At, B0); PG8_BAR; PG8_SCHED;
            PG8_STAGE(PG8_SB(1, 1), b3 + hstep, voffB);
            PG8_WAIT_V(6); PG8_BAR; PG8_MMA(1, 1, At, B1); PG8_BAR;
            }
        }
        if constexpr (ALIGN_EPI) { if (wr == 0) PG8_BAR; }
        if constexpr (!Epi::AFTER_DRAIN) { E(acc, cur, wr, wc, fr, fq); S.done(cur); }
        if (!has_next) break;
#pragma unroll
        for (int a = 0; a < 2; ++a)
#pragma unroll
            for (int b = 0; b < 2; ++b)
#pragma unroll
                for (int m = 0; m < 4; ++m)
#pragma unroll
                    for (int n = 0; n < 2; ++n) acc[a][b][m][n] = (i32x4){0, 0, 0, 0};
        cur = nxt; cA = nA; cB = nB; ++ui;
        if constexpr (ALIGN_EPI) { if (wr == 1) PG8_BAR; }
    }
    PG8_WAIT_V(0);
    if constexpr (!ALIGN_EPI) { if (wr == 0) PG8_BAR; }
    PG8_BAR;
    if constexpr (Epi::AFTER_DRAIN) { E.fused(acc, cur, wr, wc, fr, fq, lds, wid, lane); S.done(cur); }
#undef PG8_SA
#undef PG8_SB
#undef PG8_STAGE
#undef PG8_LDA
#undef PG8_LDB
#undef PG8_MMA
#undef PG8_WAIT_V
#undef PG8_WAIT_L
#undef PG8_BAR
#undef PG8_SCHED
}
}

struct ProjOut { const float* rs1; const float* lbl; const float* ffb; bf16_t *QH, *LF, *VH, *GH, *FQ, *FK, *FV, *SGA, *SGB; float* LFF; };
DI float rs2_of(const float* SSQ, int row) {
    const f32x4* p = (const f32x4*)(SSQ + (size_t)row * 16); const f32x4 a = p[0], b = p[1], c = p[2], d = p[3];
    const float s = ((a[0] + a[1]) + (a[2] + a[3])) + ((b[0] + b[1]) + (b[2] + b[3])) + ((c[0] + c[1]) + (c[2] + c[3])) + ((d[0] + d[1]) + (d[2] + d[3]));
    return 1.0f / sqrtf(s * (1.0f / kD) + kEps);
}
constexpr int HG_TSTR = 144;
constexpr int HG_KSTR = 272;
DI void hg_load_vt(const bf16_t* VHc  , LAS unsigned char* vt) {
    const int tid = VTID, s = tid & 63, vq = tid >> 6;
#pragma unroll
    for (int i = 0; i < 4; ++i) {
        const int vc = 8 * (vq + 4 * i);
        const uint4 u = *(const uint4*)(VHc + (size_t)s * 512 + vc);
        const unsigned w[4] = {u.x, u.y, u.z, u.w};
#pragma unroll
        for (int j = 0; j < 4; ++j) {
            *(LAS unsigned short*)(vt + (vc + 2 * j) * HG_TSTR + s * 2) = (unsigned short)(w[j] & 0xffffu);
            *(LAS unsigned short*)(vt + (vc + 2 * j + 1) * HG_TSTR + s * 2) = (unsigned short)(w[j] >> 16);
        }
    }
}
DI void ph_hgrn1(const bf16_t* LF, const bf16_t* VH, bf16_t* ST, float* DC, int bid, int nblk, LAS unsigned char* lds) {
    LAS unsigned char* klt = lds;
    LAS unsigned char* vt = lds + 128 * HG_TSTR;
    LAS float* tot = (LAS float*)(lds + 256 * HG_TSTR);
    const int tid = VTID, k = tid & 127, half = tid >> 7; const LaneId li = lane_id();
    for (int ib = 0; ib < 2048; ib += nblk) {
        const int item = ib + bid;
        const int c = item & 63, bh = item >> 6, b = bh >> 2, h = bh & 3;
        const size_t rowbase = (size_t)(b * kS + c * 64) * 512 + h * 128;
        __syncthreads();
        float lf[32], cum[32];
        { float run = 0.f;
#pragma unroll
          for (int i = 0; i < 32; ++i) { lf[i] = bf2f(LF[rowbase + (size_t)(32 * half + i) * 512 + k]); run += lf[i]; cum[i] = run; }
          tot[half * 128 + k] = run; }
        hg_load_vt(VH + rowbase, vt);
        __syncthreads();
        {
            const float t0 = tot[k], t1 = tot[128 + k], r4 = t0 + t1, base = half ? t0 : 0.f;
            unsigned w[16];
#pragma unroll
            for (int i = 0; i < 32; i += 2) {
                const float a0 = (1.f - __builtin_amdgcn_exp2f(lf[i])) * __builtin_amdgcn_exp2f(r4 - (base + cum[i]));
                const float a1 = (1.f - __builtin_amdgcn_exp2f(lf[i + 1])) * __builtin_amdgcn_exp2f(r4 - (base + cum[i + 1]));
                w[i >> 1] = cvtpk(a0, a1);
            }
#pragma unroll
            for (int i = 0; i < 4; ++i) *(LAS u32x4*)(klt + k * HG_TSTR + half * 64 + i * 16) = (u32x4){w[4 * i], w[4 * i + 1], w[4 * i + 2], w[4 * i + 3]};
            if (half == 0) DC[(size_t)item * 128 + k] = __builtin_amdgcn_exp2f(r4);
        }
        __syncthreads();
        f32x4 acc[4][4]; acc_zero(acc);
#pragma unroll
        for (int ks = 0; ks < 2; ++ks) {
            bf16x8 af[4], bfr[4];
#pragma unroll
            for (int m = 0; m < 4; ++m) af[m] = *(const LAS bf16x8*)(vt + (li.wr * 64 + m * 16 + li.fr) * HG_TSTR + ks * 64 + li.fq * 16);
#pragma unroll
            for (int n = 0; n < 4; ++n) bfr[n] = *(const LAS bf16x8*)(klt + (li.wc * 64 + n * 16 + li.fr) * HG_TSTR + ks * 64 + li.fq * 16);
#pragma unroll
            for (int m = 0; m < 4; ++m)
#pragma unroll
                for (int n = 0; n < 4; ++n) acc[m][n] = __builtin_amdgcn_mfma_f32_16x16x32_bf16(bfr[n], af[m], acc[m][n], 0, 0, 0);
        }
        bf16_t* dst = ST + (size_t)item * 16384;
#pragma unroll
        for (int m = 0; m < 4; ++m)
#pragma unroll
            for (int n = 0; n < 4; ++n) store_bf4(dst + (li.wr * 64 + m * 16 + li.fr) * 128 + li.wc * 64 + n * 16 + li.fq * 4, acc[m][n]);
    }
}
DI void ph_hgrn2(bf16_t* ST, const float* DC, int bid, int nblk) {
    for (int u = bid * 256 + VTID; u < 32 * 2048; u += nblk * 256) {
        const int bh = u >> 11, vk = u & 2047, k8 = (vk & 15) * 8;
        float S[8];
#pragma unroll
        for (int j = 0; j < 8; ++j) S[j] = 0.f;
        bf16_t* p = ST + (size_t)bh * 64 * 16384 + (size_t)vk * 8;
        const float* d = DC + (size_t)bh * 64 * 128 + k8;
#pragma unroll 8
        for (int c = 0; c < 64; ++c) {
            const uint4 lt = *(const uint4*)(p + (size_t)c * 16384);
            const float4 d0 = *(const float4*)(d + c * 128), d1 = *(const float4*)(d + c * 128 + 4);
            *(uint4*)(p + (size_t)c * 16384) = make_uint4(cvtpk(S[0], S[1]), cvtpk(S[2], S[3]), cvtpk(S[4], S[5]), cvtpk(S[6], S[7]));
            const float dd[8] = {d0.x, d0.y, d0.z, d0.w, d1.x, d1.y, d1.z, d1.w};
            const unsigned lw[4] = {lt.x, lt.y, lt.z, lt.w};
#pragma unroll
            for (int j = 0; j < 4; ++j) { S[2 * j] = dd[2 * j] * S[2 * j] + __uint_as_float(lw[j] << 16); S[2 * j + 1] = dd[2 * j + 1] * S[2 * j + 1] + __uint_as_float(lw[j] & 0xffff0000u); }
        }
    }
}
DI bf16x8 hg_scale_frag(bf16x8 q, const LAS float* ra, const LAS float* rb  ) {
    const f32x4 a0 = *(const LAS f32x4*)ra, a1 = *(const LAS f32x4*)(ra + 4);
    f32x4 b0 = (f32x4){0.f, 0.f, 0.f, 0.f}, b1 = b0;
    if (rb) { b0 = *(const LAS f32x4*)rb; b1 = *(const LAS f32x4*)(rb + 4); }
    const u32x4 u = __builtin_bit_cast(u32x4, q);
    unsigned w[4];
#pragma unroll
    for (int j = 0; j < 4; ++j) {
        const float ea = (j < 2) ? a0[2 * j] - b0[2 * j] : a1[2 * j - 4] - b1[2 * j - 4];
        const float eb = (j < 2) ? a0[2 * j + 1] - b0[2 * j + 1] : a1[2 * j - 3] - b1[2 * j - 3];
        w[j] = cvtpk(__uint_as_float(u[j] << 16) * __builtin_amdgcn_exp2f(ea), __uint_as_float(u[j] & 0xffff0000u) * __builtin_amdgcn_exp2f(eb));
    }
    return __builtin_bit_cast(bf16x8, (u32x4){w[0], w[1], w[2], w[3]});
}
constexpr int HG3_QH = 0, HG3_KE = 64 * HG_KSTR, HG3_VT = 128 * HG_KSTR, HG3_AM = HG3_VT + 128 * HG_TSTR, HG3_R = HG3_AM + 64 * HG_TSTR, HG3_TOT = HG3_R + 5 * 512, HG3_BYTES = HG3_TOT + 1024;
DI void ph_hgrn3(const bf16_t* QH, const bf16_t* LF, const bf16_t* VH, const bf16_t* GH, const bf16_t* ST, const float* normw, bf16_t* Aout, int bid, int nblk, LAS unsigned char* lds) {
    LAS unsigned char* qh = lds + HG3_QH; LAS unsigned char* ke = lds + HG3_KE; LAS unsigned char* vt = lds + HG3_VT; LAS unsigned char* am = lds + HG3_AM;
    LAS float* R = (LAS float*)(lds + HG3_R); LAS float* tot = (LAS float*)(lds + HG3_TOT);
    const int tid = VTID, k = tid & 127, half = tid >> 7, lane = tid & 63, I = tid >> 6, fr = lane & 15, fq = lane >> 4;
    for (int ib = 0; ib < 2048; ib += nblk) {
        const int item = ib + bid;
        const int c = item & 63, bh = item >> 6, b = bh >> 2, h = bh & 3;
        const size_t rowbase = (size_t)(b * kS + c * 64) * 512 + h * 128;
        uint4 stg[8];
#pragma unroll
        for (int i = 0; i < 8; ++i) stg[i] = *(const uint4*)(ST + (size_t)item * 16384 + (size_t)(tid + 256 * i) * 8);
        __syncthreads();
        float lf[32], cum[32];
        { float run = 0.f;
#pragma unroll
          for (int i = 0; i < 32; ++i) { lf[i] = bf2f(LF[rowbase + (size_t)(32 * half + i) * 512 + k]); run += lf[i]; cum[i] = run; }
          tot[half * 128 + k] = run; }
        hg_load_vt(VH + rowbase, vt);
        __syncthreads();
        {
            const float t0 = tot[k], base = half ? t0 : 0.f;
            const float rmid = base + cum[15], rend = base + cum[31];
            if (half == 0) { R[k] = 0.f; R[128 + k] = rmid; R[256 + k] = rend; } else { R[384 + k] = rmid; R[512 + k] = rend; }
#pragma unroll
            for (int i = 0; i < 32; ++i) {
                const float cf_ = base + cum[i], rI = (i < 16) ? base : rmid, rI1 = (i < 16) ? rmid : rend;
                const float qv = bf2f(QH[rowbase + (size_t)(32 * half + i) * 512 + k]);
                const float qhv = qv * __builtin_amdgcn_exp2f(cf_ - rI);
                const float kev = (1.f - __builtin_amdgcn_exp2f(lf[i])) * __builtin_amdgcn_exp2f(rI1 - cf_);
                *(LAS unsigned short*)(qh + (32 * half + i) * HG_KSTR + k * 2) = (unsigned short)(cvtpk(qhv, 0.f) & 0xffffu);
                *(LAS unsigned short*)(ke + (32 * half + i) * HG_KSTR + k * 2) = (unsigned short)(cvtpk(kev, 0.f) & 0xffffu);
            }
        }
        __syncthreads();
        bf16x8 qf[4];
#pragma unroll
        for (int ks = 0; ks < 4; ++ks) qf[ks] = *(const LAS bf16x8*)(qh + (16 * I + fr) * HG_KSTR + ks * 64 + fq * 16);
        for (int J = 0; J <= I; ++J) {
            f32x4 d = (f32x4){0.f, 0.f, 0.f, 0.f};
#pragma unroll
            for (int ks = 0; ks < 4; ++ks) {
                const bf16x8 kf = *(const LAS bf16x8*)(ke + (16 * J + fr) * HG_KSTR + ks * 64 + fq * 16);
                const bf16x8 qs = (J == I - 1) ? qf[ks] : hg_scale_frag(qf[ks], R + I * 128 + ks * 32 + fq * 8, R + (J + 1) * 128 + ks * 32 + fq * 8);
                d = __builtin_amdgcn_mfma_f32_16x16x32_bf16(kf, qs, d, 0, 0, 0);
            }
            if (J == I) {
#pragma unroll
                for (int j = 0; j < 4; ++j) if (4 * fq + j > fr) d[j] = 0.f;
            }
            *(LAS u32x2*)(am + (16 * I + fr) * HG_TSTR + (16 * J + 4 * fq) * 2) = (u32x2){cvtpk(d[0], d[1]), cvtpk(d[2], d[3])};
        }
        if ((I & 1) == 0) *(LAS u32x2*)(am + (16 * I + fr) * HG_TSTR + (16 * (I + 1) + 4 * fq) * 2) = (u32x2){0u, 0u};
        f32x4 o[8];
#pragma unroll
        for (int n = 0; n < 8; ++n) o[n] = (f32x4){0.f, 0.f, 0.f, 0.f};
        for (int ks = 0; ks <= (I >> 1); ++ks) {
            const bf16x8 af = *(const LAS bf16x8*)(am + (16 * I + fr) * HG_TSTR + ks * 64 + fq * 16);
#pragma unroll
            for (int n = 0; n < 8; ++n) { const bf16x8 vf = *(const LAS bf16x8*)(vt + (n * 16 + fr) * HG_TSTR + ks * 64 + fq * 16); o[n] = __builtin_amdgcn_mfma_f32_16x16x32_bf16(vf, af, o[n], 0, 0, 0); }
        }
        __syncthreads();
#pragma unroll
        for (int i = 0; i < 8; ++i) { const int pc = tid + 256 * i, row = pc >> 4, ch = pc & 15;
            *(LAS u32x4*)(lds + HG3_QH + row * 256 + ((ch ^ (row & 15)) << 4)) = (u32x4){stg[i].x, stg[i].y, stg[i].z, stg[i].w}; }
        __syncthreads();
#pragma unroll
        for (int ks = 0; ks < 4; ++ks) {
            const bf16x8 qc = hg_scale_frag(qf[ks], R + I * 128 + ks * 32 + fq * 8, nullptr);
#pragma unroll
            for (int n = 0; n < 8; ++n) { const bf16x8 sf = *(const LAS bf16x8*)(lds + HG3_QH + (n * 16 + fr) * 256 + (((ks * 4 + fq) ^ fr) << 4)); o[n] = __builtin_amdgcn_mfma_f32_16x16x32_bf16(sf, qc, o[n], 0, 0, 0); }
        }
        float ss = 0.f;
#pragma unroll
        for (int n = 0; n < 8; ++n) ss += o[n][0] * o[n][0] + o[n][1] * o[n][1] + o[n][2] * o[n][2] + o[n][3] * o[n][3];
        ss += __shfl_xor(ss, 16); ss += __shfl_xor(ss, 32);
        const float rstd = 1.0f / sqrtf(ss * (1.0f / 128.f) + kEps);
        const size_t orow = rowbase + (size_t)(16 * I + fr) * 512;
#pragma unroll
        for (int n = 0; n < 8; ++n) {
            const int v0 = n * 16 + 4 * fq;
            const f32x4 g = load_bf4(GH + orow + v0); const f32x4 w = *(const f32x4*)(normw + h * 128 + v0);
            store_bf4(Aout + orow + v0, o[n] * rstd * w * g);
        }
    }
}

DI void ph_cfox(const float* LFF, float* cf, bf16_t* aug, int bid, int nblk, float* sm) {
    const int tid = VTID, lane = tid & 63, wid = tid >> 6;
    for (int seq = bid; seq < 64; seq += nblk) {
        const int b = seq >> 3, h = seq & 7;
        float v[16]; float run = 0.f;
#pragma unroll
        for (int i = 0; i < 16; ++i) { run += LFF[(size_t)(b * kS + tid * 16 + i) * 8 + h]; v[i] = run; }
        float inc = run;
#pragma unroll
        for (int o = 1; o < 64; o <<= 1) { const float n = __shfl_up(inc, o); if (lane >= o) inc += n; }
        __syncthreads();
        if (lane == 63) sm[wid] = inc;
        __syncthreads();
        float base = inc - run;
        for (int w = 0; w < wid; ++w) base += sm[w];
#pragma unroll
        for (int i = 0; i < 16; i += 4) *(float4*)(cf + (size_t)seq * kS + tid * 16 + i) = make_float4(base + v[i], base + v[i + 1], base + v[i + 2], base + v[i + 3]);
#pragma unroll
        for (int i = 0; i < 16; ++i) {
            const float xx = -(base + v[i]); const unsigned b1 = cvtpk(xx, 0.f) & 0xffffu; const float r1 = xx - __uint_as_float(b1 << 16);
            const unsigned b2 = cvtpk(r1, 0.f) & 0xffffu; const float r2 = r1 - __uint_as_float(b2 << 16); const unsigned b3 = cvtpk(r2, 0.f) & 0xffffu;
            *(uint4*)(aug + ((size_t)seq * kS + tid * 16 + i) * 8) = make_uint4(b1 | (b2 << 16), b3 | 0xBF800000u, 0xBF80BF80u, 0u);
        }
    }
}
DI float max3f(float a, float b, float c) { float r; asm("v_max3_f32 %0, %1, %2, %3" : "=v"(r) : "v"(a), "v"(b), "v"(c)); return r; }
DI float max2f(float a, float b) { float r; asm("v_max_f32_e32 %0, %1, %2" : "=v"(r) : "v"(a), "v"(b)); return r; }
typedef float f32x16 __attribute__((ext_vector_type(16)));
typedef short s16x4 __attribute__((ext_vector_type(4)));
namespace at64 {
using bf16 = bf16_t;
constexpr int SEQ = kS, NHEAD = 8, D = 64, DM = NHEAD * D;
constexpr int NW = 8, QBLK = 32, QB = QBLK * NW, KVBLK = 64, NQB = SEQ / QB;
constexpr float C2 = 1.0f;
constexpr int SLOTB = 8192, LDS_K = 0, LDS_V = 3 * SLOTB, LDS_WS = 6 * SLOTB, LDS_OST = LDS_WS + NW * 256, LDS_AUG = LDS_OST + NW * 4096, LDS_BYTES = LDS_AUG + SEQ * 16;
#define ATTN64_THR 8
#define ATTN64_BROKEN 0
#define SBAR() __builtin_amdgcn_sched_barrier(0)
#define PIN(x) asm volatile("" : "+v"(x))
#define MFMA(a, b, c) __builtin_amdgcn_mfma_f32_32x32x16_bf16(a, b, c, 0, 0, 0)
#define WAIT_BAR(N) asm volatile("s_waitcnt vmcnt(" #N ") lgkmcnt(0)\n\ts_barrier" ::: "memory")

__device__ __forceinline__ int crow(int r, int hi) { return (r & 3) + 8 * (r >> 2) + 4 * hi; }
__device__ __forceinline__ unsigned cvtpk(float lo, float hi) { unsigned r; asm("v_cvt_pk_bf16_f32 %0, %1, %2" : "=v"(r) : "v"(lo), "v"(hi)); return r; }
__device__ __forceinline__ void glds16(const void* sbase, unsigned voff, unsigned lds_base) {
    unsigned sv; asm volatile("s_mov_b32 %0, m0\n\ts_mov_b32 m0, %3\n\ts_nop 0\n\tglobal_load_lds_dwordx4 %1, %2\n\ts_mov_b32 m0, %0" : "=&s"(sv) : "v"(voff), "s"(sbase), "s"(lds_base) : "memory"); }
typedef __attribute__((address_space(3))) const char* lds_cptr;
typedef short v4i16_t __attribute__((ext_vector_type(4)));
__device__ __forceinline__ void kload2(bf16x8* kf, lds_cptr kp, int d0) { kf[2 * d0] = *(const __attribute__((address_space(3))) bf16x8*)(kp + d0 * 2048); kf[2 * d0 + 1] = *(const __attribute__((address_space(3))) bf16x8*)(kp + d0 * 2048 + 512); }
__device__ __forceinline__ s16x4 vtr(lds_cptr p) { return __builtin_bit_cast(s16x4, __builtin_amdgcn_ds_read_tr16_b64_v4i16((__attribute__((address_space(3))) v4i16_t*)p)); }
#define MX3(a, b, c) __builtin_fmaxf(__builtin_fmaxf((a), (b)), (c))
__device__ __forceinline__ float rowmax(const f32x16& p0, const f32x16& p1) {
    float a = MX3(p0[0], p0[1], p1[0]), b = MX3(p0[2], p0[3], p1[1]); a = MX3(a, p1[2], p1[3]);
#pragma unroll
    for (int r = 4; r < 16; r += 4) { a = MX3(a, p0[r], p0[r + 1]); b = MX3(b, p0[r + 2], p0[r + 3]); a = MX3(a, p1[r], p1[r + 1]); b = MX3(b, p1[r + 2], p1[r + 3]); }
    float m = __builtin_fmaxf(a, b); auto rr = __builtin_amdgcn_permlane32_swap(__float_as_uint(m), __float_as_uint(m), false, false);
    return __builtin_fmaxf(__uint_as_float(rr[0]), __uint_as_float(rr[1])); }
__device__ __forceinline__ void cmask(f32x16& p0, f32x16& p1, int jb, int qrel, int hi) {
    const int kb = 64 * jb + 4 * hi;
#pragma unroll
    for (int r = 0; r < 16; ++r) { const int kv = kb + (r & 3) + 8 * (r >> 2); if (kv > qrel) p0[r] = -INFINITY; if (kv + 32 > qrel) p1[r] = -INFINITY; } }

__device__ __forceinline__ void attn64_unit(int b, int h, int qb, bool fill, const bf16* Q, const bf16* __restrict__ K, const bf16* __restrict__ V, const bf16* __restrict__ AUG, bf16* O, char* lds) {
    const int tid = threadIdx.x, lane = tid & 63, r32 = lane & 31, hi = lane >> 5; const int wid = __builtin_amdgcn_readfirstlane(tid >> 6);
    const long rowbase = (long)b * SEQ; const int q0 = qb * QB, NT = (q0 + QB) / KVBLK;
    const bf16* Qw = Q + (rowbase + q0 + wid * QBLK) * DM + h * D;
    const unsigned lds0 = (unsigned)(uintptr_t)lds; float* wsf = (float*)(lds + LDS_WS) + wid * 64;
    if (fill) { const char* ag = (const char*)(AUG + ((long)(b * NHEAD + h) * SEQ) * 8); const int nby = (q0 + QB) * 16;
      for (int of = tid * 16; of < nby; of += 64 * NW * 16) *(__attribute__((address_space(3))) u32x4*)((lds_cptr)lds + LDS_AUG + of) = *(const u32x4*)(ag + of); }
    const lds_cptr augp = (lds_cptr)lds + LDS_AUG + r32 * 16;
    bf16x8 qaug = __builtin_bit_cast(bf16x8, (u32x4){hi == 0 ? 0x3F803F80u : 0u, hi == 0 ? 0x00003F80u : 0u, 0u, 0u});
    float mf = 0.f;
#define SETQ() do { const unsigned m1_ = cvtpk(mf, 0.f) & 0xffffu; const float r1_ = mf - __uint_as_float(m1_ << 16); const unsigned m2_ = cvtpk(r1_, 0.f) & 0xffffu; \
        const float r2_ = r1_ - __uint_as_float(m2_ << 16); const unsigned m3_ = cvtpk(r2_, 0.f) & 0xffffu; \
        qaug = __builtin_bit_cast(bf16x8, (u32x4){hi == 0 ? 0x3F803F80u : 0u, hi == 0 ? (0x3F80u | (m1_ << 16)) : 0u, hi == 0 ? (m2_ | (m3_ << 16)) : 0u, 0u}); } while (0)
    bf16x8 ka0, ka1;
#define KAR(st) do { ka0 = *(const __attribute__((address_space(3))) bf16x8*)(augp + (NT - 1 - (st)) * 1024); ka1 = *(const __attribute__((address_space(3))) bf16x8*)(augp + (NT - 1 - (st)) * 1024 + 512); } while (0)
#define KAF(v) (v)
    const bf16* kbase = K + rowbase * DM + h * D + wid * 8; const unsigned koff = (unsigned)lane * (DM * 2);
    const bf16* vbase = V + rowbase * DM + h * D + (long)(16 * (wid & 3)) * DM + (wid >> 2) * 32; const unsigned voff = (unsigned)((lane >> 2) * (DM * 2) + (lane & 3) * 16);
    const unsigned kdst = lds0 + LDS_K + wid * 1024, vdst = lds0 + LDS_V + wid * 1024;
#define DMA_K(t, slot) glds16(kbase + (long)(NT - 1 - (t)) * KVBLK * DM, koff, (unsigned)__builtin_amdgcn_readfirstlane(kdst + (slot)))
#define DMA_V(t, slot) glds16(vbase + (long)(NT - 1 - (t)) * KVBLK * DM, voff, (unsigned)__builtin_amdgcn_readfirstlane(vdst + (slot)))
    const lds_cptr vp0 = (lds_cptr)lds + LDS_V + ((lane >> 4) & 1) * 32 + (lane & 3) * 8 + (4 * hi + ((lane & 15) >> 2)) * 64;
    const lds_cptr kp0 = (lds_cptr)lds + LDS_K + hi * 1024 + r32 * 16;
    DMA_K(0, 0); DMA_V(0, 0); DMA_K(1, SLOTB);
    bf16x8 qr[4];
#pragma unroll
    for (int d0 = 0; d0 < 4; ++d0) qr[d0] = *reinterpret_cast<const bf16x8*>(&Qw[(long)r32 * DM + d0 * 16 + hi * 8]);
    float mhat = 0.f, l_reg = 0.f; f32x16 o[2]; o[0] = f32x16{}; o[1] = f32x16{};
    const f32x16 zero16 = f32x16{};
    const int qrel = wid * QBLK + r32; bool resc = false;
    f32x16 pA0, pA1, pB0, pB1; bf16x8 kf[8]; s16x4 vlo[8], vhi[8]; u32x4 pw0, pw1, pw2, pw3;
    int sl_prev = 0, sl_cur = 0, sl_next = SLOTB;
#define ROT() do { sl_prev = sl_cur; sl_cur = sl_next; sl_next = (sl_next == 2 * SLOTB) ? 0 : sl_next + SLOTB; } while (0)
#define EX0(v) __builtin_amdgcn_exp2f(__builtin_fmaf((v), C2, nmh))
#define EX(v) __builtin_amdgcn_exp2f(v)
#define RESC() do { if (resc && !ATTN64_BROKEN) { _Pragma("unroll") for (int d_ = 0; d_ < 2; ++d_) _Pragma("unroll") for (int r = 0; r < 16; ++r) o[d_][r] *= wsf[crow(r, hi)]; } } while (0)
    DMA_K(2, 2 * SLOTB);
    WAIT_BAR(3);
    _Pragma("unroll") for (int d0 = 0; d0 < 4; ++d0) kload2(kf, kp0, d0);
    pA0 = MFMA(kf[0], qr[0], zero16); pA1 = MFMA(kf[1], qr[0], zero16); pA0 = MFMA(kf[2], qr[1], pA0); pA1 = MFMA(kf[3], qr[1], pA1);
    pA0 = MFMA(kf[4], qr[2], pA0); pA1 = MFMA(kf[5], qr[2], pA1); pA0 = MFMA(kf[6], qr[3], pA0); pA1 = MFMA(kf[7], qr[3], pA1);
    KAR(0); pA0 = MFMA(KAF(ka0), qaug, pA0); pA1 = MFMA(KAF(ka1), qaug, pA1);
    cmask(pA0, pA1, 3, qrel, hi);
    { const float rm = rowmax(pA0, pA1); mhat = __builtin_fmaxf(rm, -1e30f) * C2; const float nmh = -mhat;
#pragma unroll
      for (int r = 0; r < 16; ++r) { pA0[r] = EX0(pA0[r]); pA1[r] = EX0(pA1[r]); }
      mf = (mhat < -0.5e30f) ? 0.f : mhat; SETQ(); }
    WAIT_BAR(0);
    DMA_K(3, 0); DMA_V(1, SLOTB); ROT();
    _Pragma("unroll") for (int d0 = 0; d0 < 4; ++d0) kload2(kf, kp0 + sl_cur, d0);
    WAIT_BAR(2);
#define PKW(P, i) cvtpk(P[i], P[i + 1])
#define PAF(k) __builtin_bit_cast(bf16x8, pw##k)
#define VFR(i) (bf16x8){vlo[i][0], vlo[i][1], vlo[i][2], vlo[i][3], vhi[i][0], vhi[i][1], vhi[i][2], vhi[i][3]}
#define VRD(i) do { vlo[i] = vtr(vp_ + (((i) >> 2) * 4096 + ((i) & 3) * 1024)); vhi[i] = vtr(vp_ + (((i) >> 2) * 4096 + ((i) & 3) * 1024 + 512)); } while (0)
#define KRD(G, d0) do { if (G) { kload2(kf, kp0 + sl_next, d0); SBAR(); } } while (0)
#define GAPA(MF, a0, a1, a2, a3, W0, W1, PW) do { MF; sacc += a0; sacc += a1; sacc += a2; sacc += a3; W0; W1; PIN(PW); PIN(sacc); SBAR(); } while (0)
#define GAPB(MF, X, i) do { MF; X[i] = EX(X[i]); X[i + 1] = EX(X[i + 1]); X[i + 2] = EX(X[i + 2]); X[i + 3] = EX(X[i + 3]); PIN(X); SBAR(); } while (0)
#define STEP(C0, C1, P0, P1, t, MASK, GK, GV, GL) do { SBAR(); \
    const lds_cptr vp_ = vp0 + sl_prev; \
    VRD(0); SBAR(); float sacc = P0[0] + P0[1];                                                                                                       \
                    GAPA(C0 = MFMA(kf[0], qr[0], zero16), P0[2], P0[3], P0[4], P0[5],     pw0[0] = PKW(P0, 0),  pw0[1] = PKW(P0, 2),  pw0); \
    VRD(4); SBAR(); GAPA(C1 = MFMA(kf[1], qr[0], zero16), P0[6], P0[7], P0[8], P0[9],     pw0[2] = PKW(P0, 4),  pw0[3] = PKW(P0, 6),  pw0); \
    VRD(1); SBAR(); GAPA(C0 = MFMA(kf[2], qr[1], C0),    P0[10], P0[11], P0[12], P0[13], pw1[0] = PKW(P0, 8),  pw1[1] = PKW(P0, 10), pw1); \
    VRD(5); SBAR(); GAPA(C1 = MFMA(kf[3], qr[1], C1),    P0[14], P0[15], P1[0], P1[1],   pw1[2] = PKW(P0, 12), pw1[3] = PKW(P0, 14), pw1); \
    VRD(2); SBAR(); GAPA(C0 = MFMA(kf[4], qr[2], C0),    P1[2], P1[3], P1[4], P1[5],     pw2[0] = PKW(P1, 0),  pw2[1] = PKW(P1, 2),  pw2); \
    KAR(t); SBAR();                                                                                                                                    \
    VRD(6); SBAR(); GAPA(C1 = MFMA(kf[5], qr[2], C1),    P1[6], P1[7], P1[8], P1[9],     pw2[2] = PKW(P1, 4),  pw2[3] = PKW(P1, 6),  pw2); \
    VRD(3); SBAR(); GAPA(C0 = MFMA(kf[6], qr[3], C0),    P1[10], P1[11], P1[12], P1[13], pw3[0] = PKW(P1, 8),  pw3[1] = PKW(P1, 10), pw3); \
    VRD(7); SBAR(); GAPA(C1 = MFMA(kf[7], qr[3], C1),    P1[14], P1[15], 0.f, 0.f,       pw3[2] = PKW(P1, 12), pw3[3] = PKW(P1, 14), pw3); \
    C0 = MFMA(KAF(ka0), qaug, C0); C1 = MFMA(KAF(ka1), qaug, C1); SBAR();                                                  \
    l_reg += sacc; \
    if (GK) DMA_K((t) + 3, sl_cur); if (GV) DMA_V((t) + 1, sl_next);                                                       \
    if ((t) <= 3) cmask(C0, C1, 3 - (t), qrel, hi);                                                                         \
    { const float rmx = rowmax(C0, C1), rm = rmx + (mf - mhat); resc = false;                                               \
      if (__builtin_expect(__any(rm > (float)ATTN64_THR), 0)) { const float dl = __builtin_fmaxf(rm, 0.f);                    \
          const float mnew = (mhat < -0.5e30f) ? ((dl > 0.f) ? rmx + mf : mhat) : mhat + dl; \
          const float f = __builtin_amdgcn_exp2f(-dl); l_reg *= f; if (hi == 0) wsf[r32] = f; resc = true; \
          const float mfn = (mnew < -0.5e30f) ? 0.f : mnew, adj = mfn - mf;                                                   \
          _Pragma("unroll") for (int r = 0; r < 16; ++r) { C0[r] -= adj; C1[r] -= adj; } \
          mhat = mnew; mf = mfn; SETQ(); } } \
    SBAR(); \
    GAPB(o[0] = MFMA(PAF(0), VFR(0), o[0]), C0, 0);              GAPB(o[1] = MFMA(PAF(0), VFR(4), o[1]), C0, 4); \
    KRD(GL, 0); GAPB(o[0] = MFMA(PAF(1), VFR(1), o[0]), C0, 8);  KRD(GL, 1); GAPB(o[1] = MFMA(PAF(1), VFR(5), o[1]), C0, 12);                                     \
    KRD(GL, 2); GAPB(o[0] = MFMA(PAF(2), VFR(2), o[0]), C1, 0);  KRD(GL, 3); GAPB(o[1] = MFMA(PAF(2), VFR(6), o[1]), C1, 4); \
    GAPB(o[0] = MFMA(PAF(3), VFR(3), o[0]), C1, 8);              GAPB(o[1] = MFMA(PAF(3), VFR(7), o[1]), C1, 12); \
    } while (0)
    int t = 1;
    for (; t + 5 < NT; t += 2) {
        STEP(pB0, pB1, pA0, pA1, t, false, true, true, true);     WAIT_BAR(2); RESC(); ROT();
        STEP(pA0, pA1, pB0, pB1, t + 1, false, true, true, true); WAIT_BAR(2); RESC(); ROT();
    }
#define ENDW(tt) do { if ((tt) + 3 < NT) { WAIT_BAR(2); } else if ((tt) + 2 < NT) { WAIT_BAR(1); } else { WAIT_BAR(0); } } while (0)
    for (; t + 1 < NT; t += 2) {
        STEP(pB0, pB1, pA0, pA1, t, true, (t + 3 < NT), (t + 1 < NT), (t + 1 < NT));         ENDW(t);     RESC(); ROT();
        STEP(pA0, pA1, pB0, pB1, t + 1, true, (t + 4 < NT), (t + 2 < NT), (t + 2 < NT));     ENDW(t + 1); RESC(); ROT();
    }
    STEP(pB0, pB1, pA0, pA1, NT - 1, true, false, false, false); RESC();
    { float sacc = pB0[0] + pB0[1];
#pragma unroll
      for (int r = 2; r < 16; ++r) sacc += pB0[r];
#pragma unroll
      for (int r = 0; r < 16; ++r) sacc += pB1[r];
      l_reg += sacc;
      pw0 = (u32x4){PKW(pB0, 0), PKW(pB0, 2), PKW(pB0, 4), PKW(pB0, 6)}; pw1 = (u32x4){PKW(pB0, 8), PKW(pB0, 10), PKW(pB0, 12), PKW(pB0, 14)};
      pw2 = (u32x4){PKW(pB1, 0), PKW(pB1, 2), PKW(pB1, 4), PKW(pB1, 6)}; pw3 = (u32x4){PKW(pB1, 8), PKW(pB1, 10), PKW(pB1, 12), PKW(pB1, 14)};
      const lds_cptr vp_ = vp0 + sl_cur; _Pragma("unroll") for (int i = 0; i < 8; ++i) VRD(i);
      o[0] = MFMA(PAF(0), VFR(0), o[0]); o[1] = MFMA(PAF(0), VFR(4), o[1]); o[0] = MFMA(PAF(1), VFR(1), o[0]); o[1] = MFMA(PAF(1), VFR(5), o[1]);
      o[0] = MFMA(PAF(2), VFR(2), o[0]); o[1] = MFMA(PAF(2), VFR(6), o[1]); o[0] = MFMA(PAF(3), VFR(3), o[0]); o[1] = MFMA(PAF(3), VFR(7), o[1]); }
    { auto rr = __builtin_amdgcn_permlane32_swap(__float_as_uint(l_reg), __float_as_uint(l_reg), false, false); l_reg = __uint_as_float(rr[0]) + __uint_as_float(rr[1]); }
    if (hi == 0) wsf[32 + r32] = l_reg; asm volatile("s_waitcnt lgkmcnt(0)" ::: "memory");
    float rli[16];
#pragma unroll
    for (int r = 0; r < 16; ++r) rli[r] = __builtin_amdgcn_rcpf(wsf[32 + crow(r, hi)]);
    bf16* Ow = O + (rowbase + q0 + wid * QBLK) * DM + h * D; bf16* stg = (bf16*)(lds + LDS_OST) + wid * 2048;
#pragma unroll
    for (int r = 0; r < 16; ++r) { const int orow = crow(r, hi);
#pragma unroll
        for (int d0 = 0; d0 < 2; ++d0) stg[orow * 64 + d0 * 32 + r32] = (bf16)(cvtpk(o[d0][r] * rli[r], 0.f) & 0xffffu); }
    asm volatile("s_waitcnt lgkmcnt(0)" ::: "memory");
#pragma unroll
    for (int i = 0; i < 4; ++i) { const int row = i * 8 + (lane >> 3), ch = lane & 7; *(u32x4*)(Ow + (long)row * DM + ch * 8) = *(const u32x4*)(stg + row * 64 + ch * 8); }
    asm volatile("s_waitcnt lgkmcnt(0)\n\ts_barrier" ::: "memory");
#undef DMA_K
#undef DMA_V
#undef ROT
#undef EX
#undef RESC
#undef PKW
#undef PAF
#undef VFR
#undef VRD
#undef KRD
#undef ENDW
#undef GAPA
#undef GAPB
#undef STEP
#undef KAR
#undef KAF
#undef SETQ
#undef EX0
}
#undef SBAR
#undef PIN
#undef MFMA
#undef WAIT_BAR
#undef MX3
__device__ __forceinline__ void run_all(const bf16* Q, const bf16* K, const bf16* V, const bf16* AUG, bf16* O, char* lds) {
    constexpr int NPAIR = NQB / 2;
    for (int i = (int)blockIdx.x; i < kB * NHEAD * NPAIR; i += (int)gridDim.x) {
        const int x = i & 7, kk = i >> 3, bh = x + 8 * (kk / NPAIR), j = kk % NPAIR;
        attn64_unit(bh / NHEAD, bh % NHEAD, NQB - 1 - j, true, Q, K, V, AUG, O, lds);
        attn64_unit(bh / NHEAD, bh % NHEAD, j, false, Q, K, V, AUG, O, lds);
    }
}
}

DI float min2f(float a, float b) { float r; asm("v_min_f32_e32 %0, %1, %2" : "=v"(r) : "v"(a), "v"(b)); return r; }
#define CE_DESC(a, b) do { const float hi_ = max2f(a, b), lo_ = min2f(a, b); a = hi_; b = lo_; } while (0)
template <int N> DI void bitonic_sort_desc(float* v) {
#pragma unroll
    for (int k = 2; k <= N; k <<= 1)
#pragma unroll
        for (int j = k >> 1; j > 0; j >>= 1)
#pragma unroll
            for (int i = 0; i < N; ++i) { const int l = i ^ j; if (l > i) { if ((i & k) == 0) CE_DESC(v[i], v[l]); else CE_DESC(v[l], v[i]); } }
}
DI void bitonic_merge16_desc(float* c) {
#pragma unroll
    for (int j = 8; j > 0; j >>= 1)
#pragma unroll
        for (int i = 0; i < 16; ++i) { const int l = i ^ j; if (l > i) CE_DESC(c[i], c[l]); }
}
DI void top16_merge(float* a, const float* b) {
#pragma unroll
    for (int i = 0; i < 16; ++i) a[i] = max2f(a[i], b[15 - i]);
    bitonic_merge16_desc(a);
}
DI void top16_xlane(float* a, int mask) {
    float o[16];
#pragma unroll
    for (int i = 0; i < 16; ++i) o[i] = __shfl_xor(a[i], mask);
    top16_merge(a, o);
}
template <bool STAGE, bool LOOP>
DI void ph_topk2(const bf16_t* Q, const bf16_t* SKb, int* idx, float* gate, int bid, int nblk, LAS unsigned char* lds) {
    const int tid = VTID, lane = tid & 63, wid = tid >> 6, fr = lane & 15, fq = lane >> 4;
    LAS unsigned* tab = (LAS unsigned*)(lds + 65536 + wid * 2304) + fr * 33;
    const int h = bid & 7;
    if (STAGE) {
        const bf16_t* src = SKb + (size_t)h * 2 * 128 * 128;
#pragma unroll 4
        for (int i = 0; i < 16; ++i) {
            const int pc = tid + 256 * i, row = pc >> 4, ch = pc & 15;
            const uint4 v = *(const uint4*)(src + (size_t)row * 128 + ch * 8);
            *(LAS u32x4*)(lds + row * 256 + ((ch ^ (row & 15)) << 4)) = (u32x4){v.x, v.y, v.z, v.w};
        }
    }
    if (STAGE) __syncthreads();
    if (!LOOP) return;
    const int ntile = kT / 16, hw = (bid >> 3) * 4 + wid, nhw = (nblk >> 3) * 4;
    for (int tile = hw; tile < ntile; tile += nhw) {
        const int t0 = tile * 16;
        float L[2][16];
#pragma unroll
        for (int p = 0; p < 2; ++p) {
            f32x4 acc[8];
#pragma unroll
            for (int n = 0; n < 8; ++n) acc[n] = (f32x4){0.f, 0.f, 0.f, 0.f};
            const bf16_t* qp = Q + (size_t)(t0 + fr) * 2048 + h * 256 + p * 128 + fq * 8;
#pragma unroll
            for (int ks = 0; ks < 4; ++ks) {
                const bf16x8 af = *(const bf16x8*)(qp + ks * 32);
#pragma unroll
                for (int n = 0; n < 8; ++n) { const bf16x8 kf = *(const LAS bf16x8*)(lds + (p * 128 + n * 16 + fr) * 256 + (((ks * 4 + fq) ^ fr) << 4)); acc[n] = __builtin_amdgcn_mfma_f32_16x16x32_bf16(kf, af, acc[n], 0, 0, 0); }
            }
            float v[32];
#pragma unroll
            for (int n = 0; n < 8; ++n)
#pragma unroll
                for (int j = 0; j < 4; ++j) v[n * 4 + j] = __uint_as_float((__float_as_uint(acc[n][j]) & ~0x7fu) | (unsigned)(n * 16 + 4 * fq + j));
            bitonic_sort_desc<16>(v); bitonic_sort_desc<16>(v + 16);
            top16_merge(v, v + 16);
            top16_xlane(v, 16); top16_xlane(v, 32);
#pragma unroll
            for (int i = 0; i < 16; ++i) L[p][i] = v[i];
        }
        if (fq == 0) {
#pragma unroll
            for (int i = 0; i < 16; ++i) { tab[i] = __float_as_uint(L[0][i]) & 0x7fu; tab[16 + i] = __float_as_uint(L[1][i]) & 0x7fu; }
        }
        float c[64]; int cnt = 0;
#pragma unroll
        for (int a = 0; a < 16; ++a)
#pragma unroll
            for (int b = 0; b < 16; ++b)
                if ((a + 1) * (b + 1) <= 16) {
                    const float s = __uint_as_float(__float_as_uint(L[0][a]) & ~0x7fu) + __uint_as_float(__float_as_uint(L[1][b]) & ~0x7fu);
                    c[cnt++] = __uint_as_float((__float_as_uint(s) & ~0xffu) | (unsigned)(a * 16 + b));
                }
#pragma unroll
        for (int i = 50; i < 64; ++i) c[i] = -1e30f;
        bitonic_sort_desc<16>(c); bitonic_sort_desc<16>(c + 16); bitonic_sort_desc<16>(c + 32); bitonic_sort_desc<16>(c + 48);
        top16_merge(c, c + 16); top16_merge(c + 32, c + 48); top16_merge(c, c + 32);
        float e[16]; int id[16]; float sum = 0.f;
        const float mx = __uint_as_float(__float_as_uint(c[0]) & ~0xffu);
#pragma unroll
        for (int r = 0; r < 16; ++r) {
            const unsigned bits = __float_as_uint(c[r]); const int a = (bits >> 4) & 15, b = bits & 15;
            id[r] = (int)(tab[a] * 128u + tab[16 + b]);
            e[r] = __builtin_amdgcn_exp2f((__uint_as_float(bits & ~0xffu) - mx) * kLog2e); sum += e[r];
        }
        const float inv = 1.f / sum;
        if (fq == 0) {
            int* ip = idx + (size_t)(t0 + fr) * 128 + h * 16; float* gp = gate + (size_t)(t0 + fr) * 128 + h * 16;
#pragma unroll
            for (int r = 0; r < 16; r += 4) { *(int4*)(ip + r) = make_int4(id[r], id[r + 1], id[r + 2], id[r + 3]); *(float4*)(gp + r) = make_float4(e[r] * inv, e[r + 1] * inv, e[r + 2] * inv, e[r + 3] * inv); }
        }
    }
}

typedef int i32x4 __attribute__((ext_vector_type(4)));
template <int SLICED> DI void ph_quant_rows(const float* src, const float* colscale, unsigned char* dst, float* scale, int bias, int bid, int nblk) {
    const int wid = VTID >> 6, lane = VTID & 63;
    for (int row0 = (bid * 4 + wid) * 2; row0 < 16384; row0 += nblk * 8) {
        float4 v[2][4];
#pragma unroll
        for (int r = 0; r < 2; ++r)
#pragma unroll
            for (int i = 0; i < 4; ++i) v[r][i] = ((const float4*)(src + (size_t)(row0 + r) * kD))[lane + 64 * i];
#pragma unroll
        for (int r = 0; r < 2; ++r) {
            const int row = row0 + r; float m = 0.f;
#pragma unroll
            for (int i = 0; i < 4; ++i) {
                if (colscale) { const float4 sc = ((const float4*)colscale)[lane + 64 * i]; v[r][i].x *= sc.x; v[r][i].y *= sc.y; v[r][i].z *= sc.z; v[r][i].w *= sc.w; }
                m = fmaxf(m, fmaxf(fmaxf(fabsf(v[r][i].x), fabsf(v[r][i].y)), fmaxf(fabsf(v[r][i].z), fabsf(v[r][i].w))));
            }
            m = wave_max(m);
            const float inv = (m > 0.f) ? 127.f / m : 0.f;
#pragma unroll
            for (int i = 0; i < 4; ++i) {
                const int a = (int)rintf(v[r][i].x * inv) + bias, b = (int)rintf(v[r][i].y * inv) + bias, c = (int)rintf(v[r][i].z * inv) + bias, d = (int)rintf(v[r][i].w * inv) + bias;
                const unsigned pk_ = (unsigned)(a & 0xff) | ((unsigned)(b & 0xff) << 8) | ((unsigned)(c & 0xff) << 16) | ((unsigned)(d & 0xff) << 24);
                const int col_ = (lane + 64 * i) * 4;
                if (SLICED) *(unsigned*)(dst + ((size_t)(col_ >> 7) * 16384 + row) * 128 + (col_ & 127)) = pk_;
                else ((unsigned*)(dst + (size_t)row * kD))[lane + 64 * i] = pk_;
            }
            if (lane == 0) scale[row] = (m > 0.f) ? m * (1.0f / 127.f) : 1.f;
        }
    }
}
DI float gelu_fast(float v) {
    const float av = fabsf(v), t = __builtin_amdgcn_rcpf(av * 0.2316418882f + 1.0f);
    float q = t * 0.5307027145f + (-0.7265760135f); q = q * t + 0.7107068705f; q = q * t + (-0.142248368f); q = q * t + 0.127414796f; q = q * t;
    const float m = v * (q * __builtin_amdgcn_exp2f((v * v) * (-0.72134752044f)));
    return v < 0.f ? m : v - m;
}
constexpr int EXW_BYTES = 19584;
constexpr int EX6_LIST = 8192, EX6_TOT = EX6_LIST + 4096, EX6_SXR = EX6_TOT + 4096;
DI void ph_exp_u7(const bf16_t* Hb, const float* SSQ, const unsigned char* U8, const float* su, const float* sv, const int* idx, const float* gate, float* abuf,
                  int bid, int nblk, LAS unsigned char* lds) {
    const int tid = VTID, lane = tid & 63, wid = tid >> 6, fr = lane & 15;
    LAS unsigned char* wl = lds + wid * EXW_BYTES;
    LAS unsigned* list = (LAS unsigned*)(wl + EX6_LIST); LAS int* tot = (LAS int*)(wl + EX6_TOT); LAS float* sxr = (LAS float*)(wl + EX6_SXR);
    const unsigned long long lt = (1ull << lane) - 1ull;
    const unsigned lane16 = (unsigned)lane * 16u;
    for (int tg = bid * 4 + wid; tg < kT / 8; tg += nblk * 4) {
        const int t0 = tg * 8;
#pragma unroll 4
        for (int tl = 0; tl < 8; ++tl) {
            const size_t t = (size_t)(t0 + tl);
            const uint4 x0 = *(const uint4*)(Hb + t * kD + lane * 16), x1 = *(const uint4*)(Hb + t * kD + lane * 16 + 8);
            float sq = SSQ[t * 16 + fr];
            float xf[16];
            { const unsigned ww[8] = {x0.x, x0.y, x0.z, x0.w, x1.x, x1.y, x1.z, x1.w};
#pragma unroll
              for (int j = 0; j < 8; ++j) { xf[2 * j] = __uint_as_float(ww[j] << 16); xf[2 * j + 1] = __uint_as_float(ww[j] & 0xffff0000u); } }
            float m = 0.f;
#pragma unroll
            for (int j = 0; j < 16; ++j) m = fmaxf(m, fabsf(xf[j]));
            m = wave_max(m);
            const float inv = (m > 0.f) ? 127.f / m : 0.f;
            unsigned pk[4];
#pragma unroll
            for (int j = 0; j < 4; ++j) {
                const int a = (int)rintf(xf[4 * j] * inv), b = (int)rintf(xf[4 * j + 1] * inv), c = (int)rintf(xf[4 * j + 2] * inv), d = (int)rintf(xf[4 * j + 3] * inv);
                pk[j] = (unsigned)(a & 0xff) | ((unsigned)(b & 0xff) << 8) | ((unsigned)(c & 0xff) << 16) | ((unsigned)(d & 0xff) << 24);
            }
            *(LAS u32x4*)(wl + tl * 1024 + lane * 16) = (u32x4){pk[0], pk[1], pk[2], pk[3]};
            sq += __shfl_xor(sq, 1); sq += __shfl_xor(sq, 2); sq += __shfl_xor(sq, 4); sq += __shfl_xor(sq, 8);
            if (lane == 0) sxr[tl] = m * (1.0f / 127.f) / sqrtf(sq * (1.0f / kD) + kEps);
        }
        {
            int ev[16];
#pragma unroll
            for (int k = 0; k < 8; ++k) { const size_t t = (size_t)(t0 + k); ev[2 * k] = idx[t * 128 + lane]; ev[2 * k + 1] = idx[t * 128 + 64 + lane]; }
            int n = 0;
#pragma unroll 1
            for (int r = 0; r < 8; ++r) {
#pragma unroll
                for (int k = 0; k < 16; ++k) {
                    const bool in = (ev[k] >> 11) == r;
                    const unsigned long long b = __ballot(in);
                    if (in) list[n + __popcll(b & lt)] = (unsigned)ev[k] | ((unsigned)(k >> 1) << 14) | ((unsigned)((k & 1) * 64 + lane) << 18);
                    n += __popcll(b);
                }
            }
        }
#define EU7_LOAD(ub, en, sb_) do { const unsigned lv_ = list[min((sb_) * 8 + (lane & 7), 1023)]; \
            _Pragma("unroll") for (int j_ = 0; j_ < 8; ++j_) { en[j_] = (unsigned)__builtin_amdgcn_readlane((int)lv_, j_); \
                ub[j_] = *(const uint4*)(U8 + (size_t)(en[j_] & 16383u) * kD + lane16); } } while (0)
#define EU7_COMP(ub, en, sb_) do { i32x4 xq_[8]; int p_[8]; \
            _Pragma("unroll") for (int j_ = 0; j_ < 8; ++j_) xq_[j_] = *(const LAS i32x4*)(wl + ((en[j_] >> 14) & 7u) * 1024u + lane16); \
            _Pragma("unroll") for (int j_ = 0; j_ < 8; ++j_) p_[j_] = __builtin_amdgcn_sdot4((int)ub[j_].x, xq_[j_][0], 0, false); \
            _Pragma("unroll") for (int j_ = 0; j_ < 8; ++j_) p_[j_] = __builtin_amdgcn_sdot4((int)ub[j_].y, xq_[j_][1], p_[j_], false); \
            _Pragma("unroll") for (int j_ = 0; j_ < 8; ++j_) p_[j_] = __builtin_amdgcn_sdot4((int)ub[j_].z, xq_[j_][2], p_[j_], false); \
            _Pragma("unroll") for (int j_ = 0; j_ < 8; ++j_) p_[j_] = __builtin_amdgcn_sdot4((int)ub[j_].w, xq_[j_][3], p_[j_], false); \
            _Pragma("unroll") for (int j_ = 0; j_ < 4; ++j_) { \
                const int hi_ = p_[j_ + 4] + __builtin_amdgcn_update_dpp(0, p_[j_ + 4], 0x114, 0xF, 0xF, true), lo_ = p_[j_] + __builtin_amdgcn_update_dpp(0, p_[j_], 0x104, 0xF, 0xF, true); \
                p_[j_] = (lane & 4) ? hi_ : lo_; } \
            _Pragma("unroll") for (int j_ = 0; j_ < 2; ++j_) { \
                const int hi_ = p_[j_ + 2] + __builtin_amdgcn_update_dpp(0, p_[j_ + 2], 0x4E, 0xF, 0xF, true), lo_ = p_[j_] + __builtin_amdgcn_update_dpp(0, p_[j_], 0x4E, 0xF, 0xF, true); \
                p_[j_] = (lane & 2) ? hi_ : lo_; } \
            { const int hi_ = p_[1] + __builtin_amdgcn_update_dpp(0, p_[1], 0xB1, 0xF, 0xF, true), lo_ = p_[0] + __builtin_amdgcn_update_dpp(0, p_[0], 0xB1, 0xF, 0xF, true); \
              p_[0] = (lane & 1) ? hi_ : lo_; } \
            int s_ = p_[0] + __builtin_amdgcn_update_dpp(0, p_[0], 0x128, 0xF, 0xF, true); \
            { const auto r_ = __builtin_amdgcn_permlane16_swap((unsigned)s_, (unsigned)s_, false, false); s_ = (int)(r_[0] + r_[1]); } \
            { const auto r_ = __builtin_amdgcn_permlane32_swap((unsigned)s_, (unsigned)s_, false, false); s_ = (int)(r_[0] + r_[1]); } \
            if (lane < 8) tot[(sb_) * 8 + lane] = s_; } while (0)
        uint4 uA[8], uB[8], uC[8]; unsigned eA[8], eB[8], eC[8];
        EU7_LOAD(uA, eA, 0); __builtin_amdgcn_sched_barrier(0); EU7_LOAD(uB, eB, 1); __builtin_amdgcn_sched_barrier(0);
#pragma unroll 1
        for (int sb = 0; sb < 128; sb += 3) {
            EU7_LOAD(uC, eC, sb + 2); EU7_COMP(uA, eA, sb);
            EU7_LOAD(uA, eA, sb + 3); if (sb + 1 < 128) EU7_COMP(uB, eB, sb + 1);
            EU7_LOAD(uB, eB, sb + 4); if (sb + 2 < 128) EU7_COMP(uC, eC, sb + 2);
        }
#undef EU7_LOAD
#undef EU7_COMP
#pragma unroll 1
        for (int i0 = lane; i0 < 1024; i0 += 512) {
            float su8[8], sv8[8], g8[8]; unsigned en8[8];
#pragma unroll
            for (int q = 0; q < 8; ++q) {
                en8[q] = list[i0 + 64 * q]; const int e = en8[q] & 16383;
                su8[q] = su[e]; sv8[q] = sv[e]; g8[q] = gate[(size_t)(t0 + ((en8[q] >> 14) & 7)) * 128 + (en8[q] >> 18)];
            }
#pragma unroll
            for (int q = 0; q < 8; ++q) {
                const int tl = (en8[q] >> 14) & 7, slot = en8[q] >> 18;
                const float sdot = (float)tot[i0 + 64 * q] * (su8[q] * sxr[tl]);
                abuf[(size_t)(t0 + tl) * 128 + slot] = gelu_fast(sdot) * g8[q] * sv8[q];
            }
        }
    }
}
DI void tr4x4(unsigned r0, unsigned r1, unsigned r2, unsigned r3, unsigned (&c)[4]) {
    const unsigned t0 = __builtin_amdgcn_perm(r1, r0, 0x05010400u), t1 = __builtin_amdgcn_perm(r1, r0, 0x07030602u);
    const unsigned t2 = __builtin_amdgcn_perm(r3, r2, 0x05010400u), t3 = __builtin_amdgcn_perm(r3, r2, 0x07030602u);
    c[0] = __builtin_amdgcn_perm(t2, t0, 0x05040100u); c[1] = __builtin_amdgcn_perm(t2, t0, 0x07060302u);
    c[2] = __builtin_amdgcn_perm(t3, t1, 0x05040100u); c[3] = __builtin_amdgcn_perm(t3, t1, 0x07060302u);
}
constexpr int EV8_ACC = 0, EV8_LIST = 16384, EV8_SA = EV8_LIST + 2560;
DI void ph_exp_v8(const bf16_t* Hres, const unsigned char* V8, const int* idx, const float* abuf, const float* nlw, float* out, int bid, int nblk, LAS unsigned char* lds) {
    const int tid = VTID, lane = tid & 63, wid = tid >> 6;
    LAS unsigned char* wl = lds + wid * EXW_BYTES;
    LAS unsigned* list = (LAS unsigned*)(wl + EV8_LIST); LAS float* sal = (LAS float*)(wl + EV8_SA); LAS int* acc = (LAS int*)(wl + EV8_ACC);
    const unsigned long long lt = (1ull << lane) - 1ull;
    const unsigned lane16 = (unsigned)lane * 16u;
    for (int tg = bid * 4 + wid; tg < kT / 4; tg += nblk * 4) {
        const int t0 = tg * 4;
        int n = 0;
        {
            int ev[8], a8[8];
#pragma unroll
            for (int tl = 0; tl < 4; ++tl) {
                const size_t t = (size_t)(t0 + tl);
                const float a0 = abuf[t * 128 + lane], a1 = abuf[t * 128 + 64 + lane];
                ev[2 * tl] = idx[t * 128 + lane]; ev[2 * tl + 1] = idx[t * 128 + 64 + lane];
                const float m = wave_max(fmaxf(fabsf(a0), fabsf(a1)));
                const float inv = (m > 0.f) ? 127.f / m : 0.f;
                a8[2 * tl] = (int)rintf(a0 * inv); a8[2 * tl + 1] = (int)rintf(a1 * inv);
                if (lane == 0) sal[tl] = m * (1.0f / 127.f);
#pragma unroll
                for (int q = 0; q < 4; ++q) *(LAS u32x4*)(wl + EV8_ACC + tl * 4096 + q * 1024 + lane16) = (u32x4){0u, 0u, 0u, 0u};
            }
#pragma unroll 1
            for (int r = 0; r < 8; ++r) {
#pragma unroll
                for (int k = 0; k < 8; ++k) {
                    const bool in = (ev[k] >> 11) == r;
                    const unsigned long long b = __ballot(in);
                    if (in) list[n + __popcll(b & lt)] = (unsigned)ev[k] | ((unsigned)(k >> 1) << 14) | ((unsigned)(a8[k] & 0xff) << 16);
                    n += __popcll(b);
                    if (k & 1) { const int pad = (-n) & 3; if (lane < pad) list[n + lane] = ((unsigned)r << 11) | ((unsigned)(k >> 1) << 14); n += pad; }
                }
            }
        }
        int yi[16];
#pragma unroll
        for (int j = 0; j < 16; ++j) yi[j] = 0;
        int cur = 0;
        const int nsb = (n + 7) >> 3, last = n - 1;
#define EV8_FLUSH() do { _Pragma("unroll") for (int j_ = 0; j_ < 16; ++j_) { atomicAdd((int*)(acc + cur * 1024 + j_ * 64 + lane), yi[j_]); yi[j_] = 0; } } while (0)
#define EV8_LOAD(ub, en, sb_) do { const int i_ = (sb_) * 8 + (lane & 7); unsigned lv_ = list[min(i_, last)]; lv_ = (i_ > last) ? (lv_ & 0xff00ffffu) : lv_; \
            _Pragma("unroll") for (int j_ = 0; j_ < 8; ++j_) { en[j_] = (unsigned)__builtin_amdgcn_readlane((int)lv_, j_); \
                ub[j_] = *(const uint4*)(V8 + (size_t)(en[j_] & 16383u) * kD + lane16); } } while (0)
#define EV8_COMP(ub, en) do { _Pragma("unroll") for (int h_ = 0; h_ < 2; ++h_) { \
            const int tlh_ = (int)((en[4 * h_] >> 14) & 3u); \
            if (tlh_ != cur) { EV8_FLUSH(); cur = tlh_; } \
            const int aw_ = (int)(((en[4 * h_] >> 16) & 0xffu) | (((en[4 * h_ + 1] >> 16) & 0xffu) << 8) | (((en[4 * h_ + 2] >> 16) & 0xffu) << 16) | ((en[4 * h_ + 3] >> 16) << 24)); \
            unsigned c_[4]; \
            tr4x4(ub[4 * h_].x, ub[4 * h_ + 1].x, ub[4 * h_ + 2].x, ub[4 * h_ + 3].x, c_); \
            _Pragma("unroll") for (int k_ = 0; k_ < 4; ++k_) yi[k_] = __builtin_amdgcn_sdot4((int)c_[k_], aw_, yi[k_], false); \
            tr4x4(ub[4 * h_].y, ub[4 * h_ + 1].y, ub[4 * h_ + 2].y, ub[4 * h_ + 3].y, c_); \
            _Pragma("unroll") for (int k_ = 0; k_ < 4; ++k_) yi[4 + k_] = __builtin_amdgcn_sdot4((int)c_[k_], aw_, yi[4 + k_], false); \
            tr4x4(ub[4 * h_].z, ub[4 * h_ + 1].z, ub[4 * h_ + 2].z, ub[4 * h_ + 3].z, c_); \
            _Pragma("unroll") for (int k_ = 0; k_ < 4; ++k_) yi[8 + k_] = __builtin_amdgcn_sdot4((int)c_[k_], aw_, yi[8 + k_], false); \
            tr4x4(ub[4 * h_].w, ub[4 * h_ + 1].w, ub[4 * h_ + 2].w, ub[4 * h_ + 3].w, c_); \
            _Pragma("unroll") for (int k_ = 0; k_ < 4; ++k_) yi[12 + k_] = __builtin_amdgcn_sdot4((int)c_[k_], aw_, yi[12 + k_], false); } } while (0)
        uint4 uA[8], uB[8], uC[8]; unsigned eA[8], eB[8], eC[8];
        EV8_LOAD(uA, eA, 0); __builtin_amdgcn_sched_barrier(0); EV8_LOAD(uB, eB, 1); __builtin_amdgcn_sched_barrier(0);
#pragma unroll 1
        for (int sb = 0; sb < nsb; sb += 3) {
            EV8_LOAD(uC, eC, sb + 2); EV8_COMP(uA, eA);
            EV8_LOAD(uA, eA, sb + 3); if (sb + 1 < nsb) EV8_COMP(uB, eB);
            EV8_LOAD(uB, eB, sb + 4); if (sb + 2 < nsb) EV8_COMP(uC, eC);
        }
        EV8_FLUSH();
#undef EV8_LOAD
#undef EV8_COMP
#undef EV8_FLUSH
        uint4 hres[4][2];
#pragma unroll
        for (int tl = 0; tl < 4; ++tl) { hres[tl][0] = *(const uint4*)(Hres + (size_t)(t0 + tl) * kD + lane * 16); hres[tl][1] = *(const uint4*)(Hres + (size_t)(t0 + tl) * kD + lane * 16 + 8); }
#pragma unroll
        for (int tl = 0; tl < 4; ++tl) {
            const size_t t = (size_t)(t0 + tl);
            const float sa = sal[tl];
            const uint4 h0 = hres[tl][0], h1 = hres[tl][1];
            const unsigned hw[8] = {h0.x, h0.y, h0.z, h0.w, h1.x, h1.y, h1.z, h1.w};
            float y[16]; float ss = 0.f;
#pragma unroll
            for (int j = 0; j < 16; ++j) {
                const float hv = (j & 1) ? __uint_as_float(hw[j >> 1] & 0xffff0000u) : __uint_as_float(hw[j >> 1] << 16);
                y[j] = (float)acc[tl * 1024 + j * 64 + lane] * sa + hv; ss += y[j] * y[j];
            }
            ss += __shfl_xor(ss, 1); ss += __shfl_xor(ss, 2); ss += __shfl_xor(ss, 4); ss += __shfl_xor(ss, 8); ss += __shfl_xor(ss, 16); ss += __shfl_xor(ss, 32);
            const float rr = 1.0f / sqrtf(ss * (1.0f / kD) + kEps);
            float* op = out + t * kD + lane * 16;
#pragma unroll
            for (int q = 0; q < 4; ++q) {
                const float4 w4 = *(const float4*)(nlw + lane * 16 + 4 * q);
                *(float4*)(op + 4 * q) = make_float4(y[4 * q] * rr * w4.x, y[4 * q + 1] * rr * w4.y, y[4 * q + 2] * rr * w4.z, y[4 * q + 3] * rr * w4.w);
            }
        }
    }
}

constexpr int EPI_LDS_OFF = 131072, EPI_LDS_WAVE = 2048;
DI void epi_strip(const f32x4& a0, const f32x4& a1, LAS unsigned char* wl, int fr, int fq, f32x4& v0, f32x4& v1) {
    *(LAS f32x4*)(wl + fr * 128 + (((0 + fq) ^ (fr & 7)) << 4)) = a0;
    *(LAS f32x4*)(wl + fr * 128 + (((4 + fq) ^ (fr & 7)) << 4)) = a1;
    const int lane = fr + 16 * fq, r = lane >> 2, c = lane & 3;
    v0 = *(const LAS f32x4*)(wl + r * 128 + (((2 * c) ^ (r & 7)) << 4));
    v1 = *(const LAS f32x4*)(wl + r * 128 + (((2 * c + 1) ^ (r & 7)) << 4));
}
struct Epi8Proj {
    static constexpr bool PERM = false, AFTER_DRAIN = false;
    ProjOut o; const float* sw; LAS unsigned char* lds_epi;
    template <int KIND> DI void half(const pg8::i32x4 (&acc)[2][2][4][2], int bj, int rowb  , int colp  , int cl0  , bf16_t* dst, float sc, int fr, int fq, LAS unsigned char* wl) const {
        const int lane = fr + 16 * fq, r = lane >> 2, cl = cl0 + 8 * (lane & 3);
        float lb[8] = {0.f, 0.f, 0.f, 0.f, 0.f, 0.f, 0.f, 0.f};
        if (KIND == 1) {
#pragma unroll
            for (int j = 0; j < 8; ++j) lb[j] = fsigmoid(o.lbl[cl + j] - o.lbl[512 + cl + j]);
        }
        const f32x4 sw0 = *(const f32x4*)(sw + colp + 8 * (lane & 3)), sw1 = *(const f32x4*)(sw + colp + 8 * (lane & 3) + 4);
        float rsn = o.rs1[rowb + r];
#pragma unroll
        for (int ai = 0; ai < 2; ++ai)
#pragma unroll
            for (int m = 0; m < 4; ++m) {
                f32x4 v0, v1;
                epi_strip(__builtin_convertvector(ai == 0 ? acc[0][bj][m][0] : acc[1][bj][m][0], f32x4), __builtin_convertvector(ai == 0 ? acc[0][bj][m][1] : acc[1][bj][m][1], f32x4), wl, fr, fq, v0, v1);
                const int row = rowb + ai * 128 + m * 16 + r;
                const float rs = rsn * (sc * (1.0f / 127.f));
                { const int nb_ = ai * 4 + m + 1; if (nb_ < 8) rsn = o.rs1[rowb + (nb_ >> 2) * 128 + (nb_ & 3) * 16 + r]; }
                v0 = v0 * sw0 * rs; v1 = v1 * sw1 * rs;
                if (KIND == 0) { for (int j = 0; j < 4; ++j) { v0[j] = v0[j] * fsigmoid(v0[j]); v1[j] = v1[j] * fsigmoid(v1[j]); } store_bf8((bf16_t*)((unsigned char*)dst + (size_t)(unsigned)((row * 512 + cl) * 2)), v0, v1); }
                else if (KIND == 1) { for (int j = 0; j < 4; ++j) { v0[j] = __builtin_amdgcn_logf(lb[j] + (1.f - lb[j]) * fsigmoid(v0[j])); v1[j] = __builtin_amdgcn_logf(lb[4 + j] + (1.f - lb[4 + j]) * fsigmoid(v1[j])); }
                    store_bf8((bf16_t*)((unsigned char*)dst + (size_t)(unsigned)((row * 512 + cl) * 2)), v0, v1); }
                else if (KIND == 2) store_bf8((bf16_t*)((unsigned char*)dst + (size_t)(unsigned)((row * 512 + cl) * 2)), v0, v1);
                else { for (int j = 0; j < 4; ++j) { v0[j] = fsigmoid(v0[j]); v1[j] = fsigmoid(v1[j]); } store_bf8((bf16_t*)((unsigned char*)dst + (size_t)(unsigned)((row * 1024 + cl) * 2)), v0, v1); }
                asm volatile("" ::: "memory");
            }
    }
    DI void half_fv(const pg8::i32x4 (&acc)[2][2][4][2], int bj, int row00, int colp0, int cl0, int fr, int fq, int wc) const {
#pragma unroll
        for (int n = 0; n < 2; ++n) {
            const int cl = cl0 + wc * 32 + n * 16 + fq * 4;
            const f32x4 swv = *(const f32x4*)(sw + colp0 + wc * 32 + n * 16 + fq * 4);
#pragma unroll
            for (int ai = 0; ai < 2; ++ai)
#pragma unroll
                for (int m = 0; m < 4; ++m) {
                    const int row = row00 + ai * 128 + m * 16;
                    const f32x4 z = __builtin_convertvector(ai == 0 ? acc[0][bj][m][n] : acc[1][bj][m][n], f32x4) * swv * (o.rs1[row] * (1.0f / 127.f));
                    bf16_t* d = o.FV + ((size_t)((row >> 12) * 512 + cl)) * kS + (row & (kS - 1));
                    for (int j = 0; j < 4; ++j) d[(size_t)j * kS] = (bf16_t)(cvtpk(z[j], 0.f) & 0xffffu);
                }
        }
    }
    DI void operator()(const pg8::i32x4 (&acc)[2][2][4][2], const pg8::Unit& u, int wr, int wc, int fr_in, int fq_in) const {
        int fr = fr_in, fq = fq_in; asm volatile("" : "+v"(fr), "+v"(fq));
        const int rowb = u.pm * 256 + wr * 64;
        LAS unsigned char* wl = lds_epi + (wr * 4 + wc) * EPI_LDS_WAVE;
#pragma unroll
        for (int bj = 0; bj < 2; ++bj) {
            const int colh = u.pn * 256 + bj * 128, cw = wc * 32, cp = colh + cw;
            if (colh < 512) half<0>(acc, bj, rowb, cp, colh + cw, o.QH, 1.f, fr, fq, wl);
            else if (colh < 1024) half<1>(acc, bj, rowb, cp, colh - 512 + cw, o.LF, 1.f, fr, fq, wl);
            else if (colh < 1536) half<2>(acc, bj, rowb, cp, colh - 1024 + cw, o.VH, 1.f, fr, fq, wl);
            else if (colh < 2048) half<0>(acc, bj, rowb, cp, colh - 1536 + cw, o.GH, 1.f, fr, fq, wl);
            else if (colh < 2560) half<2>(acc, bj, rowb, cp, colh - 2048 + cw, o.FQ, 0.125f * kLog2e, fr, fq, wl);
            else if (colh < 3072) half<2>(acc, bj, rowb, cp, colh - 2560 + cw, o.FK, 1.f, fr, fq, wl);
            else if (colh < 3584) half<2>(acc, bj, rowb, cp, colh - 3072 + cw, o.FV, 1.f, fr, fq, wl);
            else if (colh < 3712) { if (wc == 0 && fq < 2) {
                    const f32x4 swv = *(const f32x4*)(sw + colh + fq * 4);
#pragma unroll
                    for (int ai = 0; ai < 2; ++ai)
#pragma unroll
                        for (int m = 0; m < 4; ++m) { const int row = rowb + fr + ai * 128 + m * 16; const f32x4 z = __builtin_convertvector(ai == 0 ? acc[0][bj][m][0] : acc[1][bj][m][0], f32x4) * swv * (o.rs1[row] * (1.0f / 127.f)); f32x4 q;
                            for (int j = 0; j < 4; ++j) q[j] = -__builtin_amdgcn_logf(1.f + __builtin_amdgcn_exp2f(-(z[j] + o.ffb[fq * 4 + j]) * kLog2e));
                            *(f32x4*)(o.LFF + (size_t)row * 8 + fq * 4) = q; } } }
            else if (colh < 4736) half<5>(acc, bj, rowb, cp, colh - 3712 + cw, o.SGA, 1.f, fr, fq, wl);
            else if (colh < kINP) half<5>(acc, bj, rowb, cp, colh - 4736 + cw, o.SGB, 1.f, fr, fq, wl);
        }
    }
};
DI void unpack_bf8(const uint4& u, f32x4& v0, f32x4& v1) {
    v0 = (f32x4){__uint_as_float(u.x << 16), __uint_as_float(u.x & 0xffff0000u), __uint_as_float(u.y << 16), __uint_as_float(u.y & 0xffff0000u)};
    v1 = (f32x4){__uint_as_float(u.z << 16), __uint_as_float(u.z & 0xffff0000u), __uint_as_float(u.w << 16), __uint_as_float(u.w & 0xffff0000u)}; }
struct Epi8Gate {
    static constexpr bool PERM = false, AFTER_DRAIN = false;
    const bf16_t* G; bf16_t* Mg; int mode; LAS unsigned char* lds_epi;
    DI void operator()(const f32x4 (&acc)[2][2][4][2], const pg8::Unit& u, int wr, int wc, int fr, int fq) const {
        LAS unsigned char* wl = lds_epi + (wr * 4 + wc) * EPI_LDS_WAVE; const int lane = fr + 16 * fq, r = lane >> 2, c8 = 8 * (lane & 3);
        const size_t base = (size_t)(u.pm * 256 + wr * 64 + r) * 1024 + u.pn * 256 + wc * 32 + c8;
#define EPG_OFF(blk) (base + (size_t)((((blk) >> 3) * 128 + (((blk) >> 1) & 3) * 16) * 1024 + ((blk) & 1) * 128))
        uint4 gn = *(const uint4*)(G + EPG_OFF(0)), pn = make_uint4(0u, 0u, 0u, 0u);
        if (mode) pn = *(const uint4*)(Mg + EPG_OFF(0));
#pragma unroll
        for (int blk = 0; blk < 16; ++blk) {
            const int ai = blk >> 3, m = (blk >> 1) & 3, bj = blk & 1;
            const uint4 gc = gn, pc = pn;
            if (blk + 1 < 16) { gn = *(const uint4*)(G + EPG_OFF(blk + 1)); if (mode) pn = *(const uint4*)(Mg + EPG_OFF(blk + 1)); }
            f32x4 v0, v1; epi_strip(acc[ai][bj][m][0], acc[ai][bj][m][1], wl, fr, fq, v0, v1);
            f32x4 g0, g1; unpack_bf8(gc, g0, g1); v0 = v0 * g0; v1 = v1 * g1;
            if (mode) { f32x4 p0, p1; unpack_bf8(pc, p0, p1); v0 += p0; v1 += p1; }
            store_bf8(Mg + EPG_OFF(blk), v0, v1);
        }
#undef EPG_OFF
    }
};
struct Epi8Wout {
    static constexpr bool PERM = false, AFTER_DRAIN = false;
    const float* X; bf16_t* Hb; float* SSQ; LAS unsigned char* lds_epi;
    DI void operator()(const f32x4 (&acc)[2][2][4][2], const pg8::Unit& u, int wr, int wc, int fr, int fq) const {
        LAS unsigned char* wl = lds_epi + (wr * 4 + wc) * EPI_LDS_WAVE; const int lane = fr + 16 * fq, r = lane >> 2, c8 = 8 * (lane & 3);
        const int row0 = u.pm * 256 + wr * 64 + r;
        const size_t base = (size_t)row0 * 1024 + u.pn * 256 + wc * 32 + c8;
#define EPO_OFF(blk) (base + (size_t)((((blk) >> 3) * 128 + (((blk) >> 1) & 3) * 16) * 1024 + ((blk) & 1) * 128))
        f32x4 xn0 = *(const f32x4*)(X + EPO_OFF(0)), xn1 = *(const f32x4*)(X + EPO_OFF(0) + 4);
        float ss = 0.f;
#pragma unroll
        for (int blk = 0; blk < 16; ++blk) {
            const int ai = blk >> 3, m = (blk >> 1) & 3, bj = blk & 1;
            const f32x4 x0 = xn0, x1 = xn1;
            if (blk + 1 < 16) { xn0 = *(const f32x4*)(X + EPO_OFF(blk + 1)); xn1 = *(const f32x4*)(X + EPO_OFF(blk + 1) + 4); }
            f32x4 v0, v1; epi_strip(acc[ai][bj][m][0], acc[ai][bj][m][1], wl, fr, fq, v0, v1);
            v0 += x0; v1 += x1;
            store_bf8(Hb + EPO_OFF(blk), v0, v1);
            ss += (v0[0] * v0[0] + v0[1] * v0[1]) + (v0[2] * v0[2] + v0[3] * v0[3]) + (v1[0] * v1[0] + v1[1] * v1[1]) + (v1[2] * v1[2] + v1[3] * v1[3]);
            if (bj == 1) {
                ss += __shfl_xor(ss, 1); ss += __shfl_xor(ss, 2);
                if ((lane & 3) == 0) SSQ[(size_t)(row0 + ai * 128 + m * 16) * 16 + u.pn * 4 + wc] = ss;
                ss = 0.f;
            }
        }
#undef EPO_OFF
    }
};
struct Epi8Wq {
    static constexpr bool PERM = false, AFTER_DRAIN = false;
    const float* SSQ; bf16_t* Q; LAS unsigned char* lds_epi;
    DI void operator()(const f32x4 (&acc)[2][2][4][2], const pg8::Unit& u, int wr, int wc, int fr, int fq) const {
        LAS unsigned char* wl = lds_epi + (wr * 4 + wc) * EPI_LDS_WAVE; const int lane = fr + 16 * fq, r = lane >> 2, c8 = 8 * (lane & 3);
        const int row0 = u.pm * 256 + wr * 64 + r;
        f32x4 sp[8];
#pragma unroll
        for (int q = 0; q < 8; ++q) sp[q] = *(const f32x4*)(SSQ + (size_t)(row0 + (q >> 2) * 128 + (q & 3) * 16) * 16 + 4 * (lane & 3));
#pragma unroll
        for (int ai = 0; ai < 2; ++ai)
#pragma unroll
            for (int m = 0; m < 4; ++m) {
                const int row = row0 + ai * 128 + m * 16;
                const f32x4 a = sp[ai * 4 + m];
                float s4 = (a[0] + a[1]) + (a[2] + a[3]); s4 += __shfl_xor(s4, 1); s4 += __shfl_xor(s4, 2);
                const float r2 = 1.0f / sqrtf(s4 * (1.0f / kD) + kEps);
#pragma unroll
                for (int bj = 0; bj < 2; ++bj) {
                    f32x4 v0, v1; epi_strip(acc[ai][bj][m][0], acc[ai][bj][m][1], wl, fr, fq, v0, v1);
                    store_bf8(Q + (size_t)row * 2048 + u.pn * 256 + bj * 128 + wc * 32 + c8, v0 * r2, v1 * r2);
                }
            }
    }
};

constexpr int NPHASE = 9;
template <int PH>
DI void run_phase(const Params& p, int bid, int nblk, float* sm) {
    unsigned char* ws = p.ws;
    float* rs1 = (float*)(ws + OFF_RS1); float* SSQ = (float*)(ws + OFF_SSQ); float* cf = (float*)(ws + OFF_CFOX); float* LFF = (float*)(ws + OFF_LFF);
    int* idx = (int*)(ws + OFF_IDX); float* gate = (float*)(ws + OFF_GATE);
    bf16_t* Wtin = (bf16_t*)(ws + OFF_WTIN); bf16_t* Wta = (bf16_t*)(ws + OFF_WTA); bf16_t* Wtb = (bf16_t*)(ws + OFF_WTB); bf16_t* Wto = (bf16_t*)(ws + OFF_WTOUT); bf16_t* Wtq = (bf16_t*)(ws + OFF_WTQ); bf16_t* SKb = (bf16_t*)(ws + OFF_SKB); unsigned char* U8 = ws + OFF_UB; unsigned char* V8 = ws + OFF_VB; float* abuf = (float*)(ws + OFF_ABUF); float* su = (float*)(ws + OFF_SU); float* sv = (float*)(ws + OFF_SV);
    bf16_t* Xb = (bf16_t*)(ws + OFF_R1); bf16_t* ST = Xb; float* DC = (float*)(ws + OFF_DC);
    bf16_t* QH = (bf16_t*)(ws + OFF_R2); bf16_t* LF = QH + (size_t)kT * 512; bf16_t* Mg = QH;
    bf16_t* VH = (bf16_t*)(ws + OFF_R3); bf16_t* GH = VH + (size_t)kT * 512; bf16_t* Hb = VH;
    bf16_t* FK = (bf16_t*)(ws + OFF_R4); bf16_t* FV = FK + (size_t)kT * 512;
    bf16_t* SGA = (bf16_t*)(ws + OFF_R6); bf16_t* SGB = SGA + (size_t)kT * 1024; bf16_t* Qp = SGA;
    bf16_t* FQ = (bf16_t*)p.out; bf16_t* Bb = FQ + (size_t)kT * 512; bf16_t* Ab = Bb + (size_t)kT * 512;
    LAS unsigned char* lds = (LAS unsigned char*)sm;
    if (PH == 0) {
        unsigned char* X8 = (unsigned char*)Xb; float* cmp = (float*)(ws + OFF_SW);
        ph_conv_x8(p.x, X8, rs1, bid, nblk);
        ph_colmax(p.w_in, kINW, 0, 3592, kD, p.nmw, cmp, bid, nblk, sm);
        ph_colmax(p.w_in, kINW, 3592, 2048, kD, p.nmw, cmp + 3712, bid, nblk, sm);
    }
    else if (PH == 11) {
        unsigned char* W8 = (unsigned char*)Wtin; const float* cmp = (const float*)(ws + OFF_SW);
        ph_conv_wt8(p.w_in, kINW, 0, 3592, kD, p.nmw, cmp, W8, bid, nblk, sm);
        ph_conv_wt8(p.w_in, kINW, 3592, 2048, kD, p.nmw, cmp + 3712, W8 + (size_t)3712 * kD, bid, nblk, sm);
        ph_zero_bf16((bf16_t*)(W8 + (size_t)3592 * kD), (size_t)120 * kD / 2, bid, nblk);
        ph_zero_bf16((bf16_t*)(W8 + (size_t)5760 * kD), (size_t)128 * kD / 2, bid, nblk);
    }
    else if (PH == 2) { ph_cfox(LFF, cf, (bf16_t*)(ws + OFF_AUG), nblk - 1 - bid, nblk, sm); ph_hgrn1(LF, VH, ST, DC, bid, nblk, lds); }
    else if (PH == 3) {
        ph_hgrn2(ST, DC, bid, nblk);
        if (bid >= nblk / 2) {
            const int vb = bid - nblk / 2, nvb = nblk / 2;
            ph_conv_wt(p.w_a, kD, 0, 1024, 512, nullptr, Wta, vb, nvb, sm);
            ph_conv_wt(p.w_b, kD, 0, 1024, 512, nullptr, Wtb, vb, nvb, sm);
            ph_conv_wt(p.w_out, kD, 0, 1024, kD, nullptr, Wto, vb, nvb, sm);
            ph_conv_wt(p.w_q, 2048, 0, 2048, kD, p.nfw, Wtq, vb, nvb, sm);
            ph_conv_plain(p.sk, SKb, (size_t)8 * 2 * 128 * 128, nullptr, vb, nvb);
        }
    }
    else if (PH == 9) ph_hgrn3(QH, LF, VH, GH, ST, p.hnw, Ab, bid, nblk, lds);
    else if (PH == 7) {
        ph_topk2<true, false>(Qp, SKb, idx, gate, bid, nblk, lds);
        if (bid & 1) { ph_topk2<false, true>(Qp, SKb, idx, gate, bid, nblk, lds); ph_quant_rows<0>(p.pu, p.nfw, U8, su, 0, bid, nblk); ph_quant_rows<0>(p.pv, nullptr, V8, sv, 0, bid, nblk); }
        else { ph_quant_rows<0>(p.pu, p.nfw, U8, su, 0, bid, nblk); ph_quant_rows<0>(p.pv, nullptr, V8, sv, 0, bid, nblk); ph_topk2<false, true>(Qp, SKb, idx, gate, bid, nblk, lds); }
    }
    else if (PH == 8) ph_exp_u7(Hb, SSQ, U8, su, sv, idx, gate, abuf, bid, nblk, lds);
    else if (PH == 10) ph_exp_v8(Hb, V8, idx, abuf, p.nlw, p.out, bid, nblk, lds);
}

template <int PH>
DI void run_gemm(const Params& p, LAS unsigned char* lds) {
    unsigned char* ws = p.ws;
    float* rs1 = (float*)(ws + OFF_RS1); float* SSQ = (float*)(ws + OFF_SSQ); float* LFF = (float*)(ws + OFF_LFF);
    bf16_t* Wtin = (bf16_t*)(ws + OFF_WTIN); bf16_t* Wta = (bf16_t*)(ws + OFF_WTA); bf16_t* Wtb = (bf16_t*)(ws + OFF_WTB); bf16_t* Wto = (bf16_t*)(ws + OFF_WTOUT); bf16_t* Wtq = (bf16_t*)(ws + OFF_WTQ);
    bf16_t* Xb = (bf16_t*)(ws + OFF_R1);
    bf16_t* QH = (bf16_t*)(ws + OFF_R2); bf16_t* LF = QH + (size_t)kT * 512; bf16_t* Mg = QH;
    bf16_t* VH = (bf16_t*)(ws + OFF_R3); bf16_t* GH = VH + (size_t)kT * 512; bf16_t* Hb = VH;
    bf16_t* FK = (bf16_t*)(ws + OFF_R4); bf16_t* FV = FK + (size_t)kT * 512;
    bf16_t* SGA = (bf16_t*)(ws + OFF_R6); bf16_t* SGB = SGA + (size_t)kT * 1024; bf16_t* Qp = SGA;
    bf16_t* FQ = (bf16_t*)p.out; bf16_t* Bb = FQ + (size_t)kT * 512; bf16_t* Ab = Bb + (size_t)kT * 512;
    const int G = (int)gridDim.x, c = (int)blockIdx.x;
    if (PH == 1) {
        pg8::Gemm g{Xb, Wtin, kT, 5888, kD / 2}; pg8::StaticOrder S; S.init(kT, 5888, G, c);
        Epi8Proj E{ProjOut{rs1, p.lbl, p.ffb, QH, LF, VH, GH, FQ, FK, FV, SGA, SGB, LFF}, (const float*)(ws + OFF_SW), lds + EPI_LDS_OFF};
        pg8::gemm_phase_i8<Epi8Proj, pg8::StaticOrder, true, true>(lds, g, S, E);
    } else if (PH == 4) {
        { pg8::Gemm g{Ab, Wta, kT, 1024, 512}; pg8::StaticOrder S; S.init(kT, 1024, G, c); Epi8Gate E{SGA, Mg, 0, lds + EPI_LDS_OFF}; pg8::gemm_phase<Epi8Gate, pg8::StaticOrder, true, true>(lds, g, S, E); }
        { pg8::Gemm g{Bb, Wtb, kT, 1024, 512}; pg8::StaticOrder S; S.init(kT, 1024, G, c); Epi8Gate E{SGB, Mg, 1, lds + EPI_LDS_OFF}; pg8::gemm_phase<Epi8Gate, pg8::StaticOrder, true, true>(lds, g, S, E); }
    } else if (PH == 5) {
        pg8::Gemm g{Mg, Wto, kT, 1024, kD}; pg8::StaticOrder S; S.init(kT, 1024, G, c); Epi8Wout E{p.x, Hb, SSQ, lds + EPI_LDS_OFF};
        pg8::gemm_phase<Epi8Wout, pg8::StaticOrder, true, true>(lds, g, S, E);
    } else if (PH == 6) {
        pg8::Gemm g{Hb, Wtq, kT, 2048, kD}; pg8::StaticOrder S; S.init(kT, 2048, G, c); Epi8Wq E{SSQ, Qp, lds + EPI_LDS_OFF};
        pg8::gemm_phase<Epi8Wq, pg8::StaticOrder, true, true>(lds, g, S, E);
    }
}

constexpr int SM_FLOATS = 19584;
constexpr size_t OFF_BAR = 512 * 1024;

__global__ void __launch_bounds__(512, 2) k_mega(Params p) {
    __shared__ __attribute__((aligned(16))) float sm_all[2 * SM_FLOATS + 4];
    volatile LAS unsigned* st = (volatile LAS unsigned*)(LAS float*)(sm_all + 2 * SM_FLOATS);
    if (threadIdx.x == 0) { st[0] = 0u; st[1] = 0u; }
    __syncthreads();
    const XcdBarrier xb = xcd_barrier_post((unsigned*)(p.ws + OFF_BAR), st);
    const int half = __builtin_amdgcn_readfirstlane((int)(threadIdx.x >> 8));
    float* sm = sm_all + half * SM_FLOATS;
    const int bid = blockIdx.x * 2 + half, nblk = gridDim.x * 2;
    run_phase<0>(p, bid, nblk, sm); xcd_barrier(xb);
    run_phase<11>(p, bid, nblk, sm); xcd_barrier(xb);
    run_gemm<1>(p, (LAS unsigned char*)sm_all); xcd_barrier(xb);
    run_phase<2>(p, bid, nblk, sm); xcd_barrier(xb);
    run_phase<3>(p, bid, nblk, sm);
    __syncthreads();
    { bf16_t* FQ_ = (bf16_t*)p.out; bf16_t* FK_ = (bf16_t*)(p.ws + OFF_R4);
      at64::run_all(FQ_, FK_, FK_ + (size_t)kT * 512, (const bf16_t*)(p.ws + OFF_AUG), FQ_ + (size_t)kT * 512, (char*)sm_all); }
    xcd_barrier(xb);
    run_phase<9>(p, bid, nblk, sm); xcd_barrier(xb);
    run_gemm<4>(p, (LAS unsigned char*)sm_all); xcd_barrier(xb);
    run_gemm<5>(p, (LAS unsigned char*)sm_all); xcd_barrier(xb);
    run_gemm<6>(p, (LAS unsigned char*)sm_all); xcd_barrier(xb);
    run_phase<7>(p, bid, nblk, sm); xcd_barrier(xb);
    run_phase<8>(p, bid, nblk, sm); xcd_barrier(xb);
    run_phase<10>(p, bid, nblk, sm);
}

extern "C" void kernel_launch(void* const* d_in, const int* in_sizes, int n_in, void* d_out, int out_size, void* d_ws, size_t ws_size, hipStream_t stream) {
    Params p{};
    p.x = (const float*)d_in[0]; p.nmw = (const float*)d_in[1]; p.w_in = (const float*)d_in[2]; p.lbl = (const float*)d_in[3];
    p.hnw = (const float*)d_in[4]; p.ffb = (const float*)d_in[5]; p.w_a = (const float*)d_in[6]; p.w_b = (const float*)d_in[7];
    p.w_out = (const float*)d_in[8]; p.nfw = (const float*)d_in[9]; p.w_q = (const float*)d_in[10]; p.sk = (const float*)d_in[11];
    p.pu = (const float*)d_in[12]; p.pv = (const float*)d_in[13]; p.nlw = (const float*)d_in[14];
    p.out = (float*)d_out; p.ws = (unsigned char*)d_ws;
    static int grid_blocks = 0;
    if (!grid_blocks) {
        int dev = 0, cus = 0, per_cu = 0;
        (void)hipGetDevice(&dev);
        (void)hipDeviceGetAttribute(&cus, hipDeviceAttributeMultiprocessorCount, dev);
        (void)hipOccupancyMaxActiveBlocksPerMultiprocessor(&per_cu, k_mega, 512, 0);
        if (per_cu > 1) per_cu = 1;
        if (per_cu < 1) per_cu = 1;
        grid_blocks = cus * per_cu;
        if (ws_size < 507 * MBy) fprintf(stderr, "workspace too small: %zu\n", ws_size);
    }
    (void)hipMemsetAsync((unsigned char*)d_ws + OFF_BAR, 0, XCD_BAR_WORDS * sizeof(unsigned), stream);
    (void)hipMemsetAsync((unsigned char*)d_ws + OFF_SW, 0, 5888 * sizeof(float), stream);
    void* args[] = {&p};
    hipError_t e = hipLaunchCooperativeKernel((void*)k_mega, dim3(grid_blocks), dim3(512), args, 0, stream);
    if (e != hipSuccess) fprintf(stderr, "cooperative launch failed: %s (grid %d)\n", hipGetErrorString(e), grid_blocks);
}
```

```cpp
#include <hip/hip_runtime.h>
#include <math.h>
#include <stdio.h>

#ifndef MEGA
#define MEGA 1
#endif

#define DI __device__ __forceinline__
__device__ __forceinline__ int vtid_opaque() { int t = (int)threadIdx.x; asm volatile("" : "+v"(t)); return t & 255; }
#define VTID (vtid_opaque())
constexpr int kB = 8, kS = 4096, kT = kB * kS, kD = 1024, kINW = 5640;
constexpr float kEps = 1e-6f;

struct Params {
    const float *x, *nmw, *w_in, *lbl, *hnw, *ffb, *w_a, *w_b, *w_out, *nfw, *w_q, *sk, *pu, *pv, *nlw;
    float* out; unsigned char* ws;
};
constexpr size_t MBy = 1u << 20;
constexpr size_t OFF_SW = 256 * 1024;
constexpr size_t OFF_RS1 = 0, OFF_SSQ = 1 * MBy, OFF_CFOX = 3 * MBy, OFF_LFF = 4 * MBy, OFF_DC = 5 * MBy, OFF_IDX = 6 * MBy, OFF_GATE = 22 * MBy;
constexpr size_t OFF_WTIN = 38 * MBy, OFF_WTA = 50 * MBy, OFF_WTB = 51 * MBy, OFF_WTOUT = 52 * MBy, OFF_WTQ = 54 * MBy, OFF_SKB = 58 * MBy, OFF_UB = 59 * MBy  , OFF_VB = 75 * MBy  , OFF_ABUF = 91 * MBy  , OFF_SU = 107 * MBy, OFF_SV = 107 * MBy + 65536;
constexpr size_t OFF_AUG = 44 * MBy;
constexpr size_t OFF_R1 = 123 * MBy;
constexpr size_t OFF_R2 = 187 * MBy;
constexpr size_t OFF_R3 = 251 * MBy;
constexpr size_t OFF_R4 = 315 * MBy;
constexpr size_t OFF_R6 = 379 * MBy;
constexpr int kINP = 5760;
constexpr float kLog2e = 1.4426950408889634f;

DI float sigmoidf_(float v) { return 1.f / (1.f + expf(-v)); }
DI float wave_max(float v) {
#pragma unroll
    for (int o = 32; o > 0; o >>= 1) v = fmaxf(v, __shfl_xor(v, o));
    return v;
}
DI float wave_sum(float v) {
#pragma unroll
    for (int o = 32; o > 0; o >>= 1) v += __shfl_xor(v, o);
    return v;
}

#define LAS __attribute__((address_space(3)))
typedef unsigned short bf16_t;
typedef short bf16x8 __attribute__((ext_vector_type(8)));
typedef float f32x4 __attribute__((ext_vector_type(4)));
typedef unsigned u32x4 __attribute__((ext_vector_type(4)));
typedef unsigned u32x2 __attribute__((ext_vector_type(2)));
typedef float f32x2_t __attribute__((ext_vector_type(2)));
typedef __bf16 bf16x2_t __attribute__((ext_vector_type(2)));
DI unsigned cvtpk(float lo, float hi) { f32x2_t v = {lo, hi}; bf16x2_t b = __builtin_convertvector(v, bf16x2_t); return __builtin_bit_cast(unsigned, b); }
DI float bf2f(bf16_t v) { return __uint_as_float(((unsigned)v) << 16); }


#define XB_TMO      128
#define XB_XCNT(j)  (256  + 64 * (j))
#define XB_XSUB(j)  (1280 + 64 * (j))
#define XB_XGEN(j)  (2304 + 64 * (j))
#define XB_TOP      3328
#define XB_TOPGEN   3392
#define XCD_BAR_WORDS 3456
#define XB_SPIN_CAP (1u << 18)
DI unsigned xb_ld(unsigned* p)              { return __hip_atomic_load(p, __ATOMIC_RELAXED, __HIP_MEMORY_SCOPE_AGENT); }
DI unsigned xb_add(unsigned* p, unsigned v) { return __hip_atomic_fetch_add(p, v, __ATOMIC_RELAXED, __HIP_MEMORY_SCOPE_AGENT); }
DI unsigned xb_xcc_id() { return (unsigned)__builtin_amdgcn_s_getreg((3 << 11) | 20) & 0xFu; }
#define XB_SPIN(cond, bar) do { unsigned _sp = 0; while (cond) { __builtin_amdgcn_s_sleep(1); \
    if ((++_sp & 255u) == 0u) { if (xb_ld(&(bar)[XB_TMO])) break; if (_sp > XB_SPIN_CAP) { atomicAdd(&(bar)[XB_TMO], 1u); break; } } } } while (0)
struct XcdBarrier { unsigned* bar; unsigned x; volatile LAS unsigned* st; };
DI XcdBarrier xcd_barrier_post(unsigned* bar, volatile LAS unsigned* st) {
    XcdBarrier b; b.bar = bar; b.x = xb_xcc_id(); b.st = st;
    if (threadIdx.x == 0) (void)xb_add(&bar[XB_XCNT(b.x)], 1u);
    return b;
}
DI void xcd_barrier_complete(unsigned* bar, unsigned x, unsigned& nloc, unsigned& nx) {
    const unsigned G = gridDim.x * gridDim.y * gridDim.z;
    unsigned sum, cnt, mine, sp = 0u;
    for (;;) {
        sum = 0u; cnt = 0u; mine = 0u;
#pragma unroll
        for (unsigned j = 0; j < 16; ++j) { const unsigned c = xb_ld(&bar[XB_XCNT(j)]); sum += c; cnt += (c > 0u) ? 1u : 0u; mine = (j == x) ? c : mine; }
        if (sum == G) break;
        __builtin_amdgcn_s_sleep(1);
        if ((++sp & 255u) == 0u) { if (xb_ld(&bar[XB_TMO])) break; if (sp > XB_SPIN_CAP) { atomicAdd(&bar[XB_TMO], 1u); break; } }
    }
    nloc = mine > 0u ? mine : 1u; nx = cnt > 0u ? cnt : 1u;
}
DI void xcd_barrier(const XcdBarrier& b) {
    asm volatile("s_waitcnt vmcnt(0)" ::: "memory");
    __syncthreads();
    if (threadIdx.x == 0) {
        unsigned* bar = b.bar;
        __builtin_amdgcn_s_waitcnt(0);
        unsigned nloc = b.st[0], nx = b.st[1];
        if (nloc == 0u) { xcd_barrier_complete(bar, b.x, nloc, nx); b.st[0] = nloc; b.st[1] = nx; }
        const unsigned old = xb_add(&bar[XB_XSUB(b.x)], 1u);
        const unsigned gen = old / nloc;
        if (old + 1u == (gen + 1u) * nloc) {
            __builtin_amdgcn_fence(__ATOMIC_RELEASE, "agent");
            asm volatile("s_waitcnt vmcnt(0)" ::: "memory");
            const unsigned og = xb_add(&bar[XB_TOP], 1u);
            const unsigned tg = og / nx;
            if (og + 1u == (tg + 1u) * nx) xb_add(&bar[XB_TOPGEN], 1u);
            else XB_SPIN(xb_ld(&bar[XB_TOPGEN]) == tg, bar);
            __builtin_amdgcn_fence(__ATOMIC_ACQUIRE, "agent");
            xb_add(&bar[XB_XGEN(b.x)], 1u);
            asm volatile("s_waitcnt vmcnt(0)" ::: "memory");
        } else {
            XB_SPIN(xb_ld(&bar[XB_XGEN(b.x)]) == gen, bar);
            __builtin_amdgcn_fence(__ATOMIC_ACQUIRE, "agent");
            asm volatile("s_waitcnt vmcnt(0)" ::: "memory");
        }
    }
    __syncthreads();
}

DI void ph_conv_x8(const float* X, unsigned char* X8, float* rsx, int bid, int nblk) {
    const int wid = VTID >> 6, lane = VTID & 63;
    for (int row0 = (bid * 4 + wid) * 2; row0 < kT; row0 += nblk * 8) {
        float4 v[2][4];
#pragma unroll
        for (int r = 0; r < 2; ++r)
#pragma unroll
            for (int i = 0; i < 4; ++i) v[r][i] = ((const float4*)(X + (size_t)(row0 + r) * kD))[lane + 64 * i];
#pragma unroll
        for (int r = 0; r < 2; ++r) {
            float s = 0.f, m = 0.f;
#pragma unroll
            for (int i = 0; i < 4; ++i) { const float4 w = v[r][i]; s += w.x * w.x + w.y * w.y + w.z * w.z + w.w * w.w; m = fmaxf(m, fmaxf(fmaxf(fabsf(w.x), fabsf(w.y)), fmaxf(fabsf(w.z), fabsf(w.w)))); }
            s = wave_sum(s); m = wave_max(m);
            const float inv = (m > 0.f) ? 127.f / m : 0.f;
#pragma unroll
            for (int i = 0; i < 4; ++i) { const float4 w = v[r][i];
                const int a = (int)rintf(w.x * inv), b = (int)rintf(w.y * inv), c = (int)rintf(w.z * inv), d = (int)rintf(w.w * inv);
                ((unsigned*)(X8 + (size_t)(row0 + r) * kD))[lane + 64 * i] = (unsigned)(a & 0xff) | ((unsigned)(b & 0xff) << 8) | ((unsigned)(c & 0xff) << 16) | ((unsigned)(d & 0xff) << 24); }
            if (lane == 0) rsx[row0 + r] = m * (1.0f / 127.f) / sqrtf(s * (1.0f / kD) + kEps);
        }
    }
}
DI void ph_colmax(const float* W, int ldw, int nsrc0, int Ncnt, int K, const float* kscale, float* cm, int bid, int nblk, float* smf) {
    float* cmx = smf;
    const int ntn = (Ncnt + 63) / 64, ntk = K / 64, tid = VTID;
    for (int tbase = 0; tbase < ntn * ntk; tbase += nblk) {
        const bool active = tbase + bid < ntn * ntk; const int tile = active ? tbase + bid : 0;
        const int n0 = (tile / ntk) * 64, k0 = (tile % ntk) * 64, r = tid >> 4, c4 = (tid & 15) * 4;
        float4 mx = make_float4(0.f, 0.f, 0.f, 0.f);
        if (n0 + c4 < Ncnt) {
#pragma unroll
            for (int i = 0; i < 4; ++i) { const int k = k0 + r + 16 * i; const float4 v = *(const float4*)(W + (size_t)k * ldw + nsrc0 + n0 + c4); const float ks = kscale ? kscale[k] : 1.f;
                mx.x = fmaxf(mx.x, fabsf(v.x * ks)); mx.y = fmaxf(mx.y, fabsf(v.y * ks)); mx.z = fmaxf(mx.z, fabsf(v.z * ks)); mx.w = fmaxf(mx.w, fabsf(v.w * ks)); }
        }
        __syncthreads();
        cmx[r * 64 + c4] = mx.x; cmx[r * 64 + c4 + 1] = mx.y; cmx[r * 64 + c4 + 2] = mx.z; cmx[r * 64 + c4 + 3] = mx.w;
        __syncthreads();
        if (tid < 64 && active && n0 + tid < Ncnt) { float m = 0.f;
#pragma unroll
            for (int i = 0; i < 16; ++i) m = fmaxf(m, cmx[i * 64 + tid]);
            atomicMax((unsigned*)cm + n0 + tid, __float_as_uint(m)); }
    }
}
DI void ph_conv_wt8(const float* W, int ldw, int nsrc0, int Ncnt, int K, const float* kscale, const float* cm, unsigned char* Wt8, int bid, int nblk, float* smf) {
    float(*tl)[65] = (float(*)[65])smf;
    const int ntn = (Ncnt + 63) / 64, ntk = K / 64, tid = VTID;
    for (int tbase = 0; tbase < ntn * ntk; tbase += nblk) {
        const bool active = tbase + bid < ntn * ntk; const int tile = active ? tbase + bid : 0;
        const int n0 = (tile / ntk) * 64, k0 = (tile % ntk) * 64;
        __syncthreads();
        {
            const int r = tid >> 4, c4 = (tid & 15) * 4;
#pragma unroll
            for (int i = 0; i < 4; ++i) {
                const int k = r + 16 * i;
                float4 v = make_float4(0.f, 0.f, 0.f, 0.f);
                if (n0 + c4 < Ncnt) v = *(const float4*)(W + (size_t)(k0 + k) * ldw + nsrc0 + n0 + c4);
                tl[k][c4] = v.x; tl[k][c4 + 1] = v.y; tl[k][c4 + 2] = v.z; tl[k][c4 + 3] = v.w;
            }
        }
        __syncthreads();
        {
            const int n = tid >> 2, kq = (tid & 3) * 16;
            if (active && n0 + n < Ncnt) {
                const float m = cm[n0 + n], inv = (m > 0.f) ? 127.f / m : 0.f;
                unsigned w[4];
#pragma unroll
                for (int j = 0; j < 4; ++j) { unsigned q = 0;
#pragma unroll
                    for (int b = 0; b < 4; ++b) { const int kk = kq + 4 * j + b; q |= ((unsigned)((int)rintf(tl[kk][n] * (kscale ? kscale[k0 + kk] : 1.f) * inv) & 0xff)) << (8 * b); }
                    w[j] = q; }
                *(uint4*)(Wt8 + (size_t)(n0 + n) * K + k0 + kq) = make_uint4(w[0], w[1], w[2], w[3]);
            }
        }
    }
}
DI void ph_conv_wt(const float* W, int ldw, int nsrc0, int Ncnt, int K, const float* kscale, bf16_t* Wt, int bid, int nblk, float* smf) {
    float(*tl)[65] = (float(*)[65])smf;
    const int ntn = (Ncnt + 63) / 64, ntk = K / 64, tid = VTID;
    for (int tbase = 0; tbase < ntn * ntk; tbase += nblk) {
        const bool active = tbase + bid < ntn * ntk; const int tile = active ? tbase + bid : 0;
        const int n0 = (tile / ntk) * 64, k0 = (tile % ntk) * 64;
        __syncthreads();
        {
            const int r = tid >> 4, c4 = (tid & 15) * 4;
#pragma unroll
            for (int i = 0; i < 4; ++i) {
                const int k = r + 16 * i;
                float4 v = make_float4(0.f, 0.f, 0.f, 0.f);
                if (n0 + c4 < Ncnt) v = *(const float4*)(W + (size_t)(k0 + k) * ldw + nsrc0 + n0 + c4);
                tl[k][c4] = v.x; tl[k][c4 + 1] = v.y; tl[k][c4 + 2] = v.z; tl[k][c4 + 3] = v.w;
            }
        }
        __syncthreads();
        {
            const int n = tid >> 2, kq = (tid & 3) * 16;
            if (active && n0 + n < Ncnt) {
                unsigned w[8];
#pragma unroll
                for (int j = 0; j < 8; ++j) {
                    const float s0 = kscale ? kscale[k0 + kq + 2 * j] : 1.f, s1 = kscale ? kscale[k0 + kq + 2 * j + 1] : 1.f;
                    w[j] = cvtpk(tl[kq + 2 * j][n] * s0, tl[kq + 2 * j + 1][n] * s1);
                }
                uint4* dst = (uint4*)(Wt + (size_t)(n0 + n) * K + k0 + kq);
                dst[0] = make_uint4(w[0], w[1], w[2], w[3]); dst[1] = make_uint4(w[4], w[5], w[6], w[7]);
            }
        }
    }
}
DI void ph_zero_bf16(bf16_t* p, size_t n  , int bid, int nblk) {
    for (size_t i = (size_t)bid * 256 + VTID; i < n / 8; i += (size_t)nblk * 256) ((uint4*)p)[i] = make_uint4(0, 0, 0, 0);
}

DI void ph_conv_plain(const float* src, bf16_t* dst, size_t n  , const float* colscale  , int bid, int nblk) {
    for (size_t i = (size_t)bid * 256 + VTID; i < n / 8; i += (size_t)nblk * 256) {
        float4 a = ((const float4*)src)[2 * i], b = ((const float4*)src)[2 * i + 1];
        if (colscale) { const int c = (int)((i * 8) & (kD - 1)); const float4 s0 = *(const float4*)(colscale + c), s1 = *(const float4*)(colscale + c + 4);
            a.x *= s0.x; a.y *= s0.y; a.z *= s0.z; a.w *= s0.w; b.x *= s1.x; b.y *= s1.y; b.z *= s1.z; b.w *= s1.w; }
        ((uint4*)dst)[i] = make_uint4(cvtpk(a.x, a.y), cvtpk(a.z, a.w), cvtpk(b.x, b.y), cvtpk(b.z, b.w));
    }
}

DI void acc_zero(f32x4 (&acc)[4][4]) {
#pragma unroll
    for (int m = 0; m < 4; ++m)
#pragma unroll
        for (int n = 0; n < 4; ++n) acc[m][n] = (f32x4){0.f, 0.f, 0.f, 0.f};
}
struct LaneId { int wr, wc, fr, fq; };
DI LaneId lane_id() { const int tid = VTID, wid = tid >> 6, lane = tid & 63; return LaneId{wid >> 1, wid & 1, lane & 15, lane >> 4}; }

DI float fsigmoid(float z) { return __builtin_amdgcn_rcpf(1.f + __builtin_amdgcn_exp2f(-z * kLog2e)); }
DI void store_bf4(bf16_t* p, f32x4 v) { *(uint2*)p = make_uint2(cvtpk(v[0], v[1]), cvtpk(v[2], v[3])); }
DI f32x4 load_bf4(const bf16_t* p) { const uint2 u = *(const uint2*)p; return (f32x4){__uint_as_float(u.x << 16), __uint_as_float(u.x & 0xffff0000u), __uint_as_float(u.y << 16), __uint_as_float(u.y & 0xffff0000u)}; }
DI void store_bf8(bf16_t* p, const f32x4& v0, const f32x4& v1) { *(uint4*)p = make_uint4(cvtpk(v0[0], v0[1]), cvtpk(v0[2], v0[3]), cvtpk(v1[0], v1[1]), cvtpk(v1[2], v1[3])); }
DI void load_bf8(const bf16_t* p, f32x4& v0, f32x4& v1) { const uint4 u = *(const uint4*)p;
    v0 = (f32x4){__uint_as_float(u.x << 16), __uint_as_float(u.x & 0xffff0000u), __uint_as_float(u.y << 16), __uint_as_float(u.y & 0xffff0000u)};
    v1 = (f32x4){__uint_as_float(u.z << 16), __uint_as_float(u.z & 0xffff0000u), __uint_as_float(u.w << 16), __uint_as_float(u.w & 0xffff0000u)}; }

namespace pg8 {
#define PG8_LAS __attribute__((address_space(3)))
constexpr int BM = 256, BK = 64, HALF = 128, HTB = HALF * BK * 2  , STAGE_BYTES = 8 * HTB, NXCD = 8, WGM = 8;

__host__ __device__ __forceinline__ int lds_byte(int r, int c) { const int st = (r >> 4) * 2 + (c >> 5), rr = r & 15, cc = c & 31, ob = rr * 64 + cc * 2; return st * 1024 + (ob ^ (((ob >> 9) & 1) << 5)); }
__host__ __device__ __forceinline__ void stage_rc(int b, int& R, int& C) { const int st = b / 1024, sb = b % 1024, swz = sb ^ (((sb >> 9) & 1) << 5); R = (st >> 1) * 16 + swz / 64; C = (st & 1) * 32 + (swz % 64) / 2; }
__host__ __device__ __forceinline__ int perm32(int rho) { const int n = rho >> 4, i = rho & 15; return 8 * (i >> 2) + 4 * n + (i & 3); }

struct Unit { int pm, pn, alt; };
struct Gemm { const bf16_t* A; const bf16_t* Bt; int M, N, K; const bf16_t* A2; const bf16_t* Bt2; };

struct StaticOrder {
    int nM, nN, nwg, G, c;
    __host__ __device__ void init(int M, int N, int G_, int c_) { nM = M / BM; nN = N / BM; nwg = nM * nN; G = G_; c = c_; }
    __host__ __device__ bool next(int i, Unit& u) const {
        const long L = (long)i * G + c; if (L >= nwg) return false;
        int wgid = (int)L; { const int q = nwg / NXCD, r = nwg % NXCD, xcd = wgid % NXCD, off = wgid / NXCD; wgid = (xcd < r ? xcd * (q + 1) : r * (q + 1) + (xcd - r) * q) + off; }
        const int nig = WGM * nN, gid = wgid / nig, fm = gid * WGM, gsz = (nM - fm) < WGM ? (nM - fm) : WGM;
        u.pm = fm + ((wgid % nig) % gsz); u.pn = (wgid % nig) / gsz; u.alt = 0; return true;
    }
    __device__ __forceinline__ void a_ready(const Unit&) const {}
    __device__ __forceinline__ void done(const Unit&) const {}
};
struct PairOrder {
    StaticOrder s;
    __host__ __device__ bool next(int i, Unit& u) const { if (!s.next(i >> 1, u)) return false; u.alt = i & 1; return true; }
    __device__ __forceinline__ void a_ready(const Unit&) const {}
    __device__ __forceinline__ void done(const Unit&) const {}
};
__device__ __forceinline__ unsigned cvt_pk_bf16(float lo, float hi) { unsigned r; asm volatile("v_cvt_pk_bf16_f32 %0, %1, %2" : "=v"(r) : "v"(lo), "v"(hi)); return r; }
typedef float f32x2 __attribute__((ext_vector_type(2)));
template <class Epi, class Sched, bool ALIGN_EPI = false, bool SP2 = false>
__device__ __forceinline__ void gemm_phase(PG8_LAS unsigned char* lds, const Gemm g, const Sched& S, const Epi& E) {
    int tid_ = (int)threadIdx.x; asm volatile("" : "+v"(tid_));
    const int tid = tid_, wid = __builtin_amdgcn_readfirstlane(tid >> 6), lane = tid & 63, wr = wid >> 2, wc = wid & 3, fr = lane & 15, fq = lane >> 4;
    const int K = g.K, nt = K / BK;
    unsigned voffA[2], voffB[2];
#pragma unroll
    for (int i = 0; i < 2; ++i) { int R, C; stage_rc(tid * 16 + i * 8192, R, C); const int Rb = Epi::PERM ? ((R & ~31) + perm32(R & 31)) : R;
        voffA[i] = (unsigned)(R * K + C) * 2u; voffB[i] = (unsigned)(Rb * K + C) * 2u; }
    const size_t kstep = (size_t)(BK * 2);
    const size_t hstep = (size_t)HALF * K * 2;
    const size_t tstep = 2 * hstep;
    const unsigned ldsw = (unsigned)wid * 1024u;
    const int aoff = lds_byte(wr * 64 + fr, fq * 8), boff = lds_byte(wc * 32 + fr, fq * 8);
#define PG8_SA(b, h) (((b) * 2 + (h)) * HTB)
#define PG8_SB(b, h) ((4 + (b) * 2 + (h)) * HTB)
#define PG8_STAGE(bufoff, gbase, voff) do { _Pragma("unroll") for (int _i = 0; _i < 2; ++_i) \
        __builtin_amdgcn_global_load_lds((const unsigned*)((const char*)(gbase) + (voff)[_i]), (PG8_LAS unsigned*)(lds + (bufoff) + ldsw + _i * 8192), 16, 0, 0); } while (0)
#define PG8_LDA(dst, b, h) do { _Pragma("unroll") for (int m = 0; m < 4; ++m) _Pragma("unroll") for (int k = 0; k < 2; ++k) dst[m][k] = *(const PG8_LAS bf16x8*)(lds + PG8_SA(b, h) + aoff + m * 2048 + k * 1024); } while (0)
#define PG8_LDB(dst, b, h) do { _Pragma("unroll") for (int n = 0; n < 2; ++n) _Pragma("unroll") for (int k = 0; k < 2; ++k) dst[n][k] = *(const PG8_LAS bf16x8*)(lds + PG8_SB(b, h) + boff + n * 2048 + k * 1024); } while (0)
#define PG8_MMA(ai, bj, At, Bt) do { __builtin_amdgcn_s_setprio(1); _Pragma("unroll") for (int m = 0; m < 4; ++m) _Pragma("unroll") for (int n = 0; n < 2; ++n) _Pragma("unroll") for (int k = 0; k < 2; ++k) \
        acc[ai][bj][m][n] = __builtin_amdgcn_mfma_f32_16x16x32_bf16(Bt[n][k], At[m][k], acc[ai][bj][m][n], 0, 0, 0); __builtin_amdgcn_s_setprio(0); } while (0)
#define PG8_WAIT_V(n) asm volatile("s_waitcnt vmcnt(" #n ")" ::: "memory")
#define PG8_WAIT_L(n) asm volatile("s_waitcnt lgkmcnt(" #n ")" ::: "memory")
#define PG8_BAR __builtin_amdgcn_s_barrier()
#define PG8_SCHED __builtin_amdgcn_sched_barrier(0)
    Unit cur, nxt; int ui = 0;
    if (!S.next(0, cur)) return;
    f32x4 acc[2][2][4][2];
#pragma unroll
    for (int a = 0; a < 2; ++a)
#pragma unroll
        for (int b = 0; b < 2; ++b)
#pragma unroll
            for (int m = 0; m < 4; ++m)
#pragma unroll
                for (int n = 0; n < 2; ++n) acc[a][b][m][n] = (f32x4){0.f, 0.f, 0.f, 0.f};
    bf16x8 At[4][2], B0[2][2], B1[2][2];
    const char* cA = (const char*)(cur.alt ? g.A2 : g.A) + (size_t)cur.pm * tstep; const char* cB = (const char*)(cur.alt ? g.Bt2 : g.Bt) + (size_t)cur.pn * tstep;
    S.a_ready(cur);
    if constexpr (SP2) {
        PG8_STAGE(PG8_SB(0, 0), cB, voffB); PG8_STAGE(PG8_SB(0, 1), cB + hstep, voffB); PG8_STAGE(PG8_SA(0, 0), cA, voffA); PG8_STAGE(PG8_SA(0, 1), cA + hstep, voffA);
        if (wr == 1) PG8_BAR;
        PG8_WAIT_V(2); PG8_BAR;
        PG8_STAGE(PG8_SB(1, 0), cB + kstep, voffB); PG8_STAGE(PG8_SA(1, 0), cA + kstep, voffA); PG8_STAGE(PG8_SB(1, 1), cB + hstep + kstep, voffB);
        PG8_WAIT_V(6); PG8_BAR;
    } else {
        PG8_STAGE(PG8_SB(0, 0), cB, voffB); PG8_STAGE(PG8_SA(0, 0), cA, voffA); PG8_STAGE(PG8_SB(0, 1), cB + hstep, voffB); PG8_STAGE(PG8_SA(0, 1), cA + hstep, voffA);
        if (wr == 1) PG8_BAR;
        PG8_WAIT_V(4); PG8_BAR;
        PG8_STAGE(PG8_SB(1, 0), cB + kstep, voffB); PG8_STAGE(PG8_SA(1, 0), cA + kstep, voffA); PG8_STAGE(PG8_SB(1, 1), cB + hstep + kstep, voffB);
        PG8_WAIT_V(6); PG8_BAR;
    }
    for (;;) {
        const bool has_next = S.next(ui + 1, nxt);
        const char* nA = has_next ? (const char*)(nxt.alt ? g.A2 : g.A) + (size_t)nxt.pm * tstep : cA; const char* nB = has_next ? (const char*)(nxt.alt ? g.Bt2 : g.Bt) + (size_t)nxt.pn * tstep : cB;
        for (int t = 0; t < nt; t += 2) {
            const bool last = (t == nt - 2);
            const char* a1 = cA + (size_t)(t + 1) * kstep;
            const char* a2 = last ? nA : cA + (size_t)(t + 2) * kstep; const char* b2 = last ? nB : cB + (size_t)(t + 2) * kstep;
            const char* a3 = a2 + kstep; const char* b3 = b2 + kstep;
            if (last && has_next) S.a_ready(nxt);
            if constexpr (SP2) {
            PG8_LDB(B0, 0, 0); PG8_LDB(B1, 0, 1); PG8_SCHED; PG8_LDA(At, 0, 0); PG8_STAGE(PG8_SA(1, 1), a1 + hstep, voffA);
            PG8_WAIT_V(8); PG8_WAIT_L(0); PG8_BAR; PG8_MMA(0, 0, At, B0); PG8_MMA(0, 1, At, B1); PG8_BAR; PG8_SCHED;
            PG8_LDA(At, 0, 1); PG8_STAGE(PG8_SB(0, 0), b2, voffB); PG8_STAGE(PG8_SB(0, 1), b2 + hstep, voffB); PG8_STAGE(PG8_SA(0, 0), a2, voffA);
            PG8_WAIT_V(8); PG8_WAIT_L(0); PG8_BAR; PG8_MMA(1, 0, At, B0); PG8_MMA(1, 1, At, B1); PG8_BAR; PG8_SCHED;
            PG8_LDB(B0, 1, 0); PG8_LDB(B1, 1, 1); PG8_SCHED; PG8_LDA(At, 1, 0); PG8_STAGE(PG8_SA(0, 1), a2 + hstep, voffA);
            PG8_WAIT_V(8); PG8_WAIT_L(0); PG8_BAR; PG8_MMA(0, 0, At, B0); PG8_MMA(0, 1, At, B1); PG8_BAR; PG8_SCHED;
            PG8_LDA(At, 1, 1); PG8_STAGE(PG8_SB(1, 0), b3, voffB); PG8_STAGE(PG8_SB(1, 1), b3 + hstep, voffB); PG8_STAGE(PG8_SA(1, 0), a3, voffA);
            PG8_WAIT_V(8); PG8_WAIT_L(0); PG8_BAR; PG8_MMA(1, 0, At, B0); PG8_MMA(1, 1, At, B1); PG8_BAR; PG8_SCHED;
            } else {
            PG8_LDB(B0, 0, 0); PG8_SCHED; PG8_LDA(At, 0, 0); PG8_STAGE(PG8_SA(1, 1), a1 + hstep, voffA);
            PG8_WAIT_L(8); PG8_BAR; PG8_WAIT_L(0); PG8_MMA(0, 0, At, B0); PG8_BAR; PG8_SCHED;
            PG8_LDB(B1, 0, 1); PG8_STAGE(PG8_SB(0, 0), b2, voffB);
            PG8_BAR; PG8_WAIT_L(0); PG8_MMA(0, 1, At, B1); PG8_BAR;
            PG8_LDA(At, 0, 1); PG8_STAGE(PG8_SA(0, 0), a2, voffA);
            PG8_BAR; PG8_WAIT_L(0); PG8_MMA(1, 0, At, B0); PG8_BAR; PG8_SCHED;
            PG8_STAGE(PG8_SB(0, 1), b2 + hstep, voffB);
            PG8_WAIT_V(6); PG8_BAR; PG8_MMA(1, 1, At, B1); PG8_BAR;
            PG8_LDB(B0, 1, 0); PG8_SCHED; PG8_LDA(At, 1, 0); PG8_STAGE(PG8_SA(0, 1), a2 + hstep, voffA);
            PG8_WAIT_L(8); PG8_BAR; PG8_WAIT_L(0); PG8_MMA(0, 0, At, B0); PG8_BAR; PG8_SCHED;
            PG8_LDB(B1, 1, 1); PG8_STAGE(PG8_SB(1, 0), b3, voffB);
            PG8_BAR; PG8_WAIT_L(0); PG8_MMA(0, 1, At, B1); PG8_BAR;
            PG8_LDA(At, 1, 1); PG8_STAGE(PG8_SA(1, 0), a3, voffA);
            PG8_BAR; PG8_WAIT_L(0); PG8_MMA(1, 0, At, B0); PG8_BAR; PG8_SCHED;
            PG8_STAGE(PG8_SB(1, 1), b3 + hstep, voffB);
            PG8_WAIT_V(6); PG8_BAR; PG8_MMA(1, 1, At, B1); PG8_BAR;
            }
        }
        if constexpr (ALIGN_EPI) { if (wr == 0) PG8_BAR; }
        if constexpr (!Epi::AFTER_DRAIN) { E(acc, cur, wr, wc, fr, fq); S.done(cur); }
        if (!has_next) break;
#pragma unroll
        for (int a = 0; a < 2; ++a)
#pragma unroll
            for (int b = 0; b < 2; ++b)
#pragma unroll
                for (int m = 0; m < 4; ++m)
#pragma unroll
                    for (int n = 0; n < 2; ++n) acc[a][b][m][n] = (f32x4){0.f, 0.f, 0.f, 0.f};
        cur = nxt; cA = nA; cB = nB; ++ui;
        if constexpr (ALIGN_EPI) { if (wr == 1) PG8_BAR; }
    }
    PG8_WAIT_V(0);
    if constexpr (!ALIGN_EPI) { if (wr == 0) PG8_BAR; }
    PG8_BAR;
    if constexpr (Epi::AFTER_DRAIN) { E.fused(acc, cur, wr, wc, fr, fq, lds, wid, lane); S.done(cur); }
#undef PG8_SA
#undef PG8_SB
#undef PG8_STAGE
#undef PG8_LDA
#undef PG8_LDB
#undef PG8_MMA
#undef PG8_WAIT_V
#undef PG8_WAIT_L
#undef PG8_BAR
#undef PG8_SCHED
}
typedef int i32x4 __attribute__((ext_vector_type(4)));
template <class Epi, class Sched, bool ALIGN_EPI = false, bool SP2 = false>
__device__ __forceinline__ void gemm_phase_i8(PG8_LAS unsigned char* lds, const Gemm g, const Sched& S, const Epi& E) {
    int tid_ = (int)threadIdx.x; asm volatile("" : "+v"(tid_));
    const int tid = tid_, wid = __builtin_amdgcn_readfirstlane(tid >> 6), lane = tid & 63, wr = wid >> 2, wc = wid & 3, fr = lane & 15, fq = lane >> 4;
    const int K = g.K, nt = K / BK;
    unsigned voffA[2], voffB[2];
#pragma unroll
    for (int i = 0; i < 2; ++i) { int R, C; stage_rc(tid * 16 + i * 8192, R, C); const int Rb = Epi::PERM ? ((R & ~31) + perm32(R & 31)) : R;
        voffA[i] = (unsigned)(R * K + C) * 2u; voffB[i] = (unsigned)(Rb * K + C) * 2u; }
    const size_t kstep = (size_t)(BK * 2);
    const size_t hstep = (size_t)HALF * K * 2;
    const size_t tstep = 2 * hstep;
    const unsigned ldsw = (unsigned)wid * 1024u;
    const int aoff = lds_byte(wr * 64 + fr, fq * 8), boff = lds_byte(wc * 32 + fr, fq * 8);
#define PG8_SA(b, h) (((b) * 2 + (h)) * HTB)
#define PG8_SB(b, h) ((4 + (b) * 2 + (h)) * HTB)
#define PG8_STAGE(bufoff, gbase, voff) do { _Pragma("unroll") for (int _i = 0; _i < 2; ++_i) \
        __builtin_amdgcn_global_load_lds((const unsigned*)((const char*)(gbase) + (voff)[_i]), (PG8_LAS unsigned*)(lds + (bufoff) + ldsw + _i * 8192), 16, 0, 0); } while (0)
#define PG8_LDA(dst, b, h) do { _Pragma("unroll") for (int m = 0; m < 4; ++m) _Pragma("unroll") for (int k = 0; k < 2; ++k) dst[m][k] = *(const PG8_LAS bf16x8*)(lds + PG8_SA(b, h) + aoff + m * 2048 + k * 1024); } while (0)
#define PG8_LDB(dst, b, h) do { _Pragma("unroll") for (int n = 0; n < 2; ++n) _Pragma("unroll") for (int k = 0; k < 2; ++k) dst[n][k] = *(const PG8_LAS bf16x8*)(lds + PG8_SB(b, h) + boff + n * 2048 + k * 1024); } while (0)
#define PG8_MMA(ai, bj, At, Bt) do { __builtin_amdgcn_s_setprio(1); _Pragma("unroll") for (int m = 0; m < 4; ++m) _Pragma("unroll") for (int n = 0; n < 2; ++n) _Pragma("unroll") for (int k = 0; k < 2; ++k) \
        acc[ai][bj][m][n] = __builtin_amdgcn_mfma_i32_16x16x64_i8(__builtin_bit_cast(i32x4, Bt[n][k]), __builtin_bit_cast(i32x4, At[m][k]), acc[ai][bj][m][n], 0, 0, 0); __builtin_amdgcn_s_setprio(0); } while (0)
#define PG8_WAIT_V(n) asm volatile("s_waitcnt vmcnt(" #n ")" ::: "memory")
#define PG8_WAIT_L(n) asm volatile("s_waitcnt lgkmcnt(" #n ")" ::: "memory")
#define PG8_BAR __builtin_amdgcn_s_barrier()
#define PG8_SCHED __builtin_amdgcn_sched_barrier(0)
    Unit cur, nxt; int ui = 0;
    if (!S.next(0, cur)) return;
    i32x4 acc[2][2][4][2];
#pragma unroll
    for (int a = 0; a < 2; ++a)
#pragma unroll
        for (int b = 0; b < 2; ++b)
#pragma unroll
            for (int m = 0; m < 4; ++m)
#pragma unroll
                for (int n = 0; n < 2; ++n) acc[a][b][m][n] = (i32x4){0, 0, 0, 0};
    bf16x8 At[4][2], B0[2][2], B1[2][2];
    const char* cA = (const char*)g.A + (size_t)cur.pm * tstep; const char* cB = (const char*)g.Bt + (size_t)cur.pn * tstep;
    S.a_ready(cur);
    if constexpr (SP2) {
        PG8_STAGE(PG8_SB(0, 0), cB, voffB); PG8_STAGE(PG8_SB(0, 1), cB + hstep, voffB); PG8_STAGE(PG8_SA(0, 0), cA, voffA); PG8_STAGE(PG8_SA(0, 1), cA + hstep, voffA);
        if (wr == 1) PG8_BAR;
        PG8_WAIT_V(2); PG8_BAR;
        PG8_STAGE(PG8_SB(1, 0), cB + kstep, voffB); PG8_STAGE(PG8_SA(1, 0), cA + kstep, voffA); PG8_STAGE(PG8_SB(1, 1), cB + hstep + kstep, voffB);
        PG8_WAIT_V(6); PG8_BAR;
    } else {
        PG8_STAGE(PG8_SB(0, 0), cB, voffB); PG8_STAGE(PG8_SA(0, 0), cA, voffA); PG8_STAGE(PG8_SB(0, 1), cB + hstep, voffB); PG8_STAGE(PG8_SA(0, 1), cA + hstep, voffA);
        if (wr == 1) PG8_BAR;
        PG8_WAIT_V(4); PG8_BAR;
        PG8_STAGE(PG8_SB(1, 0), cB + kstep, voffB); PG8_STAGE(PG8_SA(1, 0), cA + kstep, voffA); PG8_STAGE(PG8_SB(1, 1), cB + hstep + kstep, voffB);
        PG8_WAIT_V(6); PG8_BAR;
    }
    for (;;) {
        const bool has_next = S.next(ui + 1, nxt);
        const char* nA = has_next ? (const char*)g.A + (size_t)nxt.pm * tstep : cA; const char* nB = has_next ? (const char*)g.Bt + (size_t)nxt.pn * tstep : cB;
        for (int t = 0; t < nt; t += 2) {
            const bool last = (t == nt - 2);
            const char* a1 = cA + (size_t)(t + 1) * kstep;
            const char* a2 = last ? nA : cA + (size_t)(t + 2) * kstep; const char* b2 = last ? nB : cB + (size_t)(t + 2) * kstep;
            const char* a3 = a2 + kstep; const char* b3 = b2 + kstep;
            if (last && has_next) S.a_ready(nxt);
            if constexpr (SP2) {
            PG8_LDB(B0, 0, 0); PG8_LDB(B1, 0, 1); PG8_SCHED; PG8_LDA(At, 0, 0); PG8_STAGE(PG8_SA(1, 1), a1 + hstep, voffA);
            PG8_WAIT_V(8); PG8_WAIT_L(0); PG8_BAR; PG8_MMA(0, 0, At, B0); PG8_MMA(0, 1, At, B1); PG8_BAR; PG8_SCHED;
            PG8_LDA(At, 0, 1); PG8_STAGE(PG8_SB(0, 0), b2, voffB); PG8_STAGE(PG8_SB(0, 1), b2 + hstep, voffB); PG8_STAGE(PG8_SA(0, 0), a2, voffA);
            PG8_WAIT_V(8); PG8_WAIT_L(0); PG8_BAR; PG8_MMA(1, 0, At, B0); PG8_MMA(1, 1, At, B1); PG8_BAR; PG8_SCHED;
            PG8_LDB(B0, 1, 0); PG8_LDB(B1, 1, 1); PG8_SCHED; PG8_LDA(At, 1, 0); PG8_STAGE(PG8_SA(0, 1), a2 + hstep, voffA);
            PG8_WAIT_V(8); PG8_WAIT_L(0); PG8_BAR; PG8_MMA(0, 0, At, B0); PG8_MMA(0, 1, At, B1); PG8_BAR; PG8_SCHED;
            PG8_LDA(At, 1, 1); PG8_STAGE(PG8_SB(1, 0), b3, voffB); PG8_STAGE(PG8_SB(1, 1), b3 + hstep, voffB); PG8_STAGE(PG8_SA(1, 0), a3, voffA);
            PG8_WAIT_V(8); PG8_WAIT_L(0); PG8_BAR; PG8_MMA(1, 0, At, B0); PG8_MMA(1, 1, At, B1); PG8_BAR; PG8_SCHED;
            } else {
            PG8_LDB(B0, 0, 0); PG8_SCHED; PG8_LDA(At, 0, 0); PG8_STAGE(PG8_SA(1, 1), a1 + hstep, voffA);
            PG8_WAIT_L(8); PG8_BAR; PG8_WAIT_L(0); PG8_MMA(0, 0, At, B0); PG8_BAR; PG8_SCHED;
            PG8_LDB(B1, 0, 1); PG8_STAGE(PG8_SB(0, 0), b2, voffB);
            PG8_BAR; PG8_WAIT_L(0); PG8_MMA(0, 1, At, B1); PG8_BAR;
            PG8_LDA(At, 0, 1); PG8_STAGE(PG8_SA(0, 0), a2, voffA);
            PG8_BAR; PG8_WAIT_L(0); PG8_MMA(1, 0, At, B0); PG8_BAR; PG8_SCHED;
            PG8_STAGE(PG8_SB(0, 1), b2 + hstep, voffB);
            PG8_WAIT_V(6); PG8_BAR; PG8_MMA(1, 1, At, B1); PG8_BAR;
            PG8_LDB(B0, 1, 0); PG8_SCHED; PG8_LDA(At, 1, 0); PG8_STAGE(PG8_SA(0, 1), a2 + hstep, voffA);
            PG8_WAIT_L(8); PG8_BAR; PG8_WAIT_L(0); PG8_MMA(0, 0, At, B0); PG8_BAR; PG8_SCHED;
            PG8_LDB(B1, 1, 1); PG8_STAGE(PG8_SB(1, 0), b3, voffB);
            PG8_BAR; PG8_WAIT_L(0); PG8_MMA(0, 1, At, B1); PG8_BAR;
            PG8_LDA(At, 1, 1); PG8_STAGE(PG8_SA(1, 0), a3, voffA);
            PG8_BAR; PG8_WAIT_L(0); PG8_MMA(1, 0, At, B0); PG8_BAR; PG8_SCHED;
            PG8_STAGE(PG8_SB(1, 1), b3 + hstep, voffB);
            PG8_WAIT_V(6); PG8_BAR; PG8_MMA(1, 1, At, B1); PG8_BAR;
            }
        }
        if constexpr (ALIGN_EPI) { if (wr == 0) PG8_BAR; }
        if constexpr (!Epi::AFTER_DRAIN) { E(acc, cur, wr, wc, fr, fq); S.done(cur); }
        if (!has_next) break;
#pragma unroll
        for (int a = 0; a < 2; ++a)
#pragma unroll
            for (int b = 0; b < 2; ++b)
#pragma unroll
                for (int m = 0; m < 4; ++m)
#pragma unroll
                    for (int n = 0; n < 2; ++n) acc[a][b][m][n] = (i32x4){0, 0, 0, 0};
        cur = nxt; cA = nA; cB = nB; ++ui;
        if constexpr (ALIGN_EPI) { if (wr == 1) PG8_BAR; }
    }
    PG8_WAIT_V(0);
    if constexpr (!ALIGN_EPI) { if (wr == 0) PG8_BAR; }
    PG8_BAR;
    if constexpr (Epi::AFTER_DRAIN) { E.fused(acc, cur, wr, wc, fr, fq, lds, wid, lane); S.done(cur); }
#undef PG8_SA
#undef PG8_SB
#undef PG8_STAGE
#undef PG8_LDA
#undef PG8_LDB
#undef PG8_MMA
#undef PG8_WAIT_V
#undef PG8_WAIT_L
#undef PG8_BAR
#undef PG8_SCHED
}
}

struct ProjOut { const float* rs1; const float* lbl; const float* ffb; bf16_t *QH, *LF, *VH, *GH, *FQ, *FK, *FV, *SGA, *SGB; float* LFF; };
DI float rs2_of(const float* SSQ, int row) {
    const f32x4* p = (const f32x4*)(SSQ + (size_t)row * 16); const f32x4 a = p[0], b = p[1], c = p[2], d = p[3];
    const float s = ((a[0] + a[1]) + (a[2] + a[3])) + ((b[0] + b[1]) + (b[2] + b[3])) + ((c[0] + c[1]) + (c[2] + c[3])) + ((d[0] + d[1]) + (d[2] + d[3]));
    return 1.0f / sqrtf(s * (1.0f / kD) + kEps);
}
constexpr int HG_TSTR = 144;
constexpr int HG_KSTR = 272;
DI void hg_load_vt(const bf16_t* VHc  , LAS unsigned char* vt) {
    const int tid = VTID, s = (tid >> 1) & 63, vq = (tid & 1) + 2 * (tid >> 7);
#pragma unroll
    for (int i = 0; i < 4; ++i) {
        const int vc = 8 * (vq + 4 * i);
        const uint4 u = *(const uint4*)(VHc + (size_t)s * 512 + vc);
        const unsigned w[4] = {u.x, u.y, u.z, u.w};
#pragma unroll
        for (int j = 0; j < 4; ++j) {
            *(LAS unsigned short*)(vt + (vc + 2 * j) * HG_TSTR + s * 2) = (unsigned short)(w[j] & 0xffffu);
            *(LAS unsigned short*)(vt + (vc + 2 * j + 1) * HG_TSTR + s * 2) = (unsigned short)(w[j] >> 16);
        }
    }
}
DI void ph_hgrn1(const bf16_t* LF, const bf16_t* VH, bf16_t* ST, float* DC, int bid, int nblk, LAS unsigned char* lds) {
    LAS unsigned char* klt = lds;
    LAS unsigned char* vt = lds + 128 * HG_TSTR;
    LAS float* tot = (LAS float*)(lds + 256 * HG_TSTR);
    const int tid = VTID, k = tid & 127, half = tid >> 7; const LaneId li = lane_id();
    for (int ib = 0; ib < 2048; ib += nblk) {
        const int item = ib + bid;
        const int c = item & 63, bh = item >> 6, b = bh >> 2, h = bh & 3;
        const size_t rowbase = (size_t)(b * kS + c * 64) * 512 + h * 128;
        __syncthreads();
        float fv[32];
        { float prod = 1.f;
#pragma unroll
          for (int i = 0; i < 32; ++i) { fv[i] = __builtin_amdgcn_exp2f(bf2f(LF[rowbase + (size_t)(32 * half + i) * 512 + k])); prod *= fv[i]; }
          tot[half * 128 + k] = prod; }
        hg_load_vt(VH + rowbase, vt);
        __syncthreads();
        {
            const float t0 = tot[k], t1 = tot[128 + k];
            float sfx = half ? 1.f : t1;
            unsigned w[16];
#pragma unroll
            for (int i = 30; i >= 0; i -= 2) {
                const float a1 = (1.f - fv[i + 1]) * sfx; sfx *= fv[i + 1];
                const float a0 = (1.f - fv[i]) * sfx; sfx *= fv[i];
                w[i >> 1] = cvtpk(a0, a1);
            }
#pragma unroll
            for (int i = 0; i < 4; ++i) *(LAS u32x4*)(klt + k * HG_TSTR + half * 64 + i * 16) = (u32x4){w[4 * i], w[4 * i + 1], w[4 * i + 2], w[4 * i + 3]};
            if (half == 0) DC[(size_t)item * 128 + k] = t0 * t1;
        }
        __syncthreads();
        f32x4 acc[4][4]; acc_zero(acc);
#pragma unroll
        for (int ks = 0; ks < 2; ++ks) {
            bf16x8 af[4], bfr[4];
#pragma unroll
            for (int m = 0; m < 4; ++m) af[m] = *(const LAS bf16x8*)(vt + (li.wr * 64 + m * 16 + li.fr) * HG_TSTR + ks * 64 + li.fq * 16);
#pragma unroll
            for (int n = 0; n < 4; ++n) bfr[n] = *(const LAS bf16x8*)(klt + (li.wc * 64 + n * 16 + li.fr) * HG_TSTR + ks * 64 + li.fq * 16);
#pragma unroll
            for (int m = 0; m < 4; ++m)
#pragma unroll
                for (int n = 0; n < 4; ++n) acc[m][n] = __builtin_amdgcn_mfma_f32_16x16x32_bf16(bfr[n], af[m], acc[m][n], 0, 0, 0);
        }
        bf16_t* dst = ST + (size_t)item * 16384;
#pragma unroll
        for (int m = 0; m < 4; ++m)
#pragma unroll
            for (int n = 0; n < 4; n += 2) {
                const auto r01 = __builtin_amdgcn_permlane16_swap(cvtpk(acc[m][n][0], acc[m][n][1]), cvtpk(acc[m][n + 1][0], acc[m][n + 1][1]), false, false);
                const auto r23 = __builtin_amdgcn_permlane16_swap(cvtpk(acc[m][n][2], acc[m][n][3]), cvtpk(acc[m][n + 1][2], acc[m][n + 1][3]), false, false);
                *(uint4*)(dst + (li.wr * 64 + m * 16 + li.fr) * 128 + li.wc * 64 + n * 16 + 16 * (li.fq & 1) + 8 * (li.fq >> 1)) = make_uint4(r01[0], r23[0], r01[1], r23[1]);
            }
    }
}
DI void ph_hgrn2(bf16_t* ST, const float* DC, int bid, int nblk) {
    for (int u = bid * 256 + VTID; u < 32 * 2048; u += nblk * 256) {
        const int bh = u >> 11, vk = u & 2047, k8 = (vk & 15) * 8;
        float S[8];
#pragma unroll
        for (int j = 0; j < 8; ++j) S[j] = 0.f;
        bf16_t* p = ST + (size_t)bh * 64 * 16384 + (size_t)vk * 8;
        const float* d = DC + (size_t)bh * 64 * 128 + k8;
#pragma unroll 8
        for (int c = 0; c < 64; ++c) {
            const uint4 lt = *(const uint4*)(p + (size_t)c * 16384);
            const float4 d0 = *(const float4*)(d + c * 128), d1 = *(const float4*)(d + c * 128 + 4);
            *(uint4*)(p + (size_t)c * 16384) = make_uint4(cvtpk(S[0], S[1]), cvtpk(S[2], S[3]), cvtpk(S[4], S[5]), cvtpk(S[6], S[7]));
            const float dd[8] = {d0.x, d0.y, d0.z, d0.w, d1.x, d1.y, d1.z, d1.w};
            const unsigned lw[4] = {lt.x, lt.y, lt.z, lt.w};
#pragma unroll
            for (int j = 0; j < 4; ++j) { S[2 * j] = dd[2 * j] * S[2 * j] + __uint_as_float(lw[j] << 16); S[2 * j + 1] = dd[2 * j + 1] * S[2 * j + 1] + __uint_as_float(lw[j] & 0xffff0000u); }
        }
    }
}
DI bf16x8 hg_scale_frag(bf16x8 q, const LAS float* ra, const LAS float* rb  ) {
    const f32x4 a0 = *(const LAS f32x4*)ra, a1 = *(const LAS f32x4*)(ra + 4);
    f32x4 b0 = (f32x4){0.f, 0.f, 0.f, 0.f}, b1 = b0;
    if (rb) { b0 = *(const LAS f32x4*)rb; b1 = *(const LAS f32x4*)(rb + 4); }
    const u32x4 u = __builtin_bit_cast(u32x4, q);
    unsigned w[4];
#pragma unroll
    for (int j = 0; j < 4; ++j) {
        const float ea = (j < 2) ? a0[2 * j] - b0[2 * j] : a1[2 * j - 4] - b1[2 * j - 4];
        const float eb = (j < 2) ? a0[2 * j + 1] - b0[2 * j + 1] : a1[2 * j - 3] - b1[2 * j - 3];
        w[j] = cvtpk(__uint_as_float(u[j] << 16) * __builtin_amdgcn_exp2f(ea), __uint_as_float(u[j] & 0xffff0000u) * __builtin_amdgcn_exp2f(eb));
    }
    return __builtin_bit_cast(bf16x8, (u32x4){w[0], w[1], w[2], w[3]});
}
constexpr int HG3_QH = 0, HG3_KE = 64 * HG_KSTR, HG3_VT = 128 * HG_KSTR, HG3_AM = HG3_VT + 128 * HG_TSTR, HG3_R = HG3_AM + 64 * HG_TSTR, HG3_TOT = HG3_R + 5 * 512, HG3_BYTES = HG3_TOT + 2048;
DI void ph_hgrn3(const bf16_t* QH, const bf16_t* LF, const bf16_t* VH, const bf16_t* GH, const bf16_t* ST, const float* normw, bf16_t* Aout, int bid, int nblk, LAS unsigned char* lds) {
    LAS unsigned char* qh = lds + HG3_QH; LAS unsigned char* ke = lds + HG3_KE; LAS unsigned char* vt = lds + HG3_VT; LAS unsigned char* am = lds + HG3_AM;
    LAS float* R = (LAS float*)(lds + HG3_R); LAS float* tot = (LAS float*)(lds + HG3_TOT);
    const int tid = VTID, k = tid & 127, half = tid >> 7, lane = tid & 63, I = tid >> 6, fr = lane & 15, fq = lane >> 4;
    for (int ib = 0; ib < 2048; ib += nblk) {
        const int item = ib + bid;
        const int c = item & 63, bh = item >> 6, b = bh >> 2, h = bh & 3;
        const size_t rowbase = (size_t)(b * kS + c * 64) * 512 + h * 128;
        uint4 stg[8];
#pragma unroll
        for (int i = 0; i < 8; ++i) stg[i] = *(const uint4*)(ST + (size_t)item * 16384 + (size_t)(tid + 256 * i) * 8);
        __syncthreads();
        const int g = tid >> 6, kp = tid & 63;
        LAS float* Dd = R; LAS float* Di = R + 512;
        {
            float f0[16], f1[16];
#pragma unroll
            for (int i = 0; i < 16; ++i) { const unsigned w_ = *(const unsigned*)(LF + rowbase + (size_t)(16 * g + i) * 512 + 2 * kp);
                f0[i] = __builtin_amdgcn_exp2f(__uint_as_float(w_ << 16)); f1[i] = __builtin_amdgcn_exp2f(__uint_as_float(w_ & 0xffff0000u)); }
            hg_load_vt(VH + rowbase, vt);
            float p0 = 1.f, p1 = 1.f;
#pragma unroll
            for (int i = 0; i < 16; ++i) {
                const unsigned qw = *(const unsigned*)(QH + rowbase + (size_t)(16 * g + i) * 512 + 2 * kp);
                p0 *= f0[i]; p1 *= f1[i];
                *(LAS unsigned*)(qh + (16 * g + i) * HG_KSTR + kp * 4) = cvtpk(__uint_as_float(qw << 16) * p0, __uint_as_float(qw & 0xffff0000u) * p1);
            }
            Dd[g * 128 + 2 * kp] = p0; Dd[g * 128 + 2 * kp + 1] = p1;
            Di[g * 128 + 2 * kp] = __builtin_amdgcn_rcpf(p0); Di[g * 128 + 2 * kp + 1] = __builtin_amdgcn_rcpf(p1);
            float s0 = 1.f, s1 = 1.f;
#pragma unroll
            for (int i = 15; i >= 0; --i) {
                *(LAS unsigned*)(ke + (16 * g + i) * HG_KSTR + kp * 4) = cvtpk((1.f - f0[i]) * s0, (1.f - f1[i]) * s1);
                s0 *= f0[i]; s1 *= f1[i];
            }
        }
        __syncthreads();
        bf16x8 qf[4]; float P[4][8];
#pragma unroll
        for (int ks = 0; ks < 4; ++ks) { qf[ks] = *(const LAS bf16x8*)(qh + (16 * I + fr) * HG_KSTR + ks * 64 + fq * 16); const u32x4 u_ = __builtin_bit_cast(u32x4, qf[ks]);
#pragma unroll
            for (int j = 0; j < 4; ++j) { P[ks][2 * j] = __uint_as_float(u_[j] << 16); P[ks][2 * j + 1] = __uint_as_float(u_[j] & 0xffff0000u); } }
        {
            f32x4 d = (f32x4){0.f, 0.f, 0.f, 0.f};
#pragma unroll
            for (int ks = 0; ks < 4; ++ks) {
                const bf16x8 kf = *(const LAS bf16x8*)(ke + (16 * I + fr) * HG_KSTR + ks * 64 + fq * 16);
                const f32x4 e0 = *(const LAS f32x4*)(Di + I * 128 + ks * 32 + fq * 8), e1 = *(const LAS f32x4*)(Di + I * 128 + ks * 32 + fq * 8 + 4);
                const u32x4 w_ = {cvtpk(P[ks][0] * e0[0], P[ks][1] * e0[1]), cvtpk(P[ks][2] * e0[2], P[ks][3] * e0[3]), cvtpk(P[ks][4] * e1[0], P[ks][5] * e1[1]), cvtpk(P[ks][6] * e1[2], P[ks][7] * e1[3])};
                d = __builtin_amdgcn_mfma_f32_16x16x32_bf16(kf, __builtin_bit_cast(bf16x8, w_), d, 0, 0, 0);
            }
#pragma unroll
            for (int j = 0; j < 4; ++j) if (4 * fq + j > fr) d[j] = 0.f;
            *(LAS u32x2*)(am + (16 * I + fr) * HG_TSTR + (16 * I + 4 * fq) * 2) = (u32x2){cvtpk(d[0], d[1]), cvtpk(d[2], d[3])};
        }
        for (int J = I - 1; J >= 0; --J) {
            f32x4 d = (f32x4){0.f, 0.f, 0.f, 0.f};
#pragma unroll
            for (int ks = 0; ks < 4; ++ks) {
                const bf16x8 kf = *(const LAS bf16x8*)(ke + (16 * J + fr) * HG_KSTR + ks * 64 + fq * 16);
                bf16x8 qs = qf[ks];
                if (J < I - 1) {
                    const f32x4 e0 = *(const LAS f32x4*)(Dd + (J + 1) * 128 + ks * 32 + fq * 8), e1 = *(const LAS f32x4*)(Dd + (J + 1) * 128 + ks * 32 + fq * 8 + 4);
#pragma unroll
                    for (int j = 0; j < 4; ++j) { P[ks][j] *= e0[j]; P[ks][4 + j] *= e1[j]; }
                    const u32x4 w_ = {cvtpk(P[ks][0], P[ks][1]), cvtpk(P[ks][2], P[ks][3]), cvtpk(P[ks][4], P[ks][5]), cvtpk(P[ks][6], P[ks][7])};
                    qs = __builtin_bit_cast(bf16x8, w_);
                }
                d = __builtin_amdgcn_mfma_f32_16x16x32_bf16(kf, qs, d, 0, 0, 0);
            }
            *(LAS u32x2*)(am + (16 * I + fr) * HG_TSTR + (16 * J + 4 * fq) * 2) = (u32x2){cvtpk(d[0], d[1]), cvtpk(d[2], d[3])};
        }
        if ((I & 1) == 0) *(LAS u32x2*)(am + (16 * I + fr) * HG_TSTR + (16 * (I + 1) + 4 * fq) * 2) = (u32x2){0u, 0u};
        f32x4 o[8];
#pragma unroll
        for (int n = 0; n < 8; ++n) o[n] = (f32x4){0.f, 0.f, 0.f, 0.f};
        for (int ks = 0; ks <= (I >> 1); ++ks) {
            const bf16x8 af = *(const LAS bf16x8*)(am + (16 * I + fr) * HG_TSTR + ks * 64 + fq * 16);
#pragma unroll
            for (int n = 0; n < 8; ++n) { const bf16x8 vf = *(const LAS bf16x8*)(vt + (n * 16 + fr) * HG_TSTR + ks * 64 + fq * 16); o[n] = __builtin_amdgcn_mfma_f32_16x16x32_bf16(vf, af, o[n], 0, 0, 0); }
        }
        __syncthreads();
#pragma unroll
        for (int i = 0; i < 8; ++i) { const int pc = tid + 256 * i, row = pc >> 4, ch = pc & 15;
            *(LAS u32x4*)(lds + HG3_QH + row * 256 + ((ch ^ (row & 15)) << 4)) = (u32x4){stg[i].x, stg[i].y, stg[i].z, stg[i].w}; }
        __syncthreads();
#pragma unroll
        for (int ks = 0; ks < 4; ++ks) {
            if (I >= 1) { const f32x4 e0 = *(const LAS f32x4*)(Dd + ks * 32 + fq * 8), e1 = *(const LAS f32x4*)(Dd + ks * 32 + fq * 8 + 4);
#pragma unroll
                for (int j = 0; j < 4; ++j) { P[ks][j] *= e0[j]; P[ks][4 + j] *= e1[j]; } }
            const u32x4 wq_ = {cvtpk(P[ks][0], P[ks][1]), cvtpk(P[ks][2], P[ks][3]), cvtpk(P[ks][4], P[ks][5]), cvtpk(P[ks][6], P[ks][7])};
            const bf16x8 qc = __builtin_bit_cast(bf16x8, wq_);
#pragma unroll
            for (int n = 0; n < 8; ++n) { const bf16x8 sf = *(const LAS bf16x8*)(lds + HG3_QH + (n * 16 + fr) * 256 + (((ks * 4 + fq) ^ fr) << 4)); o[n] = __builtin_amdgcn_mfma_f32_16x16x32_bf16(sf, qc, o[n], 0, 0, 0); }
        }
        float ss = 0.f;
#pragma unroll
        for (int n = 0; n < 8; ++n) ss += o[n][0] * o[n][0] + o[n][1] * o[n][1] + o[n][2] * o[n][2] + o[n][3] * o[n][3];
        ss += __shfl_xor(ss, 16); ss += __shfl_xor(ss, 32);
        const float rstd = 1.0f / sqrtf(ss * (1.0f / 128.f) + kEps);
        const size_t orow = rowbase + (size_t)(16 * I + fr) * 512;
        const int v8 = 16 * (fq & 1) + 8 * (fq >> 1);
        uint4 gq[4];
#pragma unroll
        for (int n = 0; n < 8; n += 2) gq[n >> 1] = *(const uint4*)(GH + orow + n * 16 + v8);
#pragma unroll
        for (int n = 0; n < 8; n += 2) {
            f32x4 a, b;
#pragma unroll
            for (int j = 0; j < 4; ++j) { const auto r_ = __builtin_amdgcn_permlane16_swap(__float_as_uint(o[n][j]), __float_as_uint(o[n + 1][j]), false, false); a[j] = __uint_as_float(r_[0]); b[j] = __uint_as_float(r_[1]); }
            const f32x4 w0 = *(const f32x4*)(normw + h * 128 + n * 16 + v8), w1 = *(const f32x4*)(normw + h * 128 + n * 16 + v8 + 4);
            const uint4 gg = gq[n >> 1];
            const f32x4 g0 = {__uint_as_float(gg.x << 16), __uint_as_float(gg.x & 0xffff0000u), __uint_as_float(gg.y << 16), __uint_as_float(gg.y & 0xffff0000u)};
            const f32x4 g1 = {__uint_as_float(gg.z << 16), __uint_as_float(gg.z & 0xffff0000u), __uint_as_float(gg.w << 16), __uint_as_float(gg.w & 0xffff0000u)};
            a = a * rstd * w0 * g0; b = b * rstd * w1 * g1;
            *(uint4*)(Aout + orow + n * 16 + v8) = make_uint4(cvtpk(a[0], a[1]), cvtpk(a[2], a[3]), cvtpk(b[0], b[1]), cvtpk(b[2], b[3]));
        }
    }
}

DI void ph_cfox(const float* LFF, float* cf, bf16_t* aug, int bid, int nblk, float* sm) {
    const int tid = VTID, lane = tid & 63, wid = tid >> 6;
    for (int seq = bid; seq < 64; seq += nblk) {
        const int b = seq >> 3, h = seq & 7;
        float v[16]; float run = 0.f;
#pragma unroll
        for (int i = 0; i < 16; ++i) { run += LFF[(size_t)(b * kS + tid * 16 + i) * 8 + h]; v[i] = run; }
        float inc = run;
#pragma unroll
        for (int o = 1; o < 64; o <<= 1) { const float n = __shfl_up(inc, o); if (lane >= o) inc += n; }
        __syncthreads();
        if (lane == 63) sm[wid] = inc;
        __syncthreads();
        float base = inc - run;
        for (int w = 0; w < wid; ++w) base += sm[w];
        float* tw = sm + 64 + wid * 1088;
#pragma unroll
        for (int i = 0; i < 16; ++i) tw[lane * 17 + i] = base + v[i];
        asm volatile("s_waitcnt vmcnt(0) lgkmcnt(0)" ::: "memory"); __builtin_amdgcn_wave_barrier();
#pragma unroll
        for (int i = 0; i < 16; ++i) {
            const int tl_ = i * 64 + lane; const float cv = tw[(tl_ >> 4) * 17 + (tl_ & 15)];
            const size_t tok = (size_t)seq * kS + wid * 1024 + tl_;
            cf[tok] = cv;
            const float xx = -cv; const unsigned b1 = cvtpk(xx, 0.f) & 0xffffu; const float r1 = xx - __uint_as_float(b1 << 16);
            const unsigned b2 = cvtpk(r1, 0.f) & 0xffffu; const float r2 = r1 - __uint_as_float(b2 << 16); const unsigned b3 = cvtpk(r2, 0.f) & 0xffffu;
            *(uint4*)(aug + tok * 8) = make_uint4(b1 | (b2 << 16), b3 | 0xBF800000u, 0xBF80BF80u, 0u);
        }
    }
}
DI float max3f(float a, float b, float c) { float r; asm("v_max3_f32 %0, %1, %2, %3" : "=v"(r) : "v"(a), "v"(b), "v"(c)); return r; }
DI float max2f(float a, float b) { float r; asm("v_max_f32_e32 %0, %1, %2" : "=v"(r) : "v"(a), "v"(b)); return r; }
typedef float f32x16 __attribute__((ext_vector_type(16)));
typedef short s16x4 __attribute__((ext_vector_type(4)));
namespace at64 {
using bf16 = bf16_t;
constexpr int SEQ = kS, NHEAD = 8, D = 64, DM = NHEAD * D;
constexpr int NW = 8, QBLK = 32, QB = QBLK * NW, KVBLK = 64, NQB = SEQ / QB;
constexpr float C2 = 1.0f;
constexpr int SLOTB = 8192, LDS_K = 0, LDS_V = 3 * SLOTB, LDS_WS = 6 * SLOTB, LDS_OST = LDS_WS + NW * 256, LDS_AUG = LDS_OST + NW * 4096, LDS_BYTES = LDS_AUG + SEQ * 16;
#define ATTN64_THR 8
#define ATTN64_BROKEN 0
#define SBAR() __builtin_amdgcn_sched_barrier(0)
#define PIN(x) asm volatile("" : "+v"(x))
#define MFMA(a, b, c) __builtin_amdgcn_mfma_f32_32x32x16_bf16(a, b, c, 0, 0, 0)
#define WAIT_BAR(N) asm volatile("s_waitcnt vmcnt(" #N ") lgkmcnt(0)\n\ts_barrier" ::: "memory")

__device__ __forceinline__ int crow(int r, int hi) { return (r & 3) + 8 * (r >> 2) + 4 * hi; }
__device__ __forceinline__ unsigned cvtpk(float lo, float hi) { unsigned r; asm("v_cvt_pk_bf16_f32 %0, %1, %2" : "=v"(r) : "v"(lo), "v"(hi)); return r; }
__device__ __forceinline__ void glds16(const void* sbase, unsigned voff, unsigned lds_base) {
    unsigned sv; asm volatile("s_mov_b32 %0, m0\n\ts_mov_b32 m0, %3\n\ts_nop 0\n\tglobal_load_lds_dwordx4 %1, %2\n\ts_mov_b32 m0, %0" : "=&s"(sv) : "v"(voff), "s"(sbase), "s"(lds_base) : "memory"); }
typedef __attribute__((address_space(3))) const char* lds_cptr;
typedef short v4i16_t __attribute__((ext_vector_type(4)));
__device__ __forceinline__ void kload2(bf16x8* kf, lds_cptr kp, int d0) { kf[2 * d0] = *(const __attribute__((address_space(3))) bf16x8*)(kp + d0 * 2048); kf[2 * d0 + 1] = *(const __attribute__((address_space(3))) bf16x8*)(kp + d0 * 2048 + 512); }
__device__ __forceinline__ s16x4 vtr(lds_cptr p) { return __builtin_bit_cast(s16x4, __builtin_amdgcn_ds_read_tr16_b64_v4i16((__attribute__((address_space(3))) v4i16_t*)p)); }
#define MX3(a, b, c) __builtin_fmaxf(__builtin_fmaxf((a), (b)), (c))
__device__ __forceinline__ float rowmax(const f32x16& p0, const f32x16& p1) {
    float a = MX3(p0[0], p0[1], p1[0]), b = MX3(p0[2], p0[3], p1[1]); a = MX3(a, p1[2], p1[3]);
#pragma unroll
    for (int r = 4; r < 16; r += 4) { a = MX3(a, p0[r], p0[r + 1]); b = MX3(b, p0[r + 2], p0[r + 3]); a = MX3(a, p1[r], p1[r + 1]); b = MX3(b, p1[r + 2], p1[r + 3]); }
    float m = __builtin_fmaxf(a, b); auto rr = __builtin_amdgcn_permlane32_swap(__float_as_uint(m), __float_as_uint(m), false, false);
    return __builtin_fmaxf(__uint_as_float(rr[0]), __uint_as_float(rr[1])); }
__device__ __forceinline__ void cmask(f32x16& p0, f32x16& p1, int jb, int qrel, int hi) {
    const int kb = 64 * jb + 4 * hi;
#pragma unroll
    for (int r = 0; r < 16; ++r) { const int kv = kb + (r & 3) + 8 * (r >> 2); if (kv > qrel) p0[r] = -INFINITY; if (kv + 32 > qrel) p1[r] = -INFINITY; } }

__device__ __forceinline__ void attn64_unit(int b, int h, int qb, bool fill, const bf16* Q, const bf16* __restrict__ K, const bf16* __restrict__ V, const bf16* __restrict__ AUG, bf16* O, char* lds) {
    const int tid = threadIdx.x, lane = tid & 63, r32 = lane & 31, hi = lane >> 5; const int wid = __builtin_amdgcn_readfirstlane(tid >> 6);
    const long rowbase = (long)b * SEQ; const int q0 = qb * QB, NT = (q0 + QB) / KVBLK;
    const bf16* Qw = Q + (rowbase + q0 + wid * QBLK) * DM + h * D;
    const unsigned lds0 = (unsigned)(uintptr_t)lds; float* wsf = (float*)(lds + LDS_WS) + wid * 64;
    if (fill) { const char* ag = (const char*)(AUG + ((long)(b * NHEAD + h) * SEQ) * 8); const int nby = (q0 + QB) * 16;
      for (int of = tid * 16; of < nby; of += 64 * NW * 16) *(__attribute__((address_space(3))) u32x4*)((lds_cptr)lds + LDS_AUG + of) = *(const u32x4*)(ag + of); }
    const lds_cptr augp = (lds_cptr)lds + LDS_AUG + r32 * 16;
    bf16x8 qaug = __builtin_bit_cast(bf16x8, (u32x4){hi == 0 ? 0x3F803F80u : 0u, hi == 0 ? 0x00003F80u : 0u, 0u, 0u});
    float mf = 0.f;
#define SETQ() do { const unsigned m1_ = cvtpk(mf, 0.f) & 0xffffu; const float r1_ = mf - __uint_as_float(m1_ << 16); const unsigned m2_ = cvtpk(r1_, 0.f) & 0xffffu; \
        const float r2_ = r1_ - __uint_as_float(m2_ << 16); const unsigned m3_ = cvtpk(r2_, 0.f) & 0xffffu; \
        qaug = __builtin_bit_cast(bf16x8, (u32x4){hi == 0 ? 0x3F803F80u : 0u, hi == 0 ? (0x3F80u | (m1_ << 16)) : 0u, hi == 0 ? (m2_ | (m3_ << 16)) : 0u, 0u}); } while (0)
    bf16x8 ka0, ka1;
#define KAR(st) do { ka0 = *(const __attribute__((address_space(3))) bf16x8*)(augp + (NT - 1 - (st)) * 1024); ka1 = *(const __attribute__((address_space(3))) bf16x8*)(augp + (NT - 1 - (st)) * 1024 + 512); } while (0)
#define KAF(v) (v)
    const bf16* kbase = K + rowbase * DM + h * D + wid * 8; const unsigned koff = (unsigned)lane * (DM * 2);
    const bf16* vbase = V + rowbase * DM + h * D + (long)(16 * (wid & 3)) * DM + (wid >> 2) * 32; const unsigned voff = (unsigned)((lane >> 2) * (DM * 2) + (lane & 3) * 16);
    const unsigned kdst = lds0 + LDS_K + wid * 1024, vdst = lds0 + LDS_V + wid * 1024;
#define DMA_K(t, slot) glds16(kbase + (long)(NT - 1 - (t)) * KVBLK * DM, koff, (unsigned)__builtin_amdgcn_readfirstlane(kdst + (slot)))
#define DMA_V(t, slot) glds16(vbase + (long)(NT - 1 - (t)) * KVBLK * DM, voff, (unsigned)__builtin_amdgcn_readfirstlane(vdst + (slot)))
    const lds_cptr vp0 = (lds_cptr)lds + LDS_V + ((lane >> 4) & 1) * 32 + (lane & 3) * 8 + (4 * hi + ((lane & 15) >> 2)) * 64;
    const lds_cptr kp0 = (lds_cptr)lds + LDS_K + hi * 1024 + r32 * 16;
    DMA_K(0, 0); DMA_V(0, 0); DMA_K(1, SLOTB);
    bf16x8 qr[4];
#pragma unroll
    for (int d0 = 0; d0 < 4; ++d0) qr[d0] = *reinterpret_cast<const bf16x8*>(&Qw[(long)r32 * DM + d0 * 16 + hi * 8]);
    float mhat = 0.f, l_reg = 0.f; f32x16 o[2]; o[0] = f32x16{}; o[1] = f32x16{};
    const f32x16 zero16 = f32x16{};
    const int qrel = wid * QBLK + r32; bool resc = false;
    f32x16 pA0, pA1, pB0, pB1; bf16x8 kf[8]; s16x4 vlo[8], vhi[8]; u32x4 pw0, pw1, pw2, pw3;
    int sl_prev = 0, sl_cur = 0, sl_next = SLOTB;
#define ROT() do { sl_prev = sl_cur; sl_cur = sl_next; sl_next = (sl_next == 2 * SLOTB) ? 0 : sl_next + SLOTB; } while (0)
#define EX0(v) __builtin_amdgcn_exp2f(__builtin_fmaf((v), C2, nmh))
#define EX(v) __builtin_amdgcn_exp2f(v)
#define RESC() do { if (resc && !ATTN64_BROKEN) { _Pragma("unroll") for (int d_ = 0; d_ < 2; ++d_) _Pragma("unroll") for (int r = 0; r < 16; ++r) o[d_][r] *= wsf[crow(r, hi)]; } } while (0)
    DMA_K(2, 2 * SLOTB);
    WAIT_BAR(3);
    _Pragma("unroll") for (int d0 = 0; d0 < 4; ++d0) kload2(kf, kp0, d0);
    pA0 = MFMA(kf[0], qr[0], zero16); pA1 = MFMA(kf[1], qr[0], zero16); pA0 = MFMA(kf[2], qr[1], pA0); pA1 = MFMA(kf[3], qr[1], pA1);
    pA0 = MFMA(kf[4], qr[2], pA0); pA1 = MFMA(kf[5], qr[2], pA1); pA0 = MFMA(kf[6], qr[3], pA0); pA1 = MFMA(kf[7], qr[3], pA1);
    KAR(0); pA0 = MFMA(KAF(ka0), qaug, pA0); pA1 = MFMA(KAF(ka1), qaug, pA1);
    cmask(pA0, pA1, 3, qrel, hi);
    { const float rm = rowmax(pA0, pA1); mhat = __builtin_fmaxf(rm, -1e30f) * C2; const float nmh = -mhat;
#pragma unroll
      for (int r = 0; r < 16; ++r) { pA0[r] = EX0(pA0[r]); pA1[r] = EX0(pA1[r]); }
      mf = (mhat < -0.5e30f) ? 0.f : mhat; SETQ(); }
    WAIT_BAR(0);
    DMA_K(3, 0); DMA_V(1, SLOTB); ROT();
    _Pragma("unroll") for (int d0 = 0; d0 < 4; ++d0) kload2(kf, kp0 + sl_cur, d0);
    WAIT_BAR(2);
#define PKW(P, i) cvtpk(P[i], P[i + 1])
#define PAF(k) __builtin_bit_cast(bf16x8, pw##k)
#define VFR(i) (bf16x8){vlo[i][0], vlo[i][1], vlo[i][2], vlo[i][3], vhi[i][0], vhi[i][1], vhi[i][2], vhi[i][3]}
#define VRD(i) do { vlo[i] = vtr(vp_ + (((i) >> 2) * 4096 + ((i) & 3) * 1024)); vhi[i] = vtr(vp_ + (((i) >> 2) * 4096 + ((i) & 3) * 1024 + 512)); } while (0)
#define KRD(G, d0) do { if (G) { kload2(kf, kp0 + sl_next, d0); SBAR(); } } while (0)
#define GAPA(MF, a0, a1, a2, a3, W0, W1, PW) do { MF; sacc += a0; sacc += a1; sacc += a2; sacc += a3; W0; W1; PIN(PW); PIN(sacc); SBAR(); } while (0)
#define GAPB(MF, X, i) do { MF; X[i] = EX(X[i]); X[i + 1] = EX(X[i + 1]); X[i + 2] = EX(X[i + 2]); X[i + 3] = EX(X[i + 3]); PIN(X); SBAR(); } while (0)
#define STEP(C0, C1, P0, P1, t, MASK, GK, GV, GL) do { SBAR(); \
    const lds_cptr vp_ = vp0 + sl_prev; \
    VRD(0); SBAR(); float sacc = P0[0] + P0[1];                                                                                                       \
                    GAPA(C0 = MFMA(kf[0], qr[0], zero16), P0[2], P0[3], P0[4], P0[5],     pw0[0] = PKW(P0, 0),  pw0[1] = PKW(P0, 2),  pw0); \
    VRD(4); SBAR(); GAPA(C1 = MFMA(kf[1], qr[0], zero16), P0[6], P0[7], P0[8], P0[9],     pw0[2] = PKW(P0, 4),  pw0[3] = PKW(P0, 6),  pw0); \
    VRD(1); SBAR(); GAPA(C0 = MFMA(kf[2], qr[1], C0),    P0[10], P0[11], P0[12], P0[13], pw1[0] = PKW(P0, 8),  pw1[1] = PKW(P0, 10), pw1); \
    VRD(5); SBAR(); GAPA(C1 = MFMA(kf[3], qr[1], C1),    P0[14], P0[15], P1[0], P1[1],   pw1[2] = PKW(P0, 12), pw1[3] = PKW(P0, 14), pw1); \
    VRD(2); SBAR(); GAPA(C0 = MFMA(kf[4], qr[2], C0),    P1[2], P1[3], P1[4], P1[5],     pw2[0] = PKW(P1, 0),  pw2[1] = PKW(P1, 2),  pw2); \
    KAR(t); SBAR();                                                                                                                                    \
    VRD(6); SBAR(); GAPA(C1 = MFMA(kf[5], qr[2], C1),    P1[6], P1[7], P1[8], P1[9],     pw2[2] = PKW(P1, 4),  pw2[3] = PKW(P1, 6),  pw2); \
    VRD(3); SBAR(); GAPA(C0 = MFMA(kf[6], qr[3], C0),    P1[10], P1[11], P1[12], P1[13], pw3[0] = PKW(P1, 8),  pw3[1] = PKW(P1, 10), pw3); \
    VRD(7); SBAR(); GAPA(C1 = MFMA(kf[7], qr[3], C1),    P1[14], P1[15], 0.f, 0.f,       pw3[2] = PKW(P1, 12), pw3[3] = PKW(P1, 14), pw3); \
    C0 = MFMA(KAF(ka0), qaug, C0); C1 = MFMA(KAF(ka1), qaug, C1); SBAR();                                                  \
    l_reg += sacc; \
    if (GK) DMA_K((t) + 3, sl_cur); if (GV) DMA_V((t) + 1, sl_next);                                                       \
    if ((t) <= 3) cmask(C0, C1, 3 - (t), qrel, hi);                                                                         \
    { const float rmx = rowmax(C0, C1), rm = rmx + (mf - mhat); resc = false;                                               \
      if (__builtin_expect(__any(rm > (float)ATTN64_THR), 0)) { const float dl = __builtin_fmaxf(rm, 0.f);                    \
          const float mnew = (mhat < -0.5e30f) ? ((dl > 0.f) ? rmx + mf : mhat) : mhat + dl; \
          const float f = __builtin_amdgcn_exp2f(-dl); l_reg *= f; if (hi == 0) wsf[r32] = f; resc = true; \
          const float mfn = (mnew < -0.5e30f) ? 0.f : mnew, adj = mfn - mf;                                                   \
          _Pragma("unroll") for (int r = 0; r < 16; ++r) { C0[r] -= adj; C1[r] -= adj; } \
          mhat = mnew; mf = mfn; SETQ(); } } \
    SBAR(); \
    GAPB(o[0] = MFMA(PAF(0), VFR(0), o[0]), C0, 0);              GAPB(o[1] = MFMA(PAF(0), VFR(4), o[1]), C0, 4); \
    KRD(GL, 0); GAPB(o[0] = MFMA(PAF(1), VFR(1), o[0]), C0, 8);  KRD(GL, 1); GAPB(o[1] = MFMA(PAF(1), VFR(5), o[1]), C0, 12);                                     \
    KRD(GL, 2); GAPB(o[0] = MFMA(PAF(2), VFR(2), o[0]), C1, 0);  KRD(GL, 3); GAPB(o[1] = MFMA(PAF(2), VFR(6), o[1]), C1, 4); \
    GAPB(o[0] = MFMA(PAF(3), VFR(3), o[0]), C1, 8);              GAPB(o[1] = MFMA(PAF(3), VFR(7), o[1]), C1, 12); \
    } while (0)
    int t = 1;
    for (; t + 5 < NT; t += 2) {
        STEP(pB0, pB1, pA0, pA1, t, false, true, true, true);     WAIT_BAR(2); RESC(); ROT();
        STEP(pA0, pA1, pB0, pB1, t + 1, false, true, true, true); WAIT_BAR(2); RESC(); ROT();
    }
#define ENDW(tt) do { if ((tt) + 3 < NT) { WAIT_BAR(2); } else if ((tt) + 2 < NT) { WAIT_BAR(1); } else { WAIT_BAR(0); } } while (0)
    for (; t + 1 < NT; t += 2) {
        STEP(pB0, pB1, pA0, pA1, t, true, (t + 3 < NT), (t + 1 < NT), (t + 1 < NT));         ENDW(t);     RESC(); ROT();
        STEP(pA0, pA1, pB0, pB1, t + 1, true, (t + 4 < NT), (t + 2 < NT), (t + 2 < NT));     ENDW(t + 1); RESC(); ROT();
    }
    STEP(pB0, pB1, pA0, pA1, NT - 1, true, false, false, false); RESC();
    { float sacc = pB0[0] + pB0[1];
#pragma unroll
      for (int r = 2; r < 16; ++r) sacc += pB0[r];
#pragma unroll
      for (int r = 0; r < 16; ++r) sacc += pB1[r];
      l_reg += sacc;
      pw0 = (u32x4){PKW(pB0, 0), PKW(pB0, 2), PKW(pB0, 4), PKW(pB0, 6)}; pw1 = (u32x4){PKW(pB0, 8), PKW(pB0, 10), PKW(pB0, 12), PKW(pB0, 14)};
      pw2 = (u32x4){PKW(pB1, 0), PKW(pB1, 2), PKW(pB1, 4), PKW(pB1, 6)}; pw3 = (u32x4){PKW(pB1, 8), PKW(pB1, 10), PKW(pB1, 12), PKW(pB1, 14)};
      const lds_cptr vp_ = vp0 + sl_cur; _Pragma("unroll") for (int i = 0; i < 8; ++i) VRD(i);
      o[0] = MFMA(PAF(0), VFR(0), o[0]); o[1] = MFMA(PAF(0), VFR(4), o[1]); o[0] = MFMA(PAF(1), VFR(1), o[0]); o[1] = MFMA(PAF(1), VFR(5), o[1]);
      o[0] = MFMA(PAF(2), VFR(2), o[0]); o[1] = MFMA(PAF(2), VFR(6), o[1]); o[0] = MFMA(PAF(3), VFR(3), o[0]); o[1] = MFMA(PAF(3), VFR(7), o[1]); }
    { auto rr = __builtin_amdgcn_permlane32_swap(__float_as_uint(l_reg), __float_as_uint(l_reg), false, false); l_reg = __uint_as_float(rr[0]) + __uint_as_float(rr[1]); }
    if (hi == 0) wsf[32 + r32] = l_reg; asm volatile("s_waitcnt lgkmcnt(0)" ::: "memory");
    float rli[16];
#pragma unroll
    for (int r = 0; r < 16; ++r) rli[r] = __builtin_amdgcn_rcpf(wsf[32 + crow(r, hi)]);
    bf16* Ow = O + (rowbase + q0 + wid * QBLK) * DM + h * D; bf16* stg = (bf16*)(lds + LDS_OST) + wid * 2048;
#pragma unroll
    for (int r = 0; r < 16; ++r) { const int orow = crow(r, hi);
#pragma unroll
        for (int d0 = 0; d0 < 2; ++d0) stg[orow * 64 + d0 * 32 + r32] = (bf16)(cvtpk(o[d0][r] * rli[r], 0.f) & 0xffffu); }
    asm volatile("s_waitcnt lgkmcnt(0)" ::: "memory");
#pragma unroll
    for (int i = 0; i < 4; ++i) { const int row = i * 8 + (lane >> 3), ch = lane & 7; *(u32x4*)(Ow + (long)row * DM + ch * 8) = *(const u32x4*)(stg + row * 64 + ch * 8); }
    asm volatile("s_waitcnt lgkmcnt(0)\n\ts_barrier" ::: "memory");
#undef DMA_K
#undef DMA_V
#undef ROT
#undef EX
#undef RESC
#undef PKW
#undef PAF
#undef VFR
#undef VRD
#undef KRD
#undef ENDW
#undef GAPA
#undef GAPB
#undef STEP
#undef KAR
#undef KAF
#undef SETQ
#undef EX0
}
#undef SBAR
#undef PIN
#undef MFMA
#undef WAIT_BAR
#undef MX3
__device__ __forceinline__ void run_all(const bf16* Q, const bf16* K, const bf16* V, const bf16* AUG, bf16* O, char* lds) {
    constexpr int NPAIR = NQB / 2;
    for (int i = (int)blockIdx.x; i < kB * NHEAD * NPAIR; i += (int)gridDim.x) {
        const int x = i & 7, kk = i >> 3, bh = x + 8 * (kk / NPAIR), j = kk % NPAIR;
        attn64_unit(bh / NHEAD, bh % NHEAD, NQB - 1 - j, true, Q, K, V, AUG, O, lds);
        attn64_unit(bh / NHEAD, bh % NHEAD, j, false, Q, K, V, AUG, O, lds);
    }
}
}

DI float min2f(float a, float b) { float r; asm("v_min_f32_e32 %0, %1, %2" : "=v"(r) : "v"(a), "v"(b)); return r; }
#define CE_DESC(a, b) do { const float hi_ = max2f(a, b), lo_ = min2f(a, b); a = hi_; b = lo_; } while (0)
template <int N> DI void bitonic_sort_desc(float* v) {
#pragma unroll
    for (int k = 2; k <= N; k <<= 1)
#pragma unroll
        for (int j = k >> 1; j > 0; j >>= 1)
#pragma unroll
            for (int i = 0; i < N; ++i) { const int l = i ^ j; if (l > i) { if ((i & k) == 0) CE_DESC(v[i], v[l]); else CE_DESC(v[l], v[i]); } }
}
DI void sort16_desc(float* v) {
    CE_DESC(v[0], v[13]); CE_DESC(v[1], v[12]); CE_DESC(v[2], v[15]); CE_DESC(v[3], v[14]); CE_DESC(v[4], v[8]); CE_DESC(v[5], v[6]); CE_DESC(v[7], v[11]); CE_DESC(v[9], v[10]);
    CE_DESC(v[0], v[5]); CE_DESC(v[1], v[7]); CE_DESC(v[2], v[9]); CE_DESC(v[3], v[4]); CE_DESC(v[6], v[13]); CE_DESC(v[8], v[14]); CE_DESC(v[10], v[15]); CE_DESC(v[11], v[12]);
    CE_DESC(v[0], v[1]); CE_DESC(v[2], v[3]); CE_DESC(v[4], v[5]); CE_DESC(v[6], v[8]); CE_DESC(v[7], v[9]); CE_DESC(v[10], v[11]); CE_DESC(v[12], v[13]); CE_DESC(v[14], v[15]);
    CE_DESC(v[0], v[2]); CE_DESC(v[1], v[3]); CE_DESC(v[4], v[10]); CE_DESC(v[5], v[11]); CE_DESC(v[6], v[7]); CE_DESC(v[8], v[9]); CE_DESC(v[12], v[14]); CE_DESC(v[13], v[15]);
    CE_DESC(v[1], v[2]); CE_DESC(v[3], v[12]); CE_DESC(v[4], v[6]); CE_DESC(v[5], v[7]); CE_DESC(v[8], v[10]); CE_DESC(v[9], v[11]); CE_DESC(v[13], v[14]);
    CE_DESC(v[1], v[4]); CE_DESC(v[2], v[6]); CE_DESC(v[5], v[8]); CE_DESC(v[7], v[10]); CE_DESC(v[9], v[13]); CE_DESC(v[11], v[14]);
    CE_DESC(v[2], v[4]); CE_DESC(v[3], v[6]); CE_DESC(v[9], v[12]); CE_DESC(v[11], v[13]);
    CE_DESC(v[3], v[5]); CE_DESC(v[6], v[8]); CE_DESC(v[7], v[9]); CE_DESC(v[10], v[12]);
    CE_DESC(v[3], v[4]); CE_DESC(v[5], v[6]); CE_DESC(v[7], v[8]); CE_DESC(v[9], v[10]); CE_DESC(v[11], v[12]);
    CE_DESC(v[6], v[7]); CE_DESC(v[8], v[9]);
}
DI void bitonic_merge16_desc(float* c) {
#pragma unroll
    for (int j = 8; j > 0; j >>= 1)
#pragma unroll
        for (int i = 0; i < 16; ++i) { const int l = i ^ j; if (l > i) CE_DESC(c[i], c[l]); }
}
DI void top16_merge(float* a, const float* b) {
#pragma unroll
    for (int i = 0; i < 16; ++i) a[i] = max2f(a[i], b[15 - i]);
    bitonic_merge16_desc(a);
}
DI void top16_xlane(float* a, int mask) {
    float o[16];
#pragma unroll
    for (int i = 0; i < 16; ++i) o[i] = __shfl_xor(a[i], mask);
    top16_merge(a, o);
}
DI unsigned quad_mov(unsigned v, int ctrl_b1) { return ctrl_b1 ? (unsigned)__builtin_amdgcn_update_dpp(0, (int)v, 0x4E, 0xf, 0xf, false) : (unsigned)__builtin_amdgcn_update_dpp(0, (int)v, 0xB1, 0xf, 0xf, false); }
DI void quad_transpose4(unsigned& v0, unsigned& v1, unsigned& v2, unsigned& v3, bool b0, bool b1) {
    { const unsigned a = b0 ? v0 : v1; const unsigned ap = (unsigned)__builtin_amdgcn_update_dpp(0, (int)a, 0xB1, 0xf, 0xf, false); v0 = b0 ? ap : v0; v1 = b0 ? v1 : ap; }
    { const unsigned a = b0 ? v2 : v3; const unsigned ap = (unsigned)__builtin_amdgcn_update_dpp(0, (int)a, 0xB1, 0xf, 0xf, false); v2 = b0 ? ap : v2; v3 = b0 ? v3 : ap; }
    { const unsigned c0 = b1 ? v0 : v2, c1 = b1 ? v1 : v3;
      const unsigned c0p = (unsigned)__builtin_amdgcn_update_dpp(0, (int)c0, 0x4E, 0xf, 0xf, false), c1p = (unsigned)__builtin_amdgcn_update_dpp(0, (int)c1, 0x4E, 0xf, 0xf, false);
      v0 = b1 ? c0p : v0; v1 = b1 ? c1p : v1; v2 = b1 ? v2 : c0p; v3 = b1 ? v3 : c1p; }
}
template <bool STAGE, bool LOOP>
DI void ph_topk2(const bf16_t* Q, const bf16_t* SKb, int* idx, float* gate, int bid, int nblk, LAS unsigned char* lds) {
    const int tid = VTID, lane = tid & 63, wid = tid >> 6, fr = lane & 15, fq = lane >> 4;
    const int h = bid & 7;
    if (STAGE) {
        const bf16_t* src = SKb + (size_t)h * 2 * 128 * 128;
#pragma unroll 4
        for (int i = 0; i < 16; ++i) {
            const int pc = tid + 256 * i, row = pc >> 4, ch = pc & 15;
            const uint4 v = *(const uint4*)(src + (size_t)row * 128 + ch * 8);
            *(LAS u32x4*)(lds + row * 256 + ((ch ^ (row & 15)) << 4)) = (u32x4){v.x, v.y, v.z, v.w};
        }
    }
    if (STAGE) __syncthreads();
    if (!LOOP) return;
    const int ntile = kT / 16, hw = (bid >> 3) * 4 + wid, nhw = (nblk >> 3) * 4;
    LAS unsigned char* tabb = lds + 65536 + wid * 2304 + lane * 36;
    for (int base = hw; base < ntile; base += 4 * nhw) {
        float L[2][16];
#pragma unroll
        for (int i = 0; i < 16; ++i) { L[0][i] = 0.f; L[1][i] = 0.f; }
#pragma unroll 1
        for (int g = 0; g < 4; ++g) {
            const int tile = base + g * nhw;
            if (tile >= ntile) break;
            const int t0 = tile * 16;
            const bool mine = (fq == g);
#pragma unroll
            for (int p = 0; p < 2; ++p) {
                f32x4 acc[8];
#pragma unroll
                for (int n = 0; n < 8; ++n) acc[n] = (f32x4){0.f, 0.f, 0.f, 0.f};
                const bf16_t* qp = Q + (size_t)(t0 + fr) * 2048 + h * 256 + p * 128 + fq * 8;
#pragma unroll
                for (int ks = 0; ks < 4; ++ks) {
                    const bf16x8 af = *(const bf16x8*)(qp + ks * 32);
#pragma unroll
                    for (int n = 0; n < 8; ++n) { const bf16x8 kf = *(const LAS bf16x8*)(lds + (p * 128 + n * 16 + fr) * 256 + (((ks * 4 + fq) ^ fr) << 4)); acc[n] = __builtin_amdgcn_mfma_f32_16x16x32_bf16(kf, af, acc[n], 0, 0, 0); }
                }
                float v[32];
#pragma unroll
                for (int n = 0; n < 8; ++n)
#pragma unroll
                    for (int j = 0; j < 4; ++j) v[n * 4 + j] = __uint_as_float((__float_as_uint(acc[n][j]) & ~0xffu) | (unsigned)(n * 16 + 4 * fq + j));
                sort16_desc(v); sort16_desc(v + 16);
                top16_merge(v, v + 16);
                top16_xlane(v, 16); top16_xlane(v, 32);
#pragma unroll
                for (int i = 0; i < 16; ++i) L[p][i] = mine ? v[i] : L[p][i];
            }
        }
        const int mytile = base + fq * nhw, t0 = mytile * 16;
#pragma unroll
        for (int i = 0; i < 16; ++i) { tabb[i] = (unsigned char)__float_as_uint(L[0][i]); tabb[16 + i] = (unsigned char)__float_as_uint(L[1][i]); }
        float A_[16], B_[16];
#pragma unroll
        for (int i = 0; i < 16; ++i) { A_[i] = __uint_as_float(__float_as_uint(L[0][i]) & ~0xffu); B_[i] = __uint_as_float(__float_as_uint(L[1][i]) & ~0xffu); }
#define SK(a, b) __uint_as_float((__float_as_uint(A_[a] + B_[b]) & ~0xffu) | (unsigned)((a) * 16 + (b)))
        float m1[16], x[16], w[16];
        m1[0] = SK(0, 0);
        m1[1] = SK(0, 1);
        m1[2] = SK(0, 2);
        m1[3] = SK(0, 3);
        m1[4] = SK(0, 4);
        m1[5] = SK(0, 5);
        m1[6] = SK(0, 6);
        m1[7] = SK(0, 7);
        m1[8] = SK(0, 8);
        m1[9] = SK(0, 9);
        m1[10] = SK(0, 10);
        m1[11] = SK(0, 11);
        m1[12] = SK(0, 12);
        m1[13] = SK(0, 13);
        m1[14] = SK(0, 14);
        m1[15] = SK(0, 15);
        m1[1] = max2f(m1[1], SK(15, 0));
        m1[2] = max2f(m1[2], SK(14, 0));
        m1[3] = max2f(m1[3], SK(13, 0));
        m1[4] = max2f(m1[4], SK(12, 0));
        m1[5] = max2f(m1[5], SK(11, 0));
        m1[6] = max2f(m1[6], SK(10, 0));
        m1[7] = max2f(m1[7], SK(9, 0));
        m1[8] = max2f(m1[8], SK(8, 0));
        m1[9] = max2f(m1[9], SK(7, 0));
        m1[10] = max2f(m1[10], SK(6, 0));
        m1[11] = max2f(m1[11], SK(5, 0));
        m1[12] = max2f(m1[12], SK(4, 0));
        m1[13] = max2f(m1[13], SK(3, 0));
        m1[14] = max2f(m1[14], SK(2, 0));
        m1[15] = max2f(m1[15], SK(1, 0));
        CE_DESC(m1[0], m1[8]);
        CE_DESC(m1[1], m1[9]);
        CE_DESC(m1[2], m1[10]);
        CE_DESC(m1[3], m1[11]);
        CE_DESC(m1[4], m1[12]);
        CE_DESC(m1[5], m1[13]);
        CE_DESC(m1[6], m1[14]);
        CE_DESC(m1[7], m1[15]);
        CE_DESC(m1[0], m1[4]);
        CE_DESC(m1[1], m1[5]);
        CE_DESC(m1[2], m1[6]);
        CE_DESC(m1[3], m1[7]);
        CE_DESC(m1[8], m1[12]);
        CE_DESC(m1[9], m1[13]);
        CE_DESC(m1[10], m1[14]);
        CE_DESC(m1[11], m1[15]);
        CE_DESC(m1[0], m1[2]);
        CE_DESC(m1[1], m1[3]);
        CE_DESC(m1[4], m1[6]);
        CE_DESC(m1[5], m1[7]);
        CE_DESC(m1[8], m1[10]);
        CE_DESC(m1[9], m1[11]);
        CE_DESC(m1[12], m1[14]);
        CE_DESC(m1[13], m1[15]);
        CE_DESC(m1[0], m1[1]);
        CE_DESC(m1[2], m1[3]);
        CE_DESC(m1[4], m1[5]);
        CE_DESC(m1[6], m1[7]);
        CE_DESC(m1[8], m1[9]);
        CE_DESC(m1[10], m1[11]);
        CE_DESC(m1[12], m1[13]);
        CE_DESC(m1[14], m1[15]);
        x[0] = SK(1, 1);
        x[1] = SK(1, 2);
        x[2] = SK(1, 3);
        x[3] = SK(1, 4);
        x[4] = SK(1, 5);
        x[5] = SK(1, 6);
        x[6] = SK(1, 7);
        x[7] = -1e30f;
        x[8] = -1e30f;
        x[9] = -1e30f;
        x[10] = SK(7, 1);
        x[11] = SK(6, 1);
        x[12] = SK(5, 1);
        x[13] = SK(4, 1);
        x[14] = SK(3, 1);
        x[15] = SK(2, 1);
        CE_DESC(x[2], x[10]);
        CE_DESC(x[3], x[11]);
        CE_DESC(x[4], x[12]);
        CE_DESC(x[5], x[13]);
        CE_DESC(x[6], x[14]);
        { const float t_ = x[7]; x[7] = x[15]; x[15] = t_; }
        CE_DESC(x[0], x[4]);
        CE_DESC(x[1], x[5]);
        CE_DESC(x[2], x[6]);
        CE_DESC(x[3], x[7]);
        { const float t_ = x[8]; x[8] = x[12]; x[12] = t_; }
        { const float t_ = x[9]; x[9] = x[13]; x[13] = t_; }
        CE_DESC(x[10], x[14]);
        CE_DESC(x[0], x[2]);
        CE_DESC(x[1], x[3]);
        CE_DESC(x[4], x[6]);
        CE_DESC(x[5], x[7]);
        CE_DESC(x[8], x[10]);
        CE_DESC(x[9], x[11]);
        { const float t_ = x[12]; x[12] = x[14]; x[14] = t_; }
        CE_DESC(x[0], x[1]);
        CE_DESC(x[2], x[3]);
        CE_DESC(x[4], x[5]);
        CE_DESC(x[6], x[7]);
        CE_DESC(x[8], x[9]);
        CE_DESC(x[10], x[11]);
        float yp = SK(2, 2), q1 = SK(2, 3), q2 = SK(2, 4), r1 = SK(3, 2), r2 = SK(4, 2), yu = SK(3, 3);
        CE_DESC(q1, r1); CE_DESC(q2, r2); CE_DESC(r1, q2); CE_DESC(r2, yu); CE_DESC(q2, r2);
        w[0] = 1e30f;
        w[1] = 1e30f;
        w[2] = 1e30f;
        w[3] = x[0];
        w[4] = x[1];
        w[5] = x[2];
        w[6] = x[3];
        w[7] = x[4];
        w[8] = x[5];
        w[9] = x[6];
        w[10] = max2f(x[7], yu);
        w[11] = max2f(x[8], r2);
        w[12] = max2f(x[9], q2);
        w[13] = max2f(x[10], r1);
        w[14] = max2f(x[11], q1);
        w[15] = max2f(x[12], yp);
        CE_DESC(w[3], w[11]);
        CE_DESC(w[4], w[12]);
        CE_DESC(w[5], w[13]);
        CE_DESC(w[6], w[14]);
        CE_DESC(w[7], w[15]);
        CE_DESC(w[3], w[7]);
        CE_DESC(w[8], w[12]);
        CE_DESC(w[9], w[13]);
        CE_DESC(w[10], w[14]);
        CE_DESC(w[11], w[15]);
        CE_DESC(w[4], w[6]);
        CE_DESC(w[5], w[7]);
        CE_DESC(w[8], w[10]);
        CE_DESC(w[9], w[11]);
        CE_DESC(w[12], w[14]);
        CE_DESC(w[13], w[15]);
        CE_DESC(w[4], w[5]);
        CE_DESC(w[6], w[7]);
        CE_DESC(w[8], w[9]);
        CE_DESC(w[10], w[11]);
        CE_DESC(w[12], w[13]);
        CE_DESC(w[14], w[15]);
        m1[3] = max2f(m1[3], w[15]);
        m1[4] = max2f(m1[4], w[14]);
        m1[5] = max2f(m1[5], w[13]);
        m1[6] = max2f(m1[6], w[12]);
        m1[7] = max2f(m1[7], w[11]);
        m1[8] = max2f(m1[8], w[10]);
        m1[9] = max2f(m1[9], w[9]);
        m1[10] = max2f(m1[10], w[8]);
        m1[11] = max2f(m1[11], w[7]);
        m1[12] = max2f(m1[12], w[6]);
        m1[13] = max2f(m1[13], w[5]);
        m1[14] = max2f(m1[14], w[4]);
        m1[15] = max2f(m1[15], w[3]);
        CE_DESC(m1[0], m1[8]);
        CE_DESC(m1[1], m1[9]);
        CE_DESC(m1[2], m1[10]);
        CE_DESC(m1[3], m1[11]);
        CE_DESC(m1[4], m1[12]);
        CE_DESC(m1[5], m1[13]);
        CE_DESC(m1[6], m1[14]);
        CE_DESC(m1[7], m1[15]);
        CE_DESC(m1[0], m1[4]);
        CE_DESC(m1[1], m1[5]);
        CE_DESC(m1[2], m1[6]);
        CE_DESC(m1[3], m1[7]);
        CE_DESC(m1[8], m1[12]);
        CE_DESC(m1[9], m1[13]);
        CE_DESC(m1[10], m1[14]);
        CE_DESC(m1[11], m1[15]);
        CE_DESC(m1[0], m1[2]);
        CE_DESC(m1[1], m1[3]);
        CE_DESC(m1[4], m1[6]);
        CE_DESC(m1[5], m1[7]);
        CE_DESC(m1[8], m1[10]);
        CE_DESC(m1[9], m1[11]);
        CE_DESC(m1[12], m1[14]);
        CE_DESC(m1[13], m1[15]);
        CE_DESC(m1[0], m1[1]);
        CE_DESC(m1[2], m1[3]);
        CE_DESC(m1[4], m1[5]);
        CE_DESC(m1[6], m1[7]);
        CE_DESC(m1[8], m1[9]);
        CE_DESC(m1[10], m1[11]);
        CE_DESC(m1[12], m1[13]);
        CE_DESC(m1[14], m1[15]);
#undef SK
        float* const c = m1;
        float e[16]; int id[16]; float sum = 0.f;
        const float mx = __uint_as_float(__float_as_uint(c[0]) & ~0xffu);
#pragma unroll
        for (int r = 0; r < 16; ++r) {
            const unsigned bits = __float_as_uint(c[r]); const int a = (bits >> 4) & 15, b = bits & 15;
            id[r] = (int)((unsigned)tabb[a] * 128u + (unsigned)tabb[16 + b]);
            e[r] = __builtin_amdgcn_exp2f((__uint_as_float(bits & ~0xffu) - mx) * kLog2e); sum += e[r];
        }
        const float inv = 1.f / sum;
        unsigned xi[16], xg[16];
#pragma unroll
        for (int r = 0; r < 16; ++r) { xi[r] = (unsigned)id[r]; xg[r] = __float_as_uint(e[r] * inv); }
        { const bool qb0 = (fr & 1) != 0, qb1 = (fr & 2) != 0;
#pragma unroll
          for (int j = 0; j < 4; ++j) { quad_transpose4(xi[j], xi[4 + j], xi[8 + j], xi[12 + j], qb0, qb1); quad_transpose4(xg[j], xg[4 + j], xg[8 + j], xg[12 + j], qb0, qb1); } }
        if (mytile < ntile) {
            int* ip = idx + (size_t)(t0 + (fr & ~3)) * 128 + h * 16 + (fr & 3) * 4; float* gp = gate + (size_t)(t0 + (fr & ~3)) * 128 + h * 16 + (fr & 3) * 4;
#pragma unroll
            for (int r = 0; r < 4; ++r) { *(uint4*)(ip + r * 128) = make_uint4(xi[4 * r], xi[4 * r + 1], xi[4 * r + 2], xi[4 * r + 3]); *(uint4*)(gp + r * 128) = make_uint4(xg[4 * r], xg[4 * r + 1], xg[4 * r + 2], xg[4 * r + 3]); }
        }
    }
}

typedef int i32x4 __attribute__((ext_vector_type(4)));
template <int SLICED> DI void ph_quant_rows(const float* src, const float* colscale, unsigned char* dst, float* scale, int bias, int bid, int nblk) {
    const int wid = VTID >> 6, lane = VTID & 63;
    for (int row0 = (bid * 4 + wid) * 2; row0 < 16384; row0 += nblk * 8) {
        float4 v[2][4];
#pragma unroll
        for (int r = 0; r < 2; ++r)
#pragma unroll
            for (int i = 0; i < 4; ++i) v[r][i] = ((const float4*)(src + (size_t)(row0 + r) * kD))[lane + 64 * i];
#pragma unroll
        for (int r = 0; r < 2; ++r) {
            const int row = row0 + r; float m = 0.f;
#pragma unroll
            for (int i = 0; i < 4; ++i) {
                if (colscale) { const float4 sc = ((const float4*)colscale)[lane + 64 * i]; v[r][i].x *= sc.x; v[r][i].y *= sc.y; v[r][i].z *= sc.z; v[r][i].w *= sc.w; }
                m = fmaxf(m, fmaxf(fmaxf(fabsf(v[r][i].x), fabsf(v[r][i].y)), fmaxf(fabsf(v[r][i].z), fabsf(v[r][i].w))));
            }
            m = wave_max(m);
            const float inv = (m > 0.f) ? 127.f / m : 0.f;
#pragma unroll
            for (int i = 0; i < 4; ++i) {
                const int a = (int)rintf(v[r][i].x * inv) + bias, b = (int)rintf(v[r][i].y * inv) + bias, c = (int)rintf(v[r][i].z * inv) + bias, d = (int)rintf(v[r][i].w * inv) + bias;
                const unsigned pk_ = (unsigned)(a & 0xff) | ((unsigned)(b & 0xff) << 8) | ((unsigned)(c & 0xff) << 16) | ((unsigned)(d & 0xff) << 24);
                const int col_ = (lane + 64 * i) * 4;
                if (SLICED) *(unsigned*)(dst + ((size_t)(col_ >> 7) * 16384 + row) * 128 + (col_ & 127)) = pk_;
                else ((unsigned*)(dst + (size_t)row * kD))[lane + 64 * i] = pk_;
            }
            if (lane == 0) scale[row] = (m > 0.f) ? m * (1.0f / 127.f) : 1.f;
        }
    }
}
DI float gelu_fast(float v) {
    const float av = fabsf(v), t = __builtin_amdgcn_rcpf(av * 0.2316418882f + 1.0f);
    float q = t * 0.5307027145f + (-0.7265760135f); q = q * t + 0.7107068705f; q = q * t + (-0.142248368f); q = q * t + 0.127414796f; q = q * t;
    const float m = v * (q * __builtin_amdgcn_exp2f((v * v) * (-0.72134752044f)));
    return v < 0.f ? m : v - m;
}
constexpr int EXW_BYTES = 19584;
constexpr int EX6_LIST = 8192, EX6_TOT = EX6_LIST + 4096, EX6_SXR = EX6_TOT + 4096;
DI void ph_exp_u7(const bf16_t* Hb, const float* SSQ, const unsigned char* U8, const float* su, const float* sv, const int* idx, const float* gate, float* abuf,
                  int bid, int nblk, LAS unsigned char* lds) {
    const int tid = VTID, lane = tid & 63, wid = tid >> 6, fr = lane & 15;
    LAS unsigned char* wl = lds + wid * EXW_BYTES;
    LAS unsigned* list = (LAS unsigned*)(wl + EX6_LIST); LAS int* tot = (LAS int*)(wl + EX6_TOT); LAS float* sxr = (LAS float*)(wl + EX6_SXR);
    const unsigned long long lt = (1ull << lane) - 1ull;
    const unsigned lane16 = (unsigned)lane * 16u;
    for (int tg = bid * 4 + wid; tg < kT / 8; tg += nblk * 4) {
        const int t0 = tg * 8;
#pragma unroll 4
        for (int tl = 0; tl < 8; ++tl) {
            const size_t t = (size_t)(t0 + tl);
            const uint4 x0 = *(const uint4*)(Hb + t * kD + lane * 8), x1 = *(const uint4*)(Hb + t * kD + 512 + lane * 8);
            float sq = SSQ[t * 16 + fr];
            float xf[16];
            { const unsigned ww[8] = {x0.x, x0.y, x0.z, x0.w, x1.x, x1.y, x1.z, x1.w};
#pragma unroll
              for (int j = 0; j < 8; ++j) { xf[2 * j] = __uint_as_float(ww[j] << 16); xf[2 * j + 1] = __uint_as_float(ww[j] & 0xffff0000u); } }
            float m = 0.f;
#pragma unroll
            for (int j = 0; j < 16; ++j) m = fmaxf(m, fabsf(xf[j]));
            m = wave_max(m);
            const float inv = (m > 0.f) ? 127.f / m : 0.f;
            unsigned pk[4];
#pragma unroll
            for (int j = 0; j < 4; ++j) {
                const int a = (int)rintf(xf[4 * j] * inv), b = (int)rintf(xf[4 * j + 1] * inv), c = (int)rintf(xf[4 * j + 2] * inv), d = (int)rintf(xf[4 * j + 3] * inv);
                pk[j] = (unsigned)(a & 0xff) | ((unsigned)(b & 0xff) << 8) | ((unsigned)(c & 0xff) << 16) | ((unsigned)(d & 0xff) << 24);
            }
            *(LAS u32x2*)(wl + tl * 1024 + lane * 8) = (u32x2){pk[0], pk[1]}; *(LAS u32x2*)(wl + tl * 1024 + 512 + lane * 8) = (u32x2){pk[2], pk[3]};
            sq += __shfl_xor(sq, 1); sq += __shfl_xor(sq, 2); sq += __shfl_xor(sq, 4); sq += __shfl_xor(sq, 8);
            if (lane == 0) sxr[tl] = m * (1.0f / 127.f) / sqrtf(sq * (1.0f / kD) + kEps);
        }
        {
            int ev[16];
#pragma unroll
            for (int k = 0; k < 8; ++k) { const size_t t = (size_t)(t0 + k); ev[2 * k] = idx[t * 128 + lane]; ev[2 * k + 1] = idx[t * 128 + 64 + lane]; }
            int n = 0;
#pragma unroll 1
            for (int r = 0; r < 8; ++r) {
#pragma unroll
                for (int k = 0; k < 16; ++k) {
                    const bool in = (ev[k] >> 11) == r;
                    const unsigned long long b = __ballot(in);
                    if (in) list[n + __popcll(b & lt)] = (unsigned)ev[k] | ((unsigned)(k >> 1) << 14) | ((unsigned)((k & 1) * 64 + lane) << 18);
                    n += __popcll(b);
                }
            }
        }
#define EU7_LOAD(ub, en, sb_) do { const unsigned lv_ = list[min((sb_) * 8 + (lane & 7), 1023)]; \
            _Pragma("unroll") for (int j_ = 0; j_ < 8; ++j_) { en[j_] = (unsigned)__builtin_amdgcn_readlane((int)lv_, j_); \
                ub[j_] = *(const uint4*)(U8 + (size_t)(en[j_] & 16383u) * kD + lane16); } } while (0)
#define EU7_COMP(ub, en, sb_) do { i32x4 xq_[8]; int p_[8]; \
            _Pragma("unroll") for (int j_ = 0; j_ < 8; ++j_) xq_[j_] = *(const LAS i32x4*)(wl + ((en[j_] >> 14) & 7u) * 1024u + lane16); \
            _Pragma("unroll") for (int j_ = 0; j_ < 8; ++j_) p_[j_] = __builtin_amdgcn_sdot4((int)ub[j_].x, xq_[j_][0], 0, false); \
            _Pragma("unroll") for (int j_ = 0; j_ < 8; ++j_) p_[j_] = __builtin_amdgcn_sdot4((int)ub[j_].y, xq_[j_][1], p_[j_], false); \
            _Pragma("unroll") for (int j_ = 0; j_ < 8; ++j_) p_[j_] = __builtin_amdgcn_sdot4((int)ub[j_].z, xq_[j_][2], p_[j_], false); \
            _Pragma("unroll") for (int j_ = 0; j_ < 8; ++j_) p_[j_] = __builtin_amdgcn_sdot4((int)ub[j_].w, xq_[j_][3], p_[j_], false); \
            _Pragma("unroll") for (int j_ = 0; j_ < 4; ++j_) { \
                const int hi_ = p_[j_ + 4] + __builtin_amdgcn_update_dpp(0, p_[j_ + 4], 0x114, 0xF, 0xF, true), lo_ = p_[j_] + __builtin_amdgcn_update_dpp(0, p_[j_], 0x104, 0xF, 0xF, true); \
                p_[j_] = (lane & 4) ? hi_ : lo_; } \
            _Pragma("unroll") for (int j_ = 0; j_ < 2; ++j_) { \
                const int hi_ = p_[j_ + 2] + __builtin_amdgcn_update_dpp(0, p_[j_ + 2], 0x4E, 0xF, 0xF, true), lo_ = p_[j_] + __builtin_amdgcn_update_dpp(0, p_[j_], 0x4E, 0xF, 0xF, true); \
                p_[j_] = (lane & 2) ? hi_ : lo_; } \
            { const int hi_ = p_[1] + __builtin_amdgcn_update_dpp(0, p_[1], 0xB1, 0xF, 0xF, true), lo_ = p_[0] + __builtin_amdgcn_update_dpp(0, p_[0], 0xB1, 0xF, 0xF, true); \
              p_[0] = (lane & 1) ? hi_ : lo_; } \
            int s_ = p_[0] + __builtin_amdgcn_update_dpp(0, p_[0], 0x128, 0xF, 0xF, true); \
            { const auto r_ = __builtin_amdgcn_permlane16_swap((unsigned)s_, (unsigned)s_, false, false); s_ = (int)(r_[0] + r_[1]); } \
            { const auto r_ = __builtin_amdgcn_permlane32_swap((unsigned)s_, (unsigned)s_, false, false); s_ = (int)(r_[0] + r_[1]); } \
            if (lane < 8) tot[(sb_) * 8 + lane] = s_; } while (0)
        uint4 uA[8], uB[8], uC[8]; unsigned eA[8], eB[8], eC[8];
        EU7_LOAD(uA, eA, 0); __builtin_amdgcn_sched_barrier(0); EU7_LOAD(uB, eB, 1); __builtin_amdgcn_sched_barrier(0);
#pragma unroll 1
        for (int sb = 0; sb < 128; sb += 3) {
            EU7_LOAD(uC, eC, sb + 2); EU7_COMP(uA, eA, sb);
            EU7_LOAD(uA, eA, sb + 3); if (sb + 1 < 128) EU7_COMP(uB, eB, sb + 1);
            EU7_LOAD(uB, eB, sb + 4); if (sb + 2 < 128) EU7_COMP(uC, eC, sb + 2);
        }
#undef EU7_LOAD
#undef EU7_COMP
#pragma unroll
        for (int q4 = 0; q4 < 4; ++q4) { const int f_ = (q4 * 64 + lane) * 4; const uint4 g_ = *(const uint4*)(gate + (size_t)t0 * 128 + f_); *(LAS u32x4*)(wl + 4096 + f_ * 4) = (u32x4){g_.x, g_.y, g_.z, g_.w}; }
#pragma unroll 1
        for (int i0 = lane; i0 < 1024; i0 += 512) {
            float su8[8], sv8[8], g8[8]; unsigned en8[8];
#pragma unroll
            for (int q = 0; q < 8; ++q) {
                en8[q] = list[i0 + 64 * q]; const int e = en8[q] & 16383;
                su8[q] = su[e]; sv8[q] = sv[e]; g8[q] = *(const LAS float*)(wl + 4096 + ((((en8[q] >> 14) & 7) * 128 + (en8[q] >> 18)) * 4));
            }
#pragma unroll
            for (int q = 0; q < 8; ++q) {
                const int tl = (en8[q] >> 14) & 7, slot = en8[q] >> 18;
                const float sdot = (float)tot[i0 + 64 * q] * (su8[q] * sxr[tl]);
                *(LAS float*)(wl + (tl * 128 + slot) * 4) = gelu_fast(sdot) * g8[q] * sv8[q];
            }
        }
#pragma unroll
        for (int q4 = 0; q4 < 4; ++q4) { const int f_ = (q4 * 64 + lane) * 4; const u32x4 v_ = *(const LAS u32x4*)(wl + f_ * 4); *(uint4*)(abuf + (size_t)t0 * 128 + f_) = make_uint4(v_[0], v_[1], v_[2], v_[3]); }
    }
}
DI void tr4x4(unsigned r0, unsigned r1, unsigned r2, unsigned r3, unsigned (&c)[4]) {
    const unsigned t0 = __builtin_amdgcn_perm(r1, r0, 0x05010400u), t1 = __builtin_amdgcn_perm(r1, r0, 0x07030602u);
    const unsigned t2 = __builtin_amdgcn_perm(r3, r2, 0x05010400u), t3 = __builtin_amdgcn_perm(r3, r2, 0x07030602u);
    c[0] = __builtin_amdgcn_perm(t2, t0, 0x05040100u); c[1] = __builtin_amdgcn_perm(t2, t0, 0x07060302u);
    c[2] = __builtin_amdgcn_perm(t3, t1, 0x05040100u); c[3] = __builtin_amdgcn_perm(t3, t1, 0x07060302u);
}
constexpr int EV8_ACC = 0, EV8_LIST = 16384, EV8_SA = EV8_LIST + 2560;
DI void ph_exp_v8(const bf16_t* Hres, const unsigned char* V8, const int* idx, const float* abuf, const float* nlw, float* out, int bid, int nblk, LAS unsigned char* lds) {
    const int tid = VTID, lane = tid & 63, wid = tid >> 6;
    LAS unsigned char* wl = lds + wid * EXW_BYTES;
    LAS unsigned* list = (LAS unsigned*)(wl + EV8_LIST); LAS float* sal = (LAS float*)(wl + EV8_SA); LAS int* acc = (LAS int*)(wl + EV8_ACC);
    const unsigned long long lt = (1ull << lane) - 1ull;
    const unsigned lane16 = (unsigned)lane * 16u;
    for (int tg = bid * 4 + wid; tg < kT / 4; tg += nblk * 4) {
        const int t0 = tg * 4;
        int n = 0;
        {
            int ev[8], a8[8];
#pragma unroll
            for (int tl = 0; tl < 4; ++tl) {
                const size_t t = (size_t)(t0 + tl);
                const float a0 = abuf[t * 128 + lane], a1 = abuf[t * 128 + 64 + lane];
                ev[2 * tl] = idx[t * 128 + lane]; ev[2 * tl + 1] = idx[t * 128 + 64 + lane];
                const float m = wave_max(fmaxf(fabsf(a0), fabsf(a1)));
                const float inv = (m > 0.f) ? 127.f / m : 0.f;
                a8[2 * tl] = (int)rintf(a0 * inv); a8[2 * tl + 1] = (int)rintf(a1 * inv);
                if (lane == 0) sal[tl] = m * (1.0f / 127.f);
#pragma unroll
                for (int q = 0; q < 4; ++q) *(LAS u32x4*)(wl + EV8_ACC + tl * 4096 + q * 1024 + lane16) = (u32x4){0u, 0u, 0u, 0u};
            }
#pragma unroll 1
            for (int r = 0; r < 8; ++r) {
#pragma unroll
                for (int k = 0; k < 8; ++k) {
                    const bool in = (ev[k] >> 11) == r;
                    const unsigned long long b = __ballot(in);
                    if (in) list[n + __popcll(b & lt)] = (unsigned)ev[k] | ((unsigned)(k >> 1) << 14) | ((unsigned)(a8[k] & 0xff) << 16);
                    n += __popcll(b);
                    if (k & 1) { const int pad = (-n) & 3; if (lane < pad) list[n + lane] = ((unsigned)r << 11) | ((unsigned)(k >> 1) << 14); n += pad; }
                }
            }
        }
        int yi[16];
#pragma unroll
        for (int j = 0; j < 16; ++j) yi[j] = 0;
        int cur = 0;
        const int nsb = (n + 7) >> 3, last = n - 1;
#define EV8_FLUSH() do { _Pragma("unroll") for (int j_ = 0; j_ < 16; ++j_) { atomicAdd((int*)(acc + cur * 1024 + j_ * 64 + lane), yi[j_]); yi[j_] = 0; } } while (0)
#define EV8_LOAD(ub, en, sb_) do { const int i_ = (sb_) * 8 + (lane & 7); unsigned lv_ = list[min(i_, last)]; lv_ = (i_ > last) ? (lv_ & 0xff00ffffu) : lv_; \
            _Pragma("unroll") for (int j_ = 0; j_ < 8; ++j_) { en[j_] = (unsigned)__builtin_amdgcn_readlane((int)lv_, j_); \
                ub[j_] = *(const uint4*)(V8 + (size_t)(en[j_] & 16383u) * kD + lane16); } } while (0)
#define EV8_COMP(ub, en) do { _Pragma("unroll") for (int h_ = 0; h_ < 2; ++h_) { \
            const int tlh_ = (int)((en[4 * h_] >> 14) & 3u); \
            if (tlh_ != cur) { EV8_FLUSH(); cur = tlh_; } \
            const int aw_ = (int)(((en[4 * h_] >> 16) & 0xffu) | (((en[4 * h_ + 1] >> 16) & 0xffu) << 8) | (((en[4 * h_ + 2] >> 16) & 0xffu) << 16) | ((en[4 * h_ + 3] >> 16) << 24)); \
            unsigned c_[4]; \
            tr4x4(ub[4 * h_].x, ub[4 * h_ + 1].x, ub[4 * h_ + 2].x, ub[4 * h_ + 3].x, c_); \
            _Pragma("unroll") for (int k_ = 0; k_ < 4; ++k_) yi[k_] = __builtin_amdgcn_sdot4((int)c_[k_], aw_, yi[k_], false); \
            tr4x4(ub[4 * h_].y, ub[4 * h_ + 1].y, ub[4 * h_ + 2].y, ub[4 * h_ + 3].y, c_); \
            _Pragma("unroll") for (int k_ = 0; k_ < 4; ++k_) yi[4 + k_] = __builtin_amdgcn_sdot4((int)c_[k_], aw_, yi[4 + k_], false); \
            tr4x4(ub[4 * h_].z, ub[4 * h_ + 1].z, ub[4 * h_ + 2].z, ub[4 * h_ + 3].z, c_); \
            _Pragma("unroll") for (int k_ = 0; k_ < 4; ++k_) yi[8 + k_] = __builtin_amdgcn_sdot4((int)c_[k_], aw_, yi[8 + k_], false); \
            tr4x4(ub[4 * h_].w, ub[4 * h_ + 1].w, ub[4 * h_ + 2].w, ub[4 * h_ + 3].w, c_); \
            _Pragma("unroll") for (int k_ = 0; k_ < 4; ++k_) yi[12 + k_] = __builtin_amdgcn_sdot4((int)c_[k_], aw_, yi[12 + k_], false); } } while (0)
        uint4 uA[8], uB[8], uC[8]; unsigned eA[8], eB[8], eC[8];
        EV8_LOAD(uA, eA, 0); __builtin_amdgcn_sched_barrier(0); EV8_LOAD(uB, eB, 1); __builtin_amdgcn_sched_barrier(0);
#pragma unroll 1
        for (int sb = 0; sb < nsb; sb += 3) {
            EV8_LOAD(uC, eC, sb + 2); EV8_COMP(uA, eA);
            EV8_LOAD(uA, eA, sb + 3); if (sb + 1 < nsb) EV8_COMP(uB, eB);
            EV8_LOAD(uB, eB, sb + 4); if (sb + 2 < nsb) EV8_COMP(uC, eC);
        }
        EV8_FLUSH();
#undef EV8_LOAD
#undef EV8_COMP
#undef EV8_FLUSH
        uint2 hres[4][4];
#pragma unroll
        for (int tl = 0; tl < 4; ++tl)
#pragma unroll
            for (int q = 0; q < 4; ++q) hres[tl][q] = *(const uint2*)(Hres + (size_t)(t0 + tl) * kD + q * 256 + lane * 4);
#pragma unroll
        for (int tl = 0; tl < 4; ++tl) {
            const size_t t = (size_t)(t0 + tl);
            const float sa = sal[tl];
            float y[16]; float ss = 0.f;
#pragma unroll
            for (int q = 0; q < 4; ++q) {
                const unsigned hw0 = hres[tl][q].x, hw1 = hres[tl][q].y;
                const float hv[4] = {__uint_as_float(hw0 << 16), __uint_as_float(hw0 & 0xffff0000u), __uint_as_float(hw1 << 16), __uint_as_float(hw1 & 0xffff0000u)};
#pragma unroll
                for (int jj = 0; jj < 4; ++jj) { y[4 * q + jj] = (float)acc[tl * 1024 + ((lane & 3) * 4 + jj) * 64 + q * 16 + (lane >> 2)] * sa + hv[jj]; ss += y[4 * q + jj] * y[4 * q + jj]; }
            }
            ss += __shfl_xor(ss, 1); ss += __shfl_xor(ss, 2); ss += __shfl_xor(ss, 4); ss += __shfl_xor(ss, 8); ss += __shfl_xor(ss, 16); ss += __shfl_xor(ss, 32);
            const float rr = 1.0f / sqrtf(ss * (1.0f / kD) + kEps);
#pragma unroll
            for (int q = 0; q < 4; ++q) {
                const float4 w4 = *(const float4*)(nlw + q * 256 + lane * 4);
                *(float4*)(out + t * kD + q * 256 + lane * 4) = make_float4(y[4 * q] * rr * w4.x, y[4 * q + 1] * rr * w4.y, y[4 * q + 2] * rr * w4.z, y[4 * q + 3] * rr * w4.w);
            }
        }
    }
}

constexpr int EPI_LDS_OFF = 131072, EPI_LDS_WAVE = 2048;
DI void epi_strip(const f32x4& a0, const f32x4& a1, LAS unsigned char* wl, int fr, int fq, f32x4& v0, f32x4& v1) {
    *(LAS f32x4*)(wl + fr * 128 + (((0 + fq) ^ (fr & 7)) << 4)) = a0;
    *(LAS f32x4*)(wl + fr * 128 + (((4 + fq) ^ (fr & 7)) << 4)) = a1;
    const int lane = fr + 16 * fq, r = lane >> 2, c = lane & 3;
    v0 = *(const LAS f32x4*)(wl + r * 128 + (((2 * c) ^ (r & 7)) << 4));
    v1 = *(const LAS f32x4*)(wl + r * 128 + (((2 * c + 1) ^ (r & 7)) << 4));
}
struct Epi8Proj {
    static constexpr bool PERM = false, AFTER_DRAIN = false;
    ProjOut o; const float* sw; LAS unsigned char* lds_epi;
    template <int KIND> DI void half(const pg8::i32x4 (&acc)[2][2][4][2], int bj, int rowb  , int colp  , int cl0  , bf16_t* dst, float sc, int fr, int fq, LAS unsigned char* wl) const {
        const int lane = fr + 16 * fq, r = lane >> 2, cl = cl0 + 8 * (lane & 3);
        float lb[8] = {0.f, 0.f, 0.f, 0.f, 0.f, 0.f, 0.f, 0.f};
        if (KIND == 1) {
#pragma unroll
            for (int j = 0; j < 8; ++j) lb[j] = fsigmoid(o.lbl[cl + j] - o.lbl[512 + cl + j]);
        }
        const f32x4 sw0 = *(const f32x4*)(sw + colp + 8 * (lane & 3)), sw1 = *(const f32x4*)(sw + colp + 8 * (lane & 3) + 4);
        float rsn = o.rs1[rowb + r];
#pragma unroll
        for (int ai = 0; ai < 2; ++ai)
#pragma unroll
            for (int m = 0; m < 4; ++m) {
                f32x4 v0, v1;
                epi_strip(__builtin_convertvector(ai == 0 ? acc[0][bj][m][0] : acc[1][bj][m][0], f32x4), __builtin_convertvector(ai == 0 ? acc[0][bj][m][1] : acc[1][bj][m][1], f32x4), wl, fr, fq, v0, v1);
                const int row = rowb + ai * 128 + m * 16 + r;
                const float rs = rsn * (sc * (1.0f / 127.f));
                { const int nb_ = ai * 4 + m + 1; if (nb_ < 8) rsn = o.rs1[rowb + (nb_ >> 2) * 128 + (nb_ & 3) * 16 + r]; }
                v0 = v0 * sw0 * rs; v1 = v1 * sw1 * rs;
                if (KIND == 0) { for (int j = 0; j < 4; ++j) { v0[j] = v0[j] * fsigmoid(v0[j]); v1[j] = v1[j] * fsigmoid(v1[j]); } store_bf8((bf16_t*)((unsigned char*)dst + (size_t)(unsigned)((row * 512 + cl) * 2)), v0, v1); }
                else if (KIND == 1) { for (int j = 0; j < 4; ++j) { v0[j] = __builtin_amdgcn_logf(lb[j] + (1.f - lb[j]) * __builtin_amdgcn_rcpf(1.f + __builtin_amdgcn_exp2f(v0[j]))); v1[j] = __builtin_amdgcn_logf(lb[4 + j] + (1.f - lb[4 + j]) * __builtin_amdgcn_rcpf(1.f + __builtin_amdgcn_exp2f(v1[j]))); }
                    store_bf8((bf16_t*)((unsigned char*)dst + (size_t)(unsigned)((row * 512 + cl) * 2)), v0, v1); }
                else if (KIND == 2) store_bf8((bf16_t*)((unsigned char*)dst + (size_t)(unsigned)((row * 512 + cl) * 2)), v0, v1);
                else { for (int j = 0; j < 4; ++j) { v0[j] = __builtin_amdgcn_rcpf(1.f + __builtin_amdgcn_exp2f(v0[j])); v1[j] = __builtin_amdgcn_rcpf(1.f + __builtin_amdgcn_exp2f(v1[j])); } store_bf8(    (bf16_t*)((unsigned char*)dst + (size_t)(unsigned)((row * 1024 + cl) * 2)), v0, v1); }
                asm volatile("" ::: "memory");
            }
    }
    DI void half_fv(const pg8::i32x4 (&acc)[2][2][4][2], int bj, int row00, int colp0, int cl0, int fr, int fq, int wc) const {
#pragma unroll
        for (int n = 0; n < 2; ++n) {
            const int cl = cl0 + wc * 32 + n * 16 + fq * 4;
            const f32x4 swv = *(const f32x4*)(sw + colp0 + wc * 32 + n * 16 + fq * 4);
#pragma unroll
            for (int ai = 0; ai < 2; ++ai)
#pragma unroll
                for (int m = 0; m < 4; ++m) {
                    const int row = row00 + ai * 128 + m * 16;
                    const f32x4 z = __builtin_convertvector(ai == 0 ? acc[0][bj][m][n] : acc[1][bj][m][n], f32x4) * swv * (o.rs1[row] * (1.0f / 127.f));
                    bf16_t* d = o.FV + ((size_t)((row >> 12) * 512 + cl)) * kS + (row & (kS - 1));
                    for (int j = 0; j < 4; ++j) d[(size_t)j * kS] = (bf16_t)(cvtpk(z[j], 0.f) & 0xffffu);
                }
        }
    }
    DI void operator()(const pg8::i32x4 (&acc)[2][2][4][2], const pg8::Unit& u, int wr, int wc, int fr_in, int fq_in) const {
        int fr = fr_in, fq = fq_in; asm volatile("" : "+v"(fr), "+v"(fq));
        const int rowb = u.pm * 256 + wr * 64;
        LAS unsigned char* wl = lds_epi + (wr * 4 + wc) * EPI_LDS_WAVE;
#pragma unroll
        for (int bj = 0; bj < 2; ++bj) {
            const int colh = u.pn * 256 + bj * 128, cw = wc * 32, cp = colh + cw;
            if (colh < 512) half<0>(acc, bj, rowb, cp, colh + cw, o.QH, 1.f, fr, fq, wl);
            else if (colh < 1024) half<1>(acc, bj, rowb, cp, colh - 512 + cw, o.LF, -kLog2e, fr, fq, wl);
            else if (colh < 1536) half<2>(acc, bj, rowb, cp, colh - 1024 + cw, o.VH, 1.f, fr, fq, wl);
            else if (colh < 2048) half<0>(acc, bj, rowb, cp, colh - 1536 + cw, o.GH, 1.f, fr, fq, wl);
            else if (colh < 2560) half<2>(acc, bj, rowb, cp, colh - 2048 + cw, o.FQ, 0.125f * kLog2e, fr, fq, wl);
            else if (colh < 3072) half<2>(acc, bj, rowb, cp, colh - 2560 + cw, o.FK, 1.f, fr, fq, wl);
            else if (colh < 3584) half<2>(acc, bj, rowb, cp, colh - 3072 + cw, o.FV, 1.f, fr, fq, wl);
            else if (colh < 3712) { if (wc == 0 && fq < 2) {
                    const f32x4 swv = *(const f32x4*)(sw + colh + fq * 4);
#pragma unroll
                    for (int ai = 0; ai < 2; ++ai)
#pragma unroll
                        for (int m = 0; m < 4; ++m) { const int row = rowb + fr + ai * 128 + m * 16; const f32x4 z = __builtin_convertvector(ai == 0 ? acc[0][bj][m][0] : acc[1][bj][m][0], f32x4) * swv * (o.rs1[row] * (1.0f / 127.f)); f32x4 q;
                            for (int j = 0; j < 4; ++j) q[j] = -__builtin_amdgcn_logf(1.f + __builtin_amdgcn_exp2f(-(z[j] + o.ffb[fq * 4 + j]) * kLog2e));
                            *(f32x4*)(o.LFF + (size_t)row * 8 + fq * 4) = q; } } }
            else if (colh < 4736) half<5>(acc, bj, rowb, cp, colh - 3712 + cw, o.SGA, -kLog2e, fr, fq, wl);
            else if (colh < kINP) half<5>(acc, bj, rowb, cp, colh - 4736 + cw, o.SGB, -kLog2e, fr, fq, wl);
        }
    }
};
DI void unpack_bf8(const uint4& u, f32x4& v0, f32x4& v1) {
    v0 = (f32x4){__uint_as_float(u.x << 16), __uint_as_float(u.x & 0xffff0000u), __uint_as_float(u.y << 16), __uint_as_float(u.y & 0xffff0000u)};
    v1 = (f32x4){__uint_as_float(u.z << 16), __uint_as_float(u.z & 0xffff0000u), __uint_as_float(u.w << 16), __uint_as_float(u.w & 0xffff0000u)}; }
struct Epi8Gate {
    static constexpr bool PERM = false, AFTER_DRAIN = false;
    const bf16_t* G0; const bf16_t* G1; bf16_t* Mg; LAS unsigned char* lds_epi;
    DI void operator()(const f32x4 (&acc)[2][2][4][2], const pg8::Unit& u, int wr, int wc, int fr, int fq) const {
        LAS unsigned char* wl = lds_epi + (wr * 4 + wc) * EPI_LDS_WAVE; const int lane = fr + 16 * fq, r = lane >> 2, c8 = 8 * (lane & 3);
        const size_t base = (size_t)(u.pm * 256 + wr * 64 + r) * 1024 + u.pn * 256 + wc * 32 + c8;
        const int mode = u.alt; const bf16_t* G = mode ? G1 : G0;
#define EPG_OFF(blk) (base + (size_t)((((blk) >> 3) * 128 + (((blk) >> 1) & 3) * 16) * 1024 + ((blk) & 1) * 128))
        uint4 gn = *(const uint4*)(G + EPG_OFF(0)), pn = make_uint4(0u, 0u, 0u, 0u);
        if (mode) pn = *(const uint4*)(Mg + EPG_OFF(0));
#pragma unroll
        for (int blk = 0; blk < 16; ++blk) {
            const int ai = blk >> 3, m = (blk >> 1) & 3, bj = blk & 1;
            const uint4 gc = gn, pc = pn;
            if (blk + 1 < 16) { gn = *(const uint4*)(G + EPG_OFF(blk + 1)); if (mode) pn = *(const uint4*)(Mg + EPG_OFF(blk + 1)); }
            f32x4 v0, v1; epi_strip(acc[ai][bj][m][0], acc[ai][bj][m][1], wl, fr, fq, v0, v1);
            f32x4 g0, g1; unpack_bf8(gc, g0, g1); v0 = v0 * g0; v1 = v1 * g1;
            if (mode) { f32x4 p0, p1; unpack_bf8(pc, p0, p1); v0 += p0; v1 += p1; }
            store_bf8(Mg + EPG_OFF(blk), v0, v1);
        }
#undef EPG_OFF
    }
};
struct Epi8Wout {
    static constexpr bool PERM = false, AFTER_DRAIN = false;
    const float* X; bf16_t* Hb; float* SSQ; LAS unsigned char* lds_epi;
    DI void operator()(const f32x4 (&acc)[2][2][4][2], const pg8::Unit& u, int wr, int wc, int fr, int fq) const {
        LAS unsigned char* wl = lds_epi + (wr * 4 + wc) * EPI_LDS_WAVE; const int lane = fr + 16 * fq, r = lane >> 2, c8 = 8 * (lane & 3);
        const int row0 = u.pm * 256 + wr * 64 + r;
        const size_t base = (size_t)row0 * 1024 + u.pn * 256 + wc * 32 + c8;
#define EPO_OFF(blk) (base + (size_t)((((blk) >> 3) * 128 + (((blk) >> 1) & 3) * 16) * 1024 + ((blk) & 1) * 128))
        f32x4 xn0 = *(const f32x4*)(X + EPO_OFF(0)), xn1 = *(const f32x4*)(X + EPO_OFF(0) + 4);
        float ss = 0.f;
#pragma unroll
        for (int blk = 0; blk < 16; ++blk) {
            const int ai = blk >> 3, m = (blk >> 1) & 3, bj = blk & 1;
            const f32x4 x0 = xn0, x1 = xn1;
            if (blk + 1 < 16) { xn0 = *(const f32x4*)(X + EPO_OFF(blk + 1)); xn1 = *(const f32x4*)(X + EPO_OFF(blk + 1) + 4); }
            f32x4 v0, v1; epi_strip(acc[ai][bj][m][0], acc[ai][bj][m][1], wl, fr, fq, v0, v1);
            v0 += x0; v1 += x1;
            store_bf8(Hb + EPO_OFF(blk), v0, v1);
            ss += (v0[0] * v0[0] + v0[1] * v0[1]) + (v0[2] * v0[2] + v0[3] * v0[3]) + (v1[0] * v1[0] + v1[1] * v1[1]) + (v1[2] * v1[2] + v1[3] * v1[3]);
            if (bj == 1) {
                ss += __shfl_xor(ss, 1); ss += __shfl_xor(ss, 2);
                if ((lane & 3) == 0) SSQ[(size_t)(row0 + ai * 128 + m * 16) * 16 + u.pn * 4 + wc] = ss;
                ss = 0.f;
            }
        }
#undef EPO_OFF
    }
};
struct Epi8Wq {
    static constexpr bool PERM = false, AFTER_DRAIN = false;
    const float* SSQ; bf16_t* Q; LAS unsigned char* lds_epi;
    DI void operator()(const f32x4 (&acc)[2][2][4][2], const pg8::Unit& u, int wr, int wc, int fr, int fq) const {
        LAS unsigned char* wl = lds_epi + (wr * 4 + wc) * EPI_LDS_WAVE; const int lane = fr + 16 * fq, r = lane >> 2, c8 = 8 * (lane & 3);
        const int row0 = u.pm * 256 + wr * 64 + r;
        f32x4 sp[8];
#pragma unroll
        for (int q = 0; q < 8; ++q) sp[q] = *(const f32x4*)(SSQ + (size_t)(row0 + (q >> 2) * 128 + (q & 3) * 16) * 16 + 4 * (lane & 3));
#pragma unroll
        for (int ai = 0; ai < 2; ++ai)
#pragma unroll
            for (int m = 0; m < 4; ++m) {
                const int row = row0 + ai * 128 + m * 16;
                const f32x4 a = sp[ai * 4 + m];
                float s4 = (a[0] + a[1]) + (a[2] + a[3]); s4 += __shfl_xor(s4, 1); s4 += __shfl_xor(s4, 2);
                const float r2 = 1.0f / sqrtf(s4 * (1.0f / kD) + kEps);
#pragma unroll
                for (int bj = 0; bj < 2; ++bj) {
                    f32x4 v0, v1; epi_strip(acc[ai][bj][m][0], acc[ai][bj][m][1], wl, fr, fq, v0, v1);
                    store_bf8(Q + (size_t)row * 2048 + u.pn * 256 + bj * 128 + wc * 32 + c8, v0 * r2, v1 * r2);
                }
            }
    }
};

constexpr int NPHASE = 9;
template <int PH>
DI void run_phase(const Params& p, int bid, int nblk, float* sm) {
    unsigned char* ws = p.ws;
    float* rs1 = (float*)(ws + OFF_RS1); float* SSQ = (float*)(ws + OFF_SSQ); float* cf = (float*)(ws + OFF_CFOX); float* LFF = (float*)(ws + OFF_LFF);
    int* idx = (int*)(ws + OFF_IDX); float* gate = (float*)(ws + OFF_GATE);
    bf16_t* Wtin = (bf16_t*)(ws + OFF_WTIN); bf16_t* Wta = (bf16_t*)(ws + OFF_WTA); bf16_t* Wtb = (bf16_t*)(ws + OFF_WTB); bf16_t* Wto = (bf16_t*)(ws + OFF_WTOUT); bf16_t* Wtq = (bf16_t*)(ws + OFF_WTQ); bf16_t* SKb = (bf16_t*)(ws + OFF_SKB); unsigned char* U8 = ws + OFF_UB; unsigned char* V8 = ws + OFF_VB; float* abuf = (float*)(ws + OFF_ABUF); float* su = (float*)(ws + OFF_SU); float* sv = (float*)(ws + OFF_SV);
    bf16_t* Xb = (bf16_t*)(ws + OFF_R1); bf16_t* ST = Xb; float* DC = (float*)(ws + OFF_DC);
    bf16_t* QH = (bf16_t*)(ws + OFF_R2); bf16_t* LF = QH + (size_t)kT * 512; bf16_t* Mg = QH;
    bf16_t* VH = (bf16_t*)(ws + OFF_R3); bf16_t* GH = VH + (size_t)kT * 512; bf16_t* Hb = VH;
    bf16_t* FK = (bf16_t*)(ws + OFF_R4); bf16_t* FV = FK + (size_t)kT * 512;
    bf16_t* SGA = (bf16_t*)(ws + OFF_R6); bf16_t* SGB = SGA + (size_t)kT * 1024; bf16_t* Qp = SGA;
    bf16_t* FQ = (bf16_t*)p.out; bf16_t* Bb = FQ + (size_t)kT * 512; bf16_t* Ab = Bb + (size_t)kT * 512;
    LAS unsigned char* lds = (LAS unsigned char*)sm;
    if (PH == 0) {
        unsigned char* X8 = (unsigned char*)Xb; float* cmp = (float*)(ws + OFF_SW);
        ph_conv_x8(p.x, X8, rs1, bid, nblk);
        ph_colmax(p.w_in, kINW, 0, 3592, kD, p.nmw, cmp, bid, nblk, sm);
        ph_colmax(p.w_in, kINW, 3592, 2048, kD, p.nmw, cmp + 3712, bid, nblk, sm);
    }
    else if (PH == 11) {
        unsigned char* W8 = (unsigned char*)Wtin; const float* cmp = (const float*)(ws + OFF_SW);
        ph_conv_wt8(p.w_in, kINW, 0, 3592, kD, p.nmw, cmp, W8, bid, nblk, sm);
        ph_conv_wt8(p.w_in, kINW, 3592, 2048, kD, p.nmw, cmp + 3712, W8 + (size_t)3712 * kD, bid, nblk, sm);
        ph_zero_bf16((bf16_t*)(W8 + (size_t)3592 * kD), (size_t)120 * kD / 2, bid, nblk);
        ph_zero_bf16((bf16_t*)(W8 + (size_t)5760 * kD), (size_t)128 * kD / 2, bid, nblk);
    }
    else if (PH == 2) { ph_cfox(LFF, cf, (bf16_t*)(ws + OFF_AUG), nblk - 1 - bid, nblk, sm); ph_hgrn1(LF, VH, ST, DC, bid, nblk, lds); }
    else if (PH == 3) {
        ph_hgrn2(ST, DC, bid, nblk);
        if (bid >= nblk / 2) {
            const int vb = bid - nblk / 2, nvb = nblk / 2;
            ph_conv_wt(p.w_a, kD, 0, 1024, 512, nullptr, Wta, vb, nvb, sm);
            ph_conv_wt(p.w_b, kD, 0, 1024, 512, nullptr, Wtb, vb, nvb, sm);
            ph_conv_wt(p.w_out, kD, 0, 1024, kD, nullptr, Wto, vb, nvb, sm);
            ph_conv_wt(p.w_q, 2048, 0, 2048, kD, p.nfw, Wtq, vb, nvb, sm);
            ph_conv_plain(p.sk, SKb, (size_t)8 * 2 * 128 * 128, nullptr, vb, nvb);
        }
    }
    else if (PH == 9) ph_hgrn3(QH, LF, VH, GH, ST, p.hnw, Ab, bid, nblk, lds);
    else if (PH == 7) {
        ph_topk2<true, false>(Qp, SKb, idx, gate, bid, nblk, lds);
        if (!(bid & 1)) { ph_quant_rows<0>(p.pu, p.nfw, U8, su, 0, bid, nblk); ph_quant_rows<0>(p.pv, nullptr, V8, sv, 0, bid, nblk); }
        ph_topk2<false, true>(Qp, SKb, idx, gate, bid, nblk, lds);
        if (bid & 1) { ph_quant_rows<0>(p.pu, p.nfw, U8, su, 0, bid, nblk); ph_quant_rows<0>(p.pv, nullptr, V8, sv, 0, bid, nblk); }
    }
    else if (PH == 8) ph_exp_u7(Hb, SSQ, U8, su, sv, idx, gate, abuf, bid, nblk, lds);
    else if (PH == 10) ph_exp_v8(Hb, V8, idx, abuf, p.nlw, p.out, bid, nblk, lds);
}

template <int PH>
DI void run_gemm(const Params& p, LAS unsigned char* lds) {
    unsigned char* ws = p.ws;
    float* rs1 = (float*)(ws + OFF_RS1); float* SSQ = (float*)(ws + OFF_SSQ); float* LFF = (float*)(ws + OFF_LFF);
    bf16_t* Wtin = (bf16_t*)(ws + OFF_WTIN); bf16_t* Wta = (bf16_t*)(ws + OFF_WTA); bf16_t* Wtb = (bf16_t*)(ws + OFF_WTB); bf16_t* Wto = (bf16_t*)(ws + OFF_WTOUT); bf16_t* Wtq = (bf16_t*)(ws + OFF_WTQ);
    bf16_t* Xb = (bf16_t*)(ws + OFF_R1);
    bf16_t* QH = (bf16_t*)(ws + OFF_R2); bf16_t* LF = QH + (size_t)kT * 512; bf16_t* Mg = QH;
    bf16_t* VH = (bf16_t*)(ws + OFF_R3); bf16_t* GH = VH + (size_t)kT * 512; bf16_t* Hb = VH;
    bf16_t* FK = (bf16_t*)(ws + OFF_R4); bf16_t* FV = FK + (size_t)kT * 512;
    bf16_t* SGA = (bf16_t*)(ws + OFF_R6); bf16_t* SGB = SGA + (size_t)kT * 1024; bf16_t* Qp = SGA;
    bf16_t* FQ = (bf16_t*)p.out; bf16_t* Bb = FQ + (size_t)kT * 512; bf16_t* Ab = Bb + (size_t)kT * 512;
    const int G = (int)gridDim.x, c = (int)blockIdx.x;
    if (PH == 1) {
        pg8::Gemm g{Xb, Wtin, kT, 5888, kD / 2}; pg8::StaticOrder S; S.init(kT, 5888, G, c);
        Epi8Proj E{ProjOut{rs1, p.lbl, p.ffb, QH, LF, VH, GH, FQ, FK, FV, SGA, SGB, LFF}, (const float*)(ws + OFF_SW), lds + EPI_LDS_OFF};
        pg8::gemm_phase_i8<Epi8Proj, pg8::StaticOrder, true, true>(lds, g, S, E);
    } else if (PH == 4) {
        pg8::Gemm g{Ab, Wta, kT, 1024, 512, Bb, Wtb}; pg8::PairOrder S; S.s.init(kT, 1024, G, c); Epi8Gate E{SGA, SGB, Mg, lds + EPI_LDS_OFF};
        pg8::gemm_phase<Epi8Gate, pg8::PairOrder, true, true>(lds, g, S, E);
    } else if (PH == 5) {
        pg8::Gemm g{Mg, Wto, kT, 1024, kD}; pg8::StaticOrder S; S.init(kT, 1024, G, c); Epi8Wout E{p.x, Hb, SSQ, lds + EPI_LDS_OFF};
        pg8::gemm_phase<Epi8Wout, pg8::StaticOrder, true, true>(lds, g, S, E);
    } else if (PH == 6) {
        pg8::Gemm g{Hb, Wtq, kT, 2048, kD}; pg8::StaticOrder S; S.init(kT, 2048, G, c); Epi8Wq E{SSQ, Qp, lds + EPI_LDS_OFF};
        pg8::gemm_phase<Epi8Wq, pg8::StaticOrder, true, true>(lds, g, S, E);
    }
}

constexpr int SM_FLOATS = 19584;
constexpr size_t OFF_BAR = OFF_SW + 24 * 1024;

__global__ void __launch_bounds__(512, 2) k_mega(Params p) {
    __shared__ __attribute__((aligned(16))) float sm_all[2 * SM_FLOATS + 4];
    volatile LAS unsigned* st = (volatile LAS unsigned*)(LAS float*)(sm_all + 2 * SM_FLOATS);
    if (threadIdx.x == 0) { st[0] = 0u; st[1] = 0u; }
    __syncthreads();
    const XcdBarrier xb = xcd_barrier_post((unsigned*)(p.ws + OFF_BAR), st);
    const int half = __builtin_amdgcn_readfirstlane((int)(threadIdx.x >> 8));
    float* sm = sm_all + half * SM_FLOATS;
    const int bid = blockIdx.x * 2 + half, nblk = gridDim.x * 2;
    run_phase<0>(p, bid, nblk, sm); xcd_barrier(xb);
    run_phase<11>(p, bid, nblk, sm); xcd_barrier(xb);
    run_gemm<1>(p, (LAS unsigned char*)sm_all); xcd_barrier(xb);
    run_phase<2>(p, bid, nblk, sm); xcd_barrier(xb);
    run_phase<3>(p, bid, nblk, sm);
    __syncthreads();
    { bf16_t* FQ_ = (bf16_t*)p.out; bf16_t* FK_ = (bf16_t*)(p.ws + OFF_R4);
      at64::run_all(FQ_, FK_, FK_ + (size_t)kT * 512, (const bf16_t*)(p.ws + OFF_AUG), FQ_ + (size_t)kT * 512, (char*)sm_all); }
    xcd_barrier(xb);
    run_phase<9>(p, bid, nblk, sm); xcd_barrier(xb);
    run_gemm<4>(p, (LAS unsigned char*)sm_all); xcd_barrier(xb);
    run_gemm<5>(p, (LAS unsigned char*)sm_all); xcd_barrier(xb);
    run_gemm<6>(p, (LAS unsigned char*)sm_all); xcd_barrier(xb);
    run_phase<7>(p, bid, nblk, sm); xcd_barrier(xb);
    run_phase<8>(p, bid, nblk, sm); xcd_barrier(xb);
    run_phase<10>(p, bid, nblk, sm);
}

extern "C" void kernel_launch(void* const* d_in, const int* in_sizes, int n_in, void* d_out, int out_size, void* d_ws, size_t ws_size, hipStream_t stream) {
    Params p{};
    p.x = (const float*)d_in[0]; p.nmw = (const float*)d_in[1]; p.w_in = (const float*)d_in[2]; p.lbl = (const float*)d_in[3];
    p.hnw = (const float*)d_in[4]; p.ffb = (const float*)d_in[5]; p.w_a = (const float*)d_in[6]; p.w_b = (const float*)d_in[7];
    p.w_out = (const float*)d_in[8]; p.nfw = (const float*)d_in[9]; p.w_q = (const float*)d_in[10]; p.sk = (const float*)d_in[11];
    p.pu = (const float*)d_in[12]; p.pv = (const float*)d_in[13]; p.nlw = (const float*)d_in[14];
    p.out = (float*)d_out; p.ws = (unsigned char*)d_ws;
    static int grid_blocks = 0;
    if (!grid_blocks) {
        int dev = 0, cus = 0, per_cu = 0;
        (void)hipGetDevice(&dev);
        (void)hipDeviceGetAttribute(&cus, hipDeviceAttributeMultiprocessorCount, dev);
        (void)hipOccupancyMaxActiveBlocksPerMultiprocessor(&per_cu, k_mega, 512, 0);
        if (per_cu > 1) per_cu = 1;
        if (per_cu < 1) per_cu = 1;
        grid_blocks = cus * per_cu;
        if (ws_size < 507 * MBy) fprintf(stderr, "workspace too small: %zu\n", ws_size);
    }
    (void)hipMemsetAsync((unsigned char*)d_ws + OFF_SW, 0, 24 * 1024 + XCD_BAR_WORDS * sizeof(unsigned), stream);
    void* args[] = {&p};
    hipError_t e = hipLaunchCooperativeKernel((void*)k_mega, dim3(grid_blocks), dim3(512), args, 0, stream);
    if (e != hipSuccess) fprintf(stderr, "cooperative launch failed: %s (grid %d)\n", hipGetErrorString(e), grid_blocks);
}
```
